# Optimizing an MI355X kernel written in HIP

```python
import math
import jax, jax.numpy as jnp
from jax import lax
import numpy as np

D_MODEL = 2048
BATCH = 2
SEQ = 4096
DEPTH = 2

CHUNK = 64
N_META = 16
Q_BLOCK = 128
N_MIXERS = 2
RMS_EPS = 1e-6

DA_HEADS = 8
DA_HEAD_DIM = D_MODEL // (2 * DA_HEADS)
DA_V_DIM = 2 * DA_HEAD_DIM
ROPE_THETA = 500000.0
ROPE_DIM = DA_HEAD_DIM // 4

POOL_WINDOWS = (2, 4, 8, 16)
POOL_GROUPS = len(POOL_WINDOWS)
POOL_GROUP_DIM = D_MODEL // POOL_GROUPS

N_ATTN_LAYERS = (DEPTH + 1) // 2
N_POOL_LAYERS = DEPTH // 2

kernel_name = "hybrid_diffattn_pool_streaming_trunk"


def rms_norm(x, g):
    xf = x.astype(jnp.float32)
    y = xf * lax.rsqrt(jnp.mean(xf * xf, axis=-1, keepdims=True) + RMS_EPS)
    return (y * g.astype(jnp.float32)).astype(x.dtype)


def chunk_ids(length):
    p = jnp.arange(length)
    return jnp.where(p < N_META, 0, (p - N_META) // CHUNK + 1)


def rope_tables(length):
    pos = jnp.arange(length, dtype=jnp.float32)
    inv = ROPE_THETA ** (-jnp.arange(0, ROPE_DIM, 2, dtype=jnp.float32) / ROPE_DIM)
    ang = pos[:, None] * inv[None, :]
    return jnp.cos(ang), jnp.sin(ang)


def apply_partial_rope(t, cos, sin):
    half = ROPE_DIM // 2
    c = cos.astype(t.dtype)
    s = sin.astype(t.dtype)
    r1 = t[..., :half]
    r2 = t[..., half:ROPE_DIM]
    return jnp.concatenate([r1 * c - r2 * s, r2 * c + r1 * s, t[..., ROPE_DIM:]], axis=-1)


def diff_attend(q1, q2, k1, k2, v, qc, kc, lam):
    scale = DA_HEAD_DIM ** -0.5
    mask = kc[None, :] <= qc[:, None]
    neg = jnp.finfo(jnp.float32).min
    s1 = jnp.einsum('bhqd,bhkd->bhqk', q1, k1).astype(jnp.float32) * scale
    s2 = jnp.einsum('bhqd,bhkd->bhqk', q2, k2).astype(jnp.float32) * scale
    p1 = jax.nn.softmax(jnp.where(mask, s1, neg), axis=-1)
    p2 = jax.nn.softmax(jnp.where(mask, s2, neg), axis=-1)
    a = p1 - lam * p2
    return jnp.einsum('bhqk,bhkd->bhqd', a.astype(v.dtype), v)


def diff_attention_mixer(h, w_in, w_out, lq1, lk1, lq2, lk2, subln_g, layer_idx, cos, sin):
    B, L, D = h.shape
    proj = h @ w_in
    q, k, v, g = jnp.split(proj, 4, axis=-1)
    q = q.reshape(B, L, DA_HEADS, 2, DA_HEAD_DIM).transpose(0, 2, 3, 1, 4)
    k = k.reshape(B, L, DA_HEADS, 2, DA_HEAD_DIM).transpose(0, 2, 3, 1, 4)
    v = v.reshape(B, L, DA_HEADS, DA_V_DIM).transpose(0, 2, 1, 3)
    q1 = apply_partial_rope(q[:, :, 0], cos, sin)
    q2 = apply_partial_rope(q[:, :, 1], cos, sin)
    k1 = apply_partial_rope(k[:, :, 0], cos, sin)
    k2 = apply_partial_rope(k[:, :, 1], cos, sin)

    lam_init = 0.8 - 0.6 * math.exp(-0.3 * layer_idx)
    lam = (jnp.exp(jnp.sum(lq1.astype(jnp.float32) * lk1.astype(jnp.float32)))
           - jnp.exp(jnp.sum(lq2.astype(jnp.float32) * lk2.astype(jnp.float32)))
           + lam_init)

    cid = chunk_ids(L)
    outs = [diff_attend(q1[:, :, :N_META], q2[:, :, :N_META], k1[:, :, :N_META],
                        k2[:, :, :N_META], v[:, :, :N_META], cid[:N_META], cid[:N_META], lam)]
    n_blocks = (L - N_META) // Q_BLOCK
    for b in range(n_blocks):
        q0 = N_META + b * Q_BLOCK
        q1e = q0 + Q_BLOCK
        outs.append(diff_attend(q1[:, :, q0:q1e], q2[:, :, q0:q1e], k1[:, :, :q1e],
                                k2[:, :, :q1e], v[:, :, :q1e], cid[q0:q1e], cid[:q1e], lam))
    o = jnp.concatenate(outs, axis=2)
    o = rms_norm(o, subln_g) * (1.0 - lam_init)
    o = o.transpose(0, 2, 1, 3).reshape(B, L, D)
    return (o * jax.nn.silu(g)) @ w_out


def pool_mixer(h, w_in, w_group, scale, w_out):
    B, L, D = h.shape
    proj = h @ w_in
    u, g = jnp.split(proj, 2, axis=-1)
    ug = u.reshape(B, L, POOL_GROUPS, POOL_GROUP_DIM)
    cs = jnp.cumsum(ug.astype(jnp.float32), axis=1)
    csp = jnp.concatenate([jnp.zeros((B, 1, POOL_GROUPS, POOL_GROUP_DIM), jnp.float32), cs], axis=1)
    t = jnp.arange(L)
    pooled = []
    for gi, w in enumerate(POOL_WINDOWS):
        start = jnp.maximum(t + 1 - w, 0)
        cnt = jnp.minimum(t + 1, w).astype(jnp.float32)
        s = csp[:, 1:, gi] - csp[:, start, gi]
        pooled.append(s / cnt[None, :, None])
    pooled = jnp.stack(pooled, axis=2).astype(u.dtype)
    mixed = pooled - ug
    mixed = jnp.einsum('blgc,gcd->blgd', mixed, w_group).reshape(B, L, D) * scale
    return (mixed * jax.nn.silu(g)) @ w_out


def setup_inputs(seed: int = 0) -> dict:
    key = jax.random.key(seed)
    ks = jax.random.split(key, 16)
    D = D_MODEL
    f = jnp.float32
    nrm = jax.random.normal
    return {
        "x": nrm(ks[0], (BATCH, SEQ, D), f),
        "meta_tokens": nrm(ks[1], (N_META, D), f),
        "pre_norm_g": 1.0 + 0.05 * nrm(ks[2], (DEPTH, D), f),
        "post_norm_g": 1.0 + 0.05 * nrm(ks[3], (DEPTH, D), f),
        "attn_w_in": nrm(ks[4], (N_ATTN_LAYERS, D, 4 * D), f) * D ** -0.5,
        "attn_w_out": nrm(ks[5], (N_ATTN_LAYERS, D, D), f) * D ** -0.5,
        "attn_lambda_q1": 0.1 * nrm(ks[6], (N_ATTN_LAYERS, DA_HEAD_DIM), f),
        "attn_lambda_k1": 0.1 * nrm(ks[7], (N_ATTN_LAYERS, DA_HEAD_DIM), f),
        "attn_lambda_q2": 0.1 * nrm(ks[8], (N_ATTN_LAYERS, DA_HEAD_DIM), f),
        "attn_lambda_k2": 0.1 * nrm(ks[9], (N_ATTN_LAYERS, DA_HEAD_DIM), f),
        "attn_subln_g": 1.0 + 0.05 * nrm(ks[10], (N_ATTN_LAYERS, DA_V_DIM), f),
        "pool_w_in": nrm(ks[11], (N_POOL_LAYERS, D, 2 * D), f) * D ** -0.5,
        "pool_w_group": nrm(ks[12], (N_POOL_LAYERS, POOL_GROUPS, POOL_GROUP_DIM, POOL_GROUP_DIM), f) * POOL_GROUP_DIM ** -0.5,
        "pool_scale": 1.0 + 0.1 * nrm(ks[13], (N_POOL_LAYERS, D), f),
        "pool_w_out": nrm(ks[14], (N_POOL_LAYERS, D, D), f) * D ** -0.5,
    }


def reference(x, meta_tokens, pre_norm_g, post_norm_g, attn_w_in, attn_w_out,
              attn_lambda_q1, attn_lambda_k1, attn_lambda_q2, attn_lambda_k2, attn_subln_g,
              pool_w_in, pool_w_group, pool_scale, pool_w_out):
    B = x.shape[0]
    meta = jnp.broadcast_to(meta_tokens.astype(x.dtype)[None], (B, N_META, x.shape[-1]))
    h = jnp.concatenate([meta, x], axis=1)
    L = h.shape[1]
    cos, sin = rope_tables(L)
    for i in range(DEPTH):
        j = i // N_MIXERS
        hn = rms_norm(h, pre_norm_g[i])
        if i % N_MIXERS == 0:
            y = diff_attention_mixer(hn, attn_w_in[j], attn_w_out[j], attn_lambda_q1[j],
                                     attn_lambda_k1[j], attn_lambda_q2[j], attn_lambda_k2[j],
                                     attn_subln_g[j], i, cos, sin)
        else:
            y = pool_mixer(hn, pool_w_in[j], pool_w_group[j], pool_scale[j], pool_w_out[j])
        h = h + rms_norm(y, post_norm_g[i])
    return h[:, N_META:]
```

```cpp
#include <hip/hip_runtime.h>
#include <cstdio>
#include <cstdint>
#include <cmath>

#ifndef MK_N_LAUNCHES
#define MK_N_LAUNCHES 1
#endif

#define LAS __attribute__((address_space(3)))
#define GAS __attribute__((address_space(1)))
typedef unsigned short bf16_t;
typedef short bf16x8 __attribute__((ext_vector_type(8)));
typedef short s16x4 __attribute__((ext_vector_type(4)));
typedef float f32x4 __attribute__((ext_vector_type(4)));
typedef float f32x16 __attribute__((ext_vector_type(16)));
typedef unsigned u32x4 __attribute__((ext_vector_type(4)));
typedef unsigned u32x2 __attribute__((ext_vector_type(2)));

constexpr int DM = 2048, SEQ = 4096, NB = 2, NMETA = 16, LTOT = SEQ + NMETA;
constexpr int MREAL = NB * SEQ;
constexpr int MROWS = MREAL + NMETA;
constexpr int NH = 8, HD = 128, VD = 256;
constexpr int NTILE = 65;
constexpr int KTILE_B = 64 * 128 * 2, VTILE_B = 64 * 256 * 2;
constexpr float RMS_EPS = 1e-6f;
constexpr float C2 = 0.08838834764831845f * 1.4426950408889634f;
constexpr float LOG2E = 1.4426950408889634f;

constexpr size_t MiB = 1u << 20;
constexpr size_t WS_CTL = 0, CTL_ZERO_BYTES = 65536;
constexpr size_t WS_ROPEC = 1 * MiB, WS_ROPES = 1 * MiB + 512 * 1024;
constexpr size_t WS_RSTD0 = 2 * MiB;
constexpr size_t WS_W1 = 4 * MiB, WS_W2 = 36 * MiB, WS_W3 = 44 * MiB, WS_W4 = 60 * MiB, WS_W5 = 62 * MiB;
constexpr size_t WS_XN = 70 * MiB, WS_G = 104 * MiB, WS_QO = 138 * MiB, WS_K = 172 * MiB;
constexpr size_t KIMG_BYTES = (size_t)NB * NH * 2 * NTILE * KTILE_B, VIMG_BYTES = (size_t)NB * NH * NTILE * VTILE_B;
constexpr size_t WS_V = WS_K + KIMG_BYTES;
constexpr size_t WS_Y0 = WS_K;
constexpr size_t WS_U = WS_QO, WS_G1 = WS_G, WS_MIX = WS_XN, WS_GATED1 = WS_QO, WS_Y1 = WS_XN;
constexpr size_t WS_END = WS_V + VIMG_BYTES;
static_assert(WS_END <= 240 * MiB && WS_Y0 + (size_t)MROWS * DM * 4 <= WS_END && WS_Y1 + (size_t)MROWS * DM * 4 <= WS_QO, "ws map");
constexpr int CW_BAR = 4096;

constexpr int RING_BYTES = 131072, LDSCTL_OFF = RING_BYTES, MISC_OFF = LDSCTL_OFF + 320, LDS_BYTES = 147456;

__device__ __forceinline__ unsigned pk2(float lo, float hi) {
    typedef float f2_t __attribute__((ext_vector_type(2))); typedef __bf16 b2_t __attribute__((ext_vector_type(2)));
    f2_t v = {lo, hi}; b2_t b = __builtin_convertvector(v, b2_t); return __builtin_bit_cast(unsigned, b);
}
__device__ __forceinline__ float bflo(unsigned u) { return __uint_as_float(u << 16); }
__device__ __forceinline__ float bfhi(unsigned u) { return __uint_as_float(u & 0xffff0000u); }
__device__ __forceinline__ float siluf(float x) { return x * __builtin_amdgcn_rcpf(1.0f + __builtin_amdgcn_exp2f(-x * LOG2E)); }
__device__ __forceinline__ float wave_sum(float v) {
#pragma unroll
    for (int o = 1; o < 64; o <<= 1) v += __shfl_xor(v, o);
    return v;
}
__device__ __forceinline__ u32x4 pack8(f32x4 a, f32x4 b) { u32x4 w; w.x = pk2(a[0], a[1]); w.y = pk2(a[2], a[3]); w.z = pk2(b[0], b[1]); w.w = pk2(b[2], b[3]); return w; }

struct Epi {
    int mode;
    bf16_t* Q; unsigned char* Kimg; unsigned char* Vimg; bf16_t* G; const float* ropec; const float* ropes;
    float* Y;
    bf16_t* U; bf16_t* G1;
    bf16_t* GATED1; const float* pool_scale;
    template <int MODE> __device__ __forceinline__ void emit(int row, int col, f32x4 a, f32x4 b) const {
        if constexpr (MODE == 1) {
            if (col < 4096) {
                const int c = col & 2047, dim = c & 127;
                if (dim < 32) {
                    f32x4 pa, pb;
#pragma unroll
                    for (int i = 0; i < 4; ++i) { pa[i] = __shfl_xor(a[i], 32); pb[i] = __shfl_xor(b[i], 32); }
                    const int pos = row < MREAL ? NMETA + (row & (SEQ - 1)) : row - MREAL;
                    const float* cs = ropec + pos * 16 + (dim & 15); const float* sn = ropes + pos * 16 + (dim & 15);
                    const f32x4 c0 = *(const f32x4*)cs, c1 = *(const f32x4*)(cs + 4), s0 = *(const f32x4*)sn, s1 = *(const f32x4*)(sn + 4);
                    if (dim < 16) { a = a * c0 - pa * s0; b = b * c1 - pb * s1; } else { a = a * c0 + pa * s0; b = b * c1 + pb * s1; }
                }
                if (col < 2048) { a = a * C2; b = b * C2; *(u32x4*)(Q + (size_t)row * DM + c) = pack8(a, b); }
                else {
                    const int h = c >> 8, mp = (c >> 7) & 1; const u32x4 w = pack8(a, b);
                    const size_t inner = (size_t)(dim >> 3) * 1024;
                    if (row < MREAL) { const int bb = row >> 12, j = row & (SEQ - 1), tile = 1 + (j >> 6), key = j & 63;
                        *(u32x4*)(Kimg + ((size_t)((bb * NH + h) * 2 + mp) * NTILE + tile) * KTILE_B + inner + key * 16) = w; }
                    else { const int key = row - MREAL;
#pragma unroll
                        for (int bb = 0; bb < NB; ++bb) *(u32x4*)(Kimg + ((size_t)((bb * NH + h) * 2 + mp) * NTILE) * KTILE_B + inner + key * 16) = w; }
                }
            } else if (col < 6144) {
                const int c = col - 4096, h = c >> 8, d = c & 255; const u32x4 w = pack8(a, b);
                if (row < MREAL) { const int bb = row >> 12, j = row & (SEQ - 1), tile = 1 + (j >> 6), key = j & 63;
                    *(u32x4*)(Vimg + ((size_t)(bb * NH + h) * NTILE + tile) * VTILE_B + ((key >> 3) * 8 + (d >> 5)) * 512 + (key & 7) * 64 + (d & 31) * 2) = w; }
                else { const int key = row - MREAL;
#pragma unroll
                    for (int bb = 0; bb < NB; ++bb) *(u32x4*)(Vimg + ((size_t)(bb * NH + h) * NTILE) * VTILE_B + ((key >> 3) * 8 + (d >> 5)) * 512 + (key & 7) * 64 + (d & 31) * 2) = w; }
            } else {
                const int c = col - 6144;
#pragma unroll
                for (int i = 0; i < 4; ++i) { a[i] = siluf(a[i]); b[i] = siluf(b[i]); }
                *(u32x4*)(G + (size_t)row * DM + c) = pack8(a, b);
            }
        } else if constexpr (MODE == 2 || MODE == 5) {
            float* y = Y + (size_t)row * DM + col; *(f32x4*)y = a; *(f32x4*)(y + 4) = b;
        } else if constexpr (MODE == 3) {
            if (col < 2048) { *(u32x4*)(U + (size_t)row * DM + col) = pack8(a, b); }
            else { const int c = col - 2048;
#pragma unroll
                for (int i = 0; i < 4; ++i) { a[i] = siluf(a[i]); b[i] = siluf(b[i]); }
                *(u32x4*)(G1 + (size_t)row * DM + c) = pack8(a, b); }
        } else {
            const f32x4 s0 = *(const f32x4*)(pool_scale + col), s1 = *(const f32x4*)(pool_scale + col + 4);
            const u32x4 g = *(const u32x4*)(G1 + (size_t)row * DM + col);
            a[0] *= s0[0] * bflo(g.x); a[1] *= s0[1] * bfhi(g.x); a[2] *= s0[2] * bflo(g.y); a[3] *= s0[3] * bfhi(g.y);
            b[0] *= s1[0] * bflo(g.z); b[1] *= s1[1] * bfhi(g.z); b[2] *= s1[2] * bflo(g.w); b[3] *= s1[3] * bfhi(g.w);
            *(u32x4*)(GATED1 + (size_t)row * DM + col) = pack8(a, b);
        }
    }
    __device__ __forceinline__ void emit_rt(int row, int col, f32x4 a, f32x4 b) const {
        if (mode == 1) emit<1>(row, col, a, b); else if (mode == 2 || mode == 5) emit<2>(row, col, a, b); else if (mode == 3) emit<3>(row, col, a, b); else emit<4>(row, col, a, b);
    }
};

namespace pg8 {
constexpr int BM = 256, BK = 64, HALF = 128, HTB = HALF * BK * 2, STAGE_BYTES = 8 * HTB, NXCD = 8, WGM = 8;
__host__ __device__ __forceinline__ int lds_byte(int r, int c) { const int st = (r >> 4) * 2 + (c >> 5), rr = r & 15, cc = c & 31, ob = rr * 64 + cc * 2; return st * 1024 + (ob ^ (((ob >> 9) & 1) << 5)); }
__host__ __device__ __forceinline__ void stage_rc(int b, int& R, int& C) { const int st = b / 1024, sb = b % 1024, swz = sb ^ (((sb >> 9) & 1) << 5); R = (st >> 1) * 16 + swz / 64; C = (st & 1) * 32 + (swz % 64) / 2; }
__host__ __device__ __forceinline__ int perm32(int rho) { const int n = rho >> 4, i = rho & 15; return 8 * (i >> 2) + 4 * n + (i & 3); }
struct Unit { int pm, pn; };
struct Gemm { const bf16_t* A; const bf16_t* Bt; int M, N, K, lda, ldb, pn_per_grp, a_grp_cols; };
struct StaticOrder {
    int nM, nN, nwg, G, c;
    __device__ void init(int M, int N, int G_, int c_) { nM = M / BM; nN = N / BM; nwg = nM * nN; G = G_; c = c_; }
    __device__ bool next(int i, Unit& u) const {
        const long L = (long)i * G + c; if (L >= nwg) return false;
        int wgid = (int)L; { const int q = nwg / NXCD, r = nwg % NXCD, xcd = wgid % NXCD, off = wgid / NXCD; wgid = (xcd < r ? xcd * (q + 1) : r * (q + 1) + (xcd - r) * q) + off; }
        const int nig = WGM * nN, gid = wgid / nig, fm = gid * WGM, gsz = (nM - fm) < WGM ? (nM - fm) : WGM;
        u.pm = fm + ((wgid % nig) % gsz); u.pn = (wgid % nig) / gsz; return true;
    }
};
template <int MODE>
__device__ __forceinline__ void run_epi_m(const Epi& E, const f32x4 (&acc)[2][2][4][2], const Unit& u, int wr, int wc) {
    int lane = threadIdx.x & 63; asm volatile("" : "+v"(lane));
    const int fr = lane & 15, fq = lane >> 4;
#pragma unroll
    for (int ai = 0; ai < 2; ++ai)
#pragma unroll
        for (int m = 0; m < 4; ++m) { const int row = u.pm * BM + ai * HALF + wr * 64 + m * 16 + fr;
#pragma unroll
            for (int bj = 0; bj < 2; ++bj) { const int col = u.pn * BM + bj * HALF + wc * 32 + 8 * fq; E.emit<MODE>(row, col, acc[ai][bj][m][0], acc[ai][bj][m][1]); asm volatile("" ::: "memory"); } }
}
__device__ __forceinline__ void run_epi(const Epi& E, const f32x4 (&acc)[2][2][4][2], const Unit& u, int wr, int wc, int fr, int fq) {
    if (E.mode == 1) run_epi_m<1>(E, acc, u, wr, wc); else if (E.mode == 2 || E.mode == 5) run_epi_m<2>(E, acc, u, wr, wc);
    else if (E.mode == 3) run_epi_m<3>(E, acc, u, wr, wc); else run_epi_m<4>(E, acc, u, wr, wc);
}
template <bool ALIGN_EPI>
__device__ __forceinline__ void gemm_phase(LAS unsigned char* lds, const Gemm g, const StaticOrder& S, const Epi& E) {
    const int tid = threadIdx.x, wid = __builtin_amdgcn_readfirstlane(tid >> 6), lane = tid & 63, wr = wid >> 2, wc = wid & 3, fr = lane & 15, fq = lane >> 4;
    const int K = g.K, nt = K / BK;
    unsigned voffA[2], voffB[2];
#pragma unroll
    for (int i = 0; i < 2; ++i) { int R, C; stage_rc(tid * 16 + i * 8192, R, C); const int Rb = (R & ~31) + perm32(R & 31);
        voffA[i] = (unsigned)(R * g.lda + C) * 2u; voffB[i] = (unsigned)(Rb * g.ldb + C) * 2u; }
    const size_t kstep = (size_t)(BK * 2);
    const size_t hstepA = (size_t)HALF * g.lda * 2, hstepB = (size_t)HALF * g.ldb * 2;
    const size_t tstepA = 2 * hstepA, tstepB = 2 * hstepB;
    const unsigned ldsw = (unsigned)wid * 1024u;
    const int aoff = lds_byte(wr * 64 + fr, fq * 8), boff = lds_byte(wc * 32 + fr, fq * 8);
#define PG8_SA(b, h) (((b) * 2 + (h)) * HTB)
#define PG8_SB(b, h) ((4 + (b) * 2 + (h)) * HTB)
#define PG8_STAGE(bufoff, gbase, voff) do { _Pragma("unroll") for (int _i = 0; _i < 2; ++_i) \
        __builtin_amdgcn_global_load_lds((const unsigned*)((const char*)(gbase) + (voff)[_i]), (LAS unsigned*)(lds + (bufoff) + ldsw + _i * 8192), 16, 0, 0); } while (0)
#define PG8_LDA(dst, b, h) do { _Pragma("unroll") for (int m = 0; m < 4; ++m) _Pragma("unroll") for (int k = 0; k < 2; ++k) dst[m][k] = *(const LAS bf16x8*)(lds + PG8_SA(b, h) + aoff + m * 2048 + k * 1024); } while (0)
#define PG8_LDB(dst, b, h) do { _Pragma("unroll") for (int n = 0; n < 2; ++n) _Pragma("unroll") for (int k = 0; k < 2; ++k) dst[n][k] = *(const LAS bf16x8*)(lds + PG8_SB(b, h) + boff + n * 2048 + k * 1024); } while (0)
#define PG8_MMA(ai, bj, At, Bt) do { __builtin_amdgcn_s_setprio(1); _Pragma("unroll") for (int m = 0; m < 4; ++m) _Pragma("unroll") for (int n = 0; n < 2; ++n) _Pragma("unroll") for (int k = 0; k < 2; ++k) \
        acc[ai][bj][m][n] = __builtin_amdgcn_mfma_f32_16x16x32_bf16(Bt[n][k], At[m][k], acc[ai][bj][m][n], 0, 0, 0); __builtin_amdgcn_s_setprio(0); } while (0)
#define PG8_WAIT_V(n) asm volatile("s_waitcnt vmcnt(" #n ")" ::: "memory")
#define PG8_WAIT_L(n) asm volatile("s_waitcnt lgkmcnt(" #n ")" ::: "memory")
#define PG8_BAR __builtin_amdgcn_s_barrier()
#define PG8_SCHED __builtin_amdgcn_sched_barrier(0)
#define PG8_ABASE(u) ((const char*)g.A + (size_t)(u).pm * tstepA + (size_t)((u).pn / g.pn_per_grp) * g.a_grp_cols * 2)
    Unit cur, nxt; int ui = 0;
    if (!S.next(0, cur)) return;
    f32x4 acc[2][2][4][2];
#pragma unroll
    for (int a = 0; a < 2; ++a)
#pragma unroll
        for (int b = 0; b < 2; ++b)
#pragma unroll
            for (int m = 0; m < 4; ++m)
#pragma unroll
                for (int n = 0; n < 2; ++n) acc[a][b][m][n] = (f32x4){0.f, 0.f, 0.f, 0.f};
    bf16x8 At[4][2], B0[2][2], B1[2][2];
    const char* cA = PG8_ABASE(cur); const char* cB = (const char*)g.Bt + (size_t)cur.pn * tstepB;
    PG8_STAGE(PG8_SB(0, 0), cB, voffB); PG8_STAGE(PG8_SB(0, 1), cB + hstepB, voffB); PG8_STAGE(PG8_SA(0, 0), cA, voffA); PG8_STAGE(PG8_SA(0, 1), cA + hstepA, voffA);
    if (wr == 1) PG8_BAR;
    PG8_WAIT_V(2); PG8_BAR;
    PG8_STAGE(PG8_SB(1, 0), cB + kstep, voffB); PG8_STAGE(PG8_SA(1, 0), cA + kstep, voffA); PG8_STAGE(PG8_SB(1, 1), cB + hstepB + kstep, voffB);
    PG8_WAIT_V(6); PG8_BAR;
    for (;;) {
        const bool has_next = S.next(ui + 1, nxt);
        const char* nA = has_next ? PG8_ABASE(nxt) : cA; const char* nB = has_next ? (const char*)g.Bt + (size_t)nxt.pn * tstepB : cB;
        for (int t = 0; t < nt; t += 2) {
            const bool last = (t == nt - 2);
            const char* a1 = cA + (size_t)(t + 1) * kstep;
            const char* a2 = last ? nA : cA + (size_t)(t + 2) * kstep; const char* b2 = last ? nB : cB + (size_t)(t + 2) * kstep;
            const char* a3 = a2 + kstep; const char* b3 = b2 + kstep;
            PG8_LDB(B0, 0, 0); PG8_LDB(B1, 0, 1); PG8_SCHED; PG8_LDA(At, 0, 0); PG8_STAGE(PG8_SA(1, 1), a1 + hstepA, voffA);
            PG8_WAIT_V(8); PG8_WAIT_L(0); PG8_BAR; PG8_MMA(0, 0, At, B0); PG8_MMA(0, 1, At, B1); PG8_BAR; PG8_SCHED;
            PG8_LDA(At, 0, 1); PG8_STAGE(PG8_SB(0, 0), b2, voffB); PG8_STAGE(PG8_SB(0, 1), b2 + hstepB, voffB); PG8_STAGE(PG8_SA(0, 0), a2, voffA);
            PG8_WAIT_V(8); PG8_WAIT_L(0); PG8_BAR; PG8_MMA(1, 0, At, B0); PG8_MMA(1, 1, At, B1); PG8_BAR; PG8_SCHED;
            PG8_LDB(B0, 1, 0); PG8_LDB(B1, 1, 1); PG8_SCHED; PG8_LDA(At, 1, 0); PG8_STAGE(PG8_SA(0, 1), a2 + hstepA, voffA);
            PG8_WAIT_V(8); PG8_WAIT_L(0); PG8_BAR; PG8_MMA(0, 0, At, B0); PG8_MMA(0, 1, At, B1); PG8_BAR; PG8_SCHED;
            PG8_LDA(At, 1, 1); PG8_STAGE(PG8_SB(1, 0), b3, voffB); PG8_STAGE(PG8_SB(1, 1), b3 + hstepB, voffB); PG8_STAGE(PG8_SA(1, 0), a3, voffA);
            PG8_WAIT_V(8); PG8_WAIT_L(0); PG8_BAR; PG8_MMA(1, 0, At, B0); PG8_MMA(1, 1, At, B1); PG8_BAR; PG8_SCHED;
        }
        if constexpr (ALIGN_EPI) { if (wr == 0) PG8_BAR; }
        run_epi(E, acc, cur, wr, wc, fr, fq);
        if (!has_next) break;
#pragma unroll
        for (int a = 0; a < 2; ++a)
#pragma unroll
            for (int b = 0; b < 2; ++b)
#pragma unroll
                for (int m = 0; m < 4; ++m)
#pragma unroll
                    for (int n = 0; n < 2; ++n) acc[a][b][m][n] = (f32x4){0.f, 0.f, 0.f, 0.f};
        cur = nxt; cA = nA; cB = nB; ++ui;
        if constexpr (ALIGN_EPI) { if (wr == 1) PG8_BAR; }
    }
    PG8_WAIT_V(0);
    if constexpr (!ALIGN_EPI) { if (wr == 0) PG8_BAR; }
    PG8_BAR;
#undef PG8_SA
#undef PG8_SB
#undef PG8_STAGE
#undef PG8_LDA
#undef PG8_LDB
#undef PG8_MMA
#undef PG8_WAIT_V
#undef PG8_WAIT_L
#undef PG8_BAR
#undef PG8_SCHED
#undef PG8_ABASE
}
}

typedef GAS unsigned gu32;
#define RLX_AGENT __ATOMIC_RELAXED, __HIP_MEMORY_SCOPE_AGENT
#define XB_TMO      128
#define XB_XCNT(j)  (256  + 64 * (j))
#define XB_XSUB(j)  (1280 + 64 * (j))
#define XB_XGEN(j)  (2304 + 64 * (j))
#define XB_TOP      3328
#define XB_TOPGEN   3392
#define XCD_BAR_WORDS 3456
#define XB_SPIN_CAP (1u << 18)
__device__ __forceinline__ unsigned xb_ld(unsigned* p)              { return __hip_atomic_load(p, __ATOMIC_RELAXED, __HIP_MEMORY_SCOPE_AGENT); }
__device__ __forceinline__ unsigned xb_add(unsigned* p, unsigned v) { return __hip_atomic_fetch_add(p, v, __ATOMIC_RELAXED, __HIP_MEMORY_SCOPE_AGENT); }
__device__ __forceinline__ unsigned xb_xcc_id() { return (unsigned)__builtin_amdgcn_s_getreg((3 << 11) | 20) & 0xFu; }
#define XB_SPIN(cond, bar) do { unsigned _sp = 0; while (cond) { __builtin_amdgcn_s_sleep(1); \
    if ((++_sp & 255u) == 0u) { if (xb_ld(&(bar)[XB_TMO])) break; if (_sp > XB_SPIN_CAP) { atomicAdd(&(bar)[XB_TMO], 1u); break; } } } } while (0)
struct XcdBarrier { unsigned* bar; unsigned x; volatile LAS unsigned* st; };
__device__ __forceinline__ XcdBarrier xcd_barrier_post(unsigned* bar, volatile LAS unsigned* st) {
    XcdBarrier b; b.bar = bar; b.x = xb_xcc_id(); b.st = st;
    if (threadIdx.x == 0) (void)xb_add(&bar[XB_XCNT(b.x)], 1u);
    return b;
}
__device__ __forceinline__ void xcd_barrier_complete(unsigned* bar, unsigned x, unsigned& nloc, unsigned& nx) {
    const unsigned G = gridDim.x * gridDim.y * gridDim.z;
    unsigned sum, cnt, mine, sp = 0u;
    for (;;) {
        sum = 0u; cnt = 0u; mine = 0u;
#pragma unroll
        for (unsigned j = 0; j < 16; ++j) { const unsigned c = xb_ld(&bar[XB_XCNT(j)]); sum += c; cnt += (c > 0u) ? 1u : 0u; mine = (j == x) ? c : mine; }
        if (sum == G) break;
        __builtin_amdgcn_s_sleep(1);
        if ((++sp & 255u) == 0u) { if (xb_ld(&bar[XB_TMO])) break; if (sp > XB_SPIN_CAP) { atomicAdd(&bar[XB_TMO], 1u); break; } }
    }
    nloc = mine > 0u ? mine : 1u; nx = cnt > 0u ? cnt : 1u;
}
__device__ __forceinline__ void xcd_barrier(const XcdBarrier& b) {
    asm volatile("s_waitcnt vmcnt(0)" ::: "memory");
    __syncthreads();
    if (threadIdx.x == 0) {
        unsigned* bar = b.bar;
        __builtin_amdgcn_s_waitcnt(0);
        unsigned nloc = b.st[0], nx = b.st[1];
        if (nloc == 0u) { xcd_barrier_complete(bar, b.x, nloc, nx); b.st[0] = nloc; b.st[1] = nx; }
        const unsigned old = xb_add(&bar[XB_XSUB(b.x)], 1u);
        const unsigned gen = old / nloc;
        if (old + 1u == (gen + 1u) * nloc) {
            __builtin_amdgcn_fence(__ATOMIC_RELEASE, "agent");
            asm volatile("s_waitcnt vmcnt(0)" ::: "memory");
            const unsigned og = xb_add(&bar[XB_TOP], 1u);
            const unsigned tg = og / nx;
            if (og + 1u == (tg + 1u) * nx) xb_add(&bar[XB_TOPGEN], 1u);
            else XB_SPIN(xb_ld(&bar[XB_TOPGEN]) == tg, bar);
            __builtin_amdgcn_fence(__ATOMIC_ACQUIRE, "agent");
            xb_add(&bar[XB_XGEN(b.x)], 1u);
            asm volatile("s_waitcnt vmcnt(0)" ::: "memory");
        } else {
            XB_SPIN(xb_ld(&bar[XB_XGEN(b.x)]) == gen, bar);
            __builtin_amdgcn_fence(__ATOMIC_ACQUIRE, "agent");
            asm volatile("s_waitcnt vmcnt(0)" ::: "memory");
        }
    }
    __syncthreads();
}

struct Args {
    const float* in[15]; float* out; unsigned char* ws;
    float inv_freq[16];
    int ph_lo, ph_hi, li, pad;
};
struct Frame {
    LAS unsigned char* lds; int tid, lane, wave, vcu, G;
};

__device__ __forceinline__ void p0_transpose_item(const float* W, int N, bf16_t* WT, int ldt, int row_off, LAS float* scr, int item, int lane) {
    const int nblk = N / 32, kb = item / nblk, nb = item % nblk, k0 = 64 * kb, n0 = 32 * nb;
#pragma unroll 8
    for (int i = 0; i < 32; ++i) { const int kk = 2 * i + (lane >> 5); scr[kk * 33 + (lane & 31)] = W[(size_t)(k0 + kk) * N + n0 + (lane & 31)]; }
    asm volatile("s_waitcnt lgkmcnt(0)" ::: "memory");
    const int c = lane & 7;
#pragma unroll
    for (int j = 0; j < 4; ++j) { const int n = (lane >> 3) + 8 * j; const LAS float* s = scr + (8 * c) * 33 + n;
        u32x4 o; o.x = pk2(s[0 * 33], s[1 * 33]); o.y = pk2(s[2 * 33], s[3 * 33]); o.z = pk2(s[4 * 33], s[5 * 33]); o.w = pk2(s[6 * 33], s[7 * 33]);
        *(u32x4*)(WT + (size_t)(row_off + n0 + n) * ldt + k0 + 8 * c) = o; }
    asm volatile("s_waitcnt lgkmcnt(0)" ::: "memory");
}
__device__ __forceinline__ void load_row(const float* p, int lane, f32x4 (&v)[8]) {
#pragma unroll
    for (int j = 0; j < 8; ++j) v[j] = *(const f32x4*)(p + 4 * (64 * j + lane));
}
__device__ __forceinline__ float row_ss(const f32x4 (&v)[8]) {
    float s = 0.f;
#pragma unroll
    for (int j = 0; j < 8; ++j) s += (v[j][0] * v[j][0] + v[j][1] * v[j][1]) + (v[j][2] * v[j][2] + v[j][3] * v[j][3]);
    return wave_sum(s);
}
__device__ __forceinline__ void store_row_bf16(bf16_t* p, int lane, const f32x4 (&v)[8]) {
#pragma unroll
    for (int j = 0; j < 8; ++j) { u32x2 w; w.x = pk2(v[j][0], v[j][1]); w.y = pk2(v[j][2], v[j][3]); *(u32x2*)(p + 4 * (64 * j + lane)) = w; }
}

__device__ __forceinline__ void rows16_phase(const Frame& F, const bf16_t* A16, int lda, const bf16_t* Bt, int ldb, int K, int ntasks, int a_grp_cols, int tasks_per_grp, const Epi& E) {
    const int lane = F.lane, m = lane & 15, fq = lane >> 4;
    LAS float* red = (LAS float*)F.lds;
    const int stride = F.G / ntasks > 0 ? F.G / ntasks : 1;
    for (int task0 = F.vcu; task0 < ntasks * stride; task0 += F.G) {
        if (task0 % stride) continue;
        const int task = task0 / stride;
        const int n0 = task * 32, kslice = K / 8, kb = F.wave * kslice;
        const bf16_t* ap = A16 + (size_t)m * lda + (task / tasks_per_grp) * a_grp_cols + kb + 8 * fq;
        const bf16_t* bp0 = Bt + (size_t)(n0 + 8 * (m >> 2) + (m & 3)) * ldb + kb + 8 * fq;
        const bf16_t* bp1 = bp0 + (size_t)4 * ldb;
        f32x4 acc0 = {0.f, 0.f, 0.f, 0.f}, acc1 = {0.f, 0.f, 0.f, 0.f};
        for (int ks = 0; ks < kslice; ks += 32) {
            const bf16x8 a = *(const bf16x8*)(ap + ks), b0 = *(const bf16x8*)(bp0 + ks), b1 = *(const bf16x8*)(bp1 + ks);
            acc0 = __builtin_amdgcn_mfma_f32_16x16x32_bf16(b0, a, acc0, 0, 0, 0);
            acc1 = __builtin_amdgcn_mfma_f32_16x16x32_bf16(b1, a, acc1, 0, 0, 0);
        }
        *(LAS f32x4*)(red + (F.wave * 2 + 0) * 256 + lane * 4) = acc0;
        *(LAS f32x4*)(red + (F.wave * 2 + 1) * 256 + lane * 4) = acc1;
        __syncthreads();
        if (F.wave == 0) {
            f32x4 s0 = {0.f, 0.f, 0.f, 0.f}, s1 = {0.f, 0.f, 0.f, 0.f};
#pragma unroll
            for (int w = 0; w < 8; ++w) { s0 += *(const LAS f32x4*)(red + (w * 2 + 0) * 256 + lane * 4); s1 += *(const LAS f32x4*)(red + (w * 2 + 1) * 256 + lane * 4); }
            E.emit_rt(MREAL + m, n0 + 8 * fq, s0, s1);
        }
        __syncthreads();
    }
}

namespace att {
__device__ __forceinline__ int crow(int r, int hi) { return (r & 3) + 8 * (r >> 2) + 4 * hi; }
__device__ __forceinline__ float xch32(float v) { return __shfl_xor(v, 32); }
constexpr float THRL = 6.0f;
template <int OFF> __device__ __forceinline__ s16x4 tr_read(int vb) {
    s16x4 r; asm volatile("ds_read_b64_tr_b16 %0, %1 offset:%2" : "=&v"(r) : "v"(vb), "i"(OFF) : "memory"); return r;
}
template <int D0> __device__ __forceinline__ void pv_one(f32x16& od, int vb, const u32x4 (&pw)[4]) {
    const s16x4 l0 = tr_read<(0 * 8 + D0) * 512>(vb), h0 = tr_read<(1 * 8 + D0) * 512>(vb), l1 = tr_read<(2 * 8 + D0) * 512>(vb), h1 = tr_read<(3 * 8 + D0) * 512>(vb);
    const s16x4 l2 = tr_read<(4 * 8 + D0) * 512>(vb), h2 = tr_read<(5 * 8 + D0) * 512>(vb), l3 = tr_read<(6 * 8 + D0) * 512>(vb), h3 = tr_read<(7 * 8 + D0) * 512>(vb);
    asm volatile("s_waitcnt lgkmcnt(0)" ::: "memory"); __builtin_amdgcn_sched_barrier(0);
#define ATT_PK(L, H) (bf16x8){L[0], L[1], L[2], L[3], H[0], H[1], H[2], H[3]}
    od = __builtin_amdgcn_mfma_f32_32x32x16_bf16(ATT_PK(l0, h0), __builtin_bit_cast(bf16x8, pw[0]), od, 0, 0, 0);
    od = __builtin_amdgcn_mfma_f32_32x32x16_bf16(ATT_PK(l1, h1), __builtin_bit_cast(bf16x8, pw[1]), od, 0, 0, 0);
    od = __builtin_amdgcn_mfma_f32_32x32x16_bf16(ATT_PK(l2, h2), __builtin_bit_cast(bf16x8, pw[2]), od, 0, 0, 0);
    od = __builtin_amdgcn_mfma_f32_32x32x16_bf16(ATT_PK(l3, h3), __builtin_bit_cast(bf16x8, pw[3]), od, 0, 0, 0);
#undef ATT_PK
}
__device__ __forceinline__ void attn_unit(const Frame& F, const bf16_t* Q, const unsigned char* Kimg, const unsigned char* Vimg, const bf16_t* Gt, bf16_t* O,
                                          const float* subln_g, int b, int h, int qb) {
    LAS unsigned char* lds = F.lds;
    int lane_o = threadIdx.x & 63; asm volatile("" : "+v"(lane_o));
    const int lane = lane_o, r32 = lane & 31, hi = lane >> 5, wid = F.wave, mp = wid >> 2, rg = wid & 3;
    const bool meta = qb < 0;
    const size_t qrow = meta ? (size_t)(MREAL + (r32 & 15)) : (size_t)b * SEQ + qb * 128 + rg * 32 + r32;
    const int NT = meta ? 1 : 2 * qb + 3;
    const int tmax = meta ? 0 : 2 * qb + 1 + (rg >> 1);
    bf16x8 qr[8];
    { const bf16_t* qp = Q + qrow * DM + h * 256 + mp * 128 + hi * 8;
#pragma unroll
      for (int d0 = 0; d0 < 8; ++d0) qr[d0] = *(const bf16x8*)(qp + 16 * d0); }
    const int bsel = meta ? 0 : b;
    const unsigned char* src; size_t tstride;
    if (wid < 2)      { src = Kimg + ((size_t)((bsel * NH + h) * 2 + 0) * NTILE) * KTILE_B + wid * 8192; tstride = KTILE_B; }
    else if (wid < 4) { src = Kimg + ((size_t)((bsel * NH + h) * 2 + 1) * NTILE) * KTILE_B + (wid - 2) * 8192; tstride = KTILE_B; }
    else              { src = Vimg + ((size_t)(bsel * NH + h) * NTILE) * VTILE_B + (wid - 4) * 8192; tstride = VTILE_B; }
    src += lane * 16;
#define ATT_DMA(t, st) do { _Pragma("unroll") for (int _i = 0; _i < 8; ++_i) \
        __builtin_amdgcn_global_load_lds((const unsigned*)(src + (size_t)(t) * tstride + _i * 1024), (LAS unsigned*)(lds + (st) * 65536 + wid * 8192 + _i * 1024), 16, 0, 0); } while (0)
    f32x16 o[8];
#pragma unroll
    for (int d = 0; d < 8; ++d) o[d] = (f32x16){0.f, 0.f, 0.f, 0.f, 0.f, 0.f, 0.f, 0.f, 0.f, 0.f, 0.f, 0.f, 0.f, 0.f, 0.f, 0.f};
    float m_run = -1e30f, l_run = 0.f;
    const int vbase = (4 * hi + ((lane & 15) >> 2)) * 64 + ((lane >> 4) & 1) * 32 + (lane & 3) * 8;
    ATT_DMA(0, 0);
    for (int t = 0; t < NT; ++t) {
        asm volatile("s_waitcnt vmcnt(0)" ::: "memory"); __builtin_amdgcn_s_barrier(); asm volatile("" ::: "memory");
        if (t + 1 < NT) ATT_DMA(t + 1, (t + 1) & 1);
        if (t <= tmax) {
            const LAS unsigned char* Kst = lds + (t & 1) * 65536 + mp * KTILE_B + hi * 1024 + r32 * 16;
            const LAS unsigned char* Vst = lds + (t & 1) * 65536 + 32768 + vbase;
            f32x16 p0 = (f32x16){0.f, 0.f, 0.f, 0.f, 0.f, 0.f, 0.f, 0.f, 0.f, 0.f, 0.f, 0.f, 0.f, 0.f, 0.f, 0.f}, p1 = p0;
#pragma unroll
            for (int d0 = 0; d0 < 8; ++d0) {
                const bf16x8 a0 = *(const LAS bf16x8*)(Kst + d0 * 2048), a1 = *(const LAS bf16x8*)(Kst + d0 * 2048 + 512);
                p0 = __builtin_amdgcn_mfma_f32_32x32x16_bf16(a0, qr[d0], p0, 0, 0, 0);
                p1 = __builtin_amdgcn_mfma_f32_32x32x16_bf16(a1, qr[d0], p1, 0, 0, 0);
            }
            if (t == 0) {
#pragma unroll
                for (int r = 8; r < 16; ++r) p0[r] = -INFINITY;
#pragma unroll
                for (int r = 0; r < 16; ++r) p1[r] = -INFINITY;
            }
            float rm = p0[0];
#pragma unroll
            for (int r = 1; r < 16; ++r) rm = fmaxf(rm, p0[r]);
#pragma unroll
            for (int r = 0; r < 16; ++r) rm = fmaxf(rm, p1[r]);
            rm = fmaxf(rm, xch32(rm));
            if (__any(rm > m_run + THRL)) {
                const float mn = fmaxf(m_run, rm), alpha = __builtin_amdgcn_exp2f(m_run - mn);
                m_run = mn; l_run *= alpha;
#pragma unroll
                for (int d = 0; d < 8; ++d)
#pragma unroll
                    for (int r = 0; r < 16; ++r) o[d][r] *= alpha;
            }
            float ps = 0.f;
#pragma unroll
            for (int r = 0; r < 16; ++r) { p0[r] = __builtin_amdgcn_exp2f(p0[r] - m_run); ps += p0[r]; }
#pragma unroll
            for (int r = 0; r < 16; ++r) { p1[r] = __builtin_amdgcn_exp2f(p1[r] - m_run); ps += p1[r]; }
            l_run += ps;
            u32x4 pw[4];
            pw[0] = (u32x4){pk2(p0[0], p0[1]), pk2(p0[2], p0[3]), pk2(p0[4], p0[5]), pk2(p0[6], p0[7])};
            pw[1] = (u32x4){pk2(p0[8], p0[9]), pk2(p0[10], p0[11]), pk2(p0[12], p0[13]), pk2(p0[14], p0[15])};
            pw[2] = (u32x4){pk2(p1[0], p1[1]), pk2(p1[2], p1[3]), pk2(p1[4], p1[5]), pk2(p1[6], p1[7])};
            pw[3] = (u32x4){pk2(p1[8], p1[9]), pk2(p1[10], p1[11]), pk2(p1[12], p1[13]), pk2(p1[14], p1[15])};
            const int vb = (int)(unsigned)(uintptr_t)Vst;
            pv_one<0>(o[0], vb, pw); pv_one<1>(o[1], vb, pw); pv_one<2>(o[2], vb, pw); pv_one<3>(o[3], vb, pw);
            pv_one<4>(o[4], vb, pw); pv_one<5>(o[5], vb, pw); pv_one<6>(o[6], vb, pw); pv_one<7>(o[7], vb, pw);
        }
    }
    asm volatile("s_waitcnt vmcnt(0) lgkmcnt(0)" ::: "memory"); __builtin_amdgcn_s_barrier(); asm volatile("" ::: "memory");
    const float ltot = l_run + xch32(l_run);
    const float inv = __builtin_amdgcn_rcpf(ltot);
    LAS float* xb = (LAS float*)lds + (size_t)rg * 8192;
    if (mp == 1) {
        const float sc = *(const LAS float*)(lds + MISC_OFF + 64) * inv;
#pragma unroll
        for (int d = 0; d < 8; ++d) {
#pragma unroll
            for (int r = 0; r < 16; ++r) xb[(d * 16 + r) * 64 + lane] = o[d][r] * sc;
            asm volatile("" ::: "memory"); }
    }
    asm volatile("s_waitcnt lgkmcnt(0)" ::: "memory"); __builtin_amdgcn_s_barrier(); asm volatile("" ::: "memory");
    if (mp == 0) {
        float ss = 0.f;
#pragma unroll
        for (int d = 0; d < 8; ++d) {
#pragma unroll
            for (int r = 0; r < 16; ++r) { const float v = o[d][r] * inv - xb[(d * 16 + r) * 64 + lane]; o[d][r] = v; ss = fmaf(v, v, ss); }
            asm volatile("" : "+v"(ss) :: "memory"); }
        ss += xch32(ss);
        const float rstd = __builtin_amdgcn_rsqf(ss * (1.0f / 256.0f) + RMS_EPS) * 0.8f;
        const bool valid = !meta || r32 < 16;
        const bf16_t* gp = Gt + qrow * DM + h * 256; bf16_t* op = O + qrow * DM + h * 256;
#pragma unroll
        for (int d = 0; d < 8; ++d)
#pragma unroll
            for (int rq = 0; rq < 4; ++rq) {
                const int dd = 32 * d + 8 * rq + 4 * hi;
                const u32x2 g = *(const u32x2*)(gp + dd); const f32x4 sg = *(const f32x4*)(subln_g + dd);
                const float v0 = o[d][4 * rq + 0] * rstd * sg[0] * bflo(g.x), v1 = o[d][4 * rq + 1] * rstd * sg[1] * bfhi(g.x);
                const float v2 = o[d][4 * rq + 2] * rstd * sg[2] * bflo(g.y), v3 = o[d][4 * rq + 3] * rstd * sg[3] * bfhi(g.y);
                u32x2 w; w.x = pk2(v0, v1); w.y = pk2(v2, v3);
                if (valid) *(u32x2*)(op + dd) = w;
                asm volatile("" ::: "memory");
            }
    }
    asm volatile("s_waitcnt lgkmcnt(0)" ::: "memory"); __builtin_amdgcn_s_barrier(); asm volatile("" ::: "memory");
#undef ATT_DMA
}
}

__global__ void __launch_bounds__(512, 2) trunk_fwd(Args args) {
    extern __shared__ __attribute__((aligned(16))) unsigned char lds_raw[];
    Frame F;
    F.lds = (LAS unsigned char*)lds_raw;
    F.tid = threadIdx.x; F.lane = F.tid & 63; F.wave = __builtin_amdgcn_readfirstlane(F.tid >> 6);
    F.G = gridDim.x; { const int bx = blockIdx.x; F.vcu = (F.G % 8 == 0) ? (bx % 8) * (F.G / 8) + bx / 8 : bx; }
    volatile LAS unsigned* MISC = (volatile LAS unsigned*)(F.lds + MISC_OFF);
    unsigned char* ws = args.ws;
    gu32* ctl = (gu32*)(ws + WS_CTL);
    for (int u = F.tid; u < (LDS_BYTES - LDSCTL_OFF) / 4; u += 512) ((LAS unsigned*)(F.lds + LDSCTL_OFF))[u] = 0u;
    __syncthreads();
    XcdBarrier bar; bar.bar = (unsigned*)(ctl + CW_BAR); bar.x = 0; bar.st = nullptr;
    if (MK_N_LAUNCHES == 1) bar = xcd_barrier_post((unsigned*)(ctl + CW_BAR), MISC + 8);
#define GRID_BAR() do { if (MK_N_LAUNCHES == 1) xcd_barrier(bar); } while (0)
    const int lo = args.ph_lo, hi = args.ph_hi;
#define IN(k) (lo <= (k) && (k) < hi)

    const float* x = args.in[0]; const float* meta_tok = args.in[1]; const float* pre_g = args.in[2]; const float* post_g = args.in[3];
    const float* attn_w_in = args.in[4]; const float* attn_w_out = args.in[5];
    const float* lq1 = args.in[6]; const float* lk1 = args.in[7]; const float* lq2 = args.in[8]; const float* lk2 = args.in[9];
    const float* subln_g = args.in[10];
    const float* pool_w_in = args.in[11]; const float* pool_w_group = args.in[12]; const float* pool_scale = args.in[13]; const float* pool_w_out = args.in[14];
    bf16_t* W1 = (bf16_t*)(ws + WS_W1); bf16_t* W2 = (bf16_t*)(ws + WS_W2); bf16_t* W3 = (bf16_t*)(ws + WS_W3); bf16_t* W4 = (bf16_t*)(ws + WS_W4); bf16_t* W5 = (bf16_t*)(ws + WS_W5);
    bf16_t* XN = (bf16_t*)(ws + WS_XN); bf16_t* GB = (bf16_t*)(ws + WS_G); bf16_t* QO = (bf16_t*)(ws + WS_QO);
    unsigned char* Kimg = ws + WS_K; unsigned char* Vimg = ws + WS_V;
    float* Y0 = (float*)(ws + WS_Y0); float* Y1 = (float*)(ws + WS_Y1);
    bf16_t* UB = (bf16_t*)(ws + WS_U); bf16_t* G1 = (bf16_t*)(ws + WS_G1); bf16_t* MIX = (bf16_t*)(ws + WS_MIX); bf16_t* GATED1 = (bf16_t*)(ws + WS_GATED1);
    float* ropec = (float*)(ws + WS_ROPEC); float* ropes = (float*)(ws + WS_ROPES); float* rstd0 = (float*)(ws + WS_RSTD0);
    const int gw = F.vcu * 8 + F.wave, NGW = F.G * 8;
    const int gtid = F.vcu * 512 + F.tid, NGT = F.G * 512;

    Epi E; E.mode = 0; E.Q = QO; E.Kimg = Kimg; E.Vimg = Vimg; E.G = GB; E.ropec = ropec; E.ropes = ropes; E.Y = Y0; E.U = UB; E.G1 = G1; E.GATED1 = GATED1; E.pool_scale = pool_scale;

    if (IN(0)) {
        LAS float* scr = (LAS float*)(F.lds + F.wave * 16384);
        constexpr int I1 = (DM / 64) * (4 * DM / 32), I2 = (DM / 64) * (DM / 32), I3 = (DM / 64) * (2 * DM / 32), I4 = (512 / 64) * (512 / 32), I5 = I2;
        constexpr int NITEMS = I1 + I2 + I3 + 4 * I4 + I5;
        for (int it = gw; it < NITEMS; it += NGW) {
            int r = it;
            if (r < I1) { p0_transpose_item(attn_w_in, 4 * DM, W1, DM, 0, scr, r, F.lane); continue; } r -= I1;
            if (r < I2) { p0_transpose_item(attn_w_out, DM, W2, DM, 0, scr, r, F.lane); continue; } r -= I2;
            if (r < I3) { p0_transpose_item(pool_w_in, 2 * DM, W3, DM, 0, scr, r, F.lane); continue; } r -= I3;
            if (r < 4 * I4) { const int g = r / I4; p0_transpose_item(pool_w_group + (size_t)g * 512 * 512, 512, W4, 512, g * 512, scr, r % I4, F.lane); continue; } r -= 4 * I4;
            p0_transpose_item(pool_w_out, DM, W5, DM, 0, scr, r, F.lane);
        }
        for (int i = gtid; i < LTOT * 16; i += NGT) {
            const int pos = i >> 4, k = i & 15; const float ang = (float)pos * args.inv_freq[k];
            double rev = (double)ang * 0.15915494309189535; rev -= floor(rev);
            const float fr = (float)rev; ropec[i] = __builtin_amdgcn_cosf(fr); ropes[i] = __builtin_amdgcn_sinf(fr);
        }
        for (int m = gw; m < MROWS; m += NGW) {
            const float* src = m < MREAL ? x + (size_t)m * DM : meta_tok + (size_t)(m - MREAL) * DM;
            f32x4 v[8]; load_row(src, F.lane, v);
            const float rstd = __builtin_amdgcn_rsqf(row_ss(v) * (1.0f / DM) + RMS_EPS);
#pragma unroll
            for (int j = 0; j < 8; ++j) v[j] = v[j] * rstd * *(const f32x4*)(pre_g + 4 * (64 * j + F.lane));
            store_row_bf16(XN + (size_t)m * DM, F.lane, v);
        }
        const u32x4 z = {0u, 0u, 0u, 0u};
        for (int i = gtid; i < NB * NH * 2 * 1024; i += NGT) *(u32x4*)(Kimg + (size_t)(i >> 10) * NTILE * KTILE_B + (i & 1023) * 16) = z;
        for (int i = gtid; i < NB * NH * 2048; i += NGT) *(u32x4*)(Vimg + (size_t)(i >> 11) * NTILE * VTILE_B + (i & 2047) * 16) = z;
        GRID_BAR();
    }
    if (IN(1)) {
        E.mode = 1;
        rows16_phase(F, XN + (size_t)MREAL * DM, DM, W1, DM, DM, 4 * DM / 32, 0, 1 << 30, E);
        pg8::Gemm g{XN, W1, MREAL, 4 * DM, DM, DM, DM, 1 << 30, 0}; pg8::StaticOrder S; S.init(MREAL, 4 * DM, F.G, (int)blockIdx.x);
        pg8::gemm_phase<true>(F.lds, g, S, E);
        GRID_BAR();
    }
    if (IN(2)) {
        float d1 = 0.f, d2 = 0.f;
#pragma unroll
        for (int j = 0; j < 2; ++j) { d1 += lq1[F.lane + 64 * j] * lk1[F.lane + 64 * j]; d2 += lq2[F.lane + 64 * j] * lk2[F.lane + 64 * j]; }
        const float lam = expf(wave_sum(d1)) - expf(wave_sum(d2)) + 0.2f;
        if (F.tid == 0) *(LAS float*)(F.lds + MISC_OFF + 64) = lam;
        __syncthreads();
        for (int u = F.vcu; u < 520; u += F.G) {
            int bh, qb;
            if (u < 256) { bh = u >> 4; qb = u & 15; } else if (u < 512) { bh = (u - 256) >> 4; qb = 31 - ((u - 256) & 15); } else { bh = u - 512; qb = -1; }
            att::attn_unit(F, QO, Kimg, Vimg, GB, QO, subln_g, bh >> 3, bh & 7, qb);
        }
        GRID_BAR();
    }
    if (IN(3)) {
        E.mode = 2; E.Y = Y0;
        rows16_phase(F, QO + (size_t)MREAL * DM, DM, W2, DM, DM, DM / 32, 0, 1 << 30, E);
        pg8::Gemm g{QO, W2, MREAL, DM, DM, DM, DM, 1 << 30, 0}; pg8::StaticOrder S; S.init(MREAL, DM, F.G, (int)blockIdx.x);
        pg8::gemm_phase<true>(F.lds, g, S, E);
        GRID_BAR();
    }
    if (IN(4)) {
        for (int m = gw; m < MROWS; m += NGW) {
            f32x4 y[8], hrow[8]; load_row(Y0 + (size_t)m * DM, F.lane, y);
            load_row(m < MREAL ? x + (size_t)m * DM : meta_tok + (size_t)(m - MREAL) * DM, F.lane, hrow);
            const float r0 = __builtin_amdgcn_rsqf(row_ss(y) * (1.0f / DM) + RMS_EPS);
            if (F.lane == 0) rstd0[m] = r0;
#pragma unroll
            for (int j = 0; j < 8; ++j) hrow[j] = hrow[j] + y[j] * r0 * *(const f32x4*)(post_g + 4 * (64 * j + F.lane));
            const float r1 = __builtin_amdgcn_rsqf(row_ss(hrow) * (1.0f / DM) + RMS_EPS);
#pragma unroll
            for (int j = 0; j < 8; ++j) hrow[j] = hrow[j] * r1 * *(const f32x4*)(pre_g + DM + 4 * (64 * j + F.lane));
            store_row_bf16(XN + (size_t)m * DM, F.lane, hrow);
        }
        GRID_BAR();
    }
    if (IN(5)) {
        E.mode = 3;
        rows16_phase(F, XN + (size_t)MREAL * DM, DM, W3, DM, DM, DM / 32, 0, 1 << 30, E);
        pg8::Gemm g{XN, W3, MREAL, 2 * DM, DM, DM, DM, 1 << 30, 0}; pg8::StaticOrder S; S.init(MREAL, 2 * DM, F.G, (int)blockIdx.x);
        pg8::gemm_phase<true>(F.lds, g, S, E);
        GRID_BAR();
    }
    if (IN(6)) {
        for (int idx = gtid; idx < MREAL * 256; idx += NGT) {
            const int row = idx >> 8, c0 = (idx & 255) * 8, gi = c0 >> 9, w = 2 << gi;
            const int bb = row >> 12, p = NMETA + (row & (SEQ - 1));
            float s[8] = {0.f, 0.f, 0.f, 0.f, 0.f, 0.f, 0.f, 0.f}, self[8];
            for (int i = 0; i < w; ++i) {
                const int pp = p - i; const int r = pp >= NMETA ? bb * SEQ + pp - NMETA : MREAL + pp;
                const u32x4 v = *(const u32x4*)(UB + (size_t)r * DM + c0);
                const float f[8] = {bflo(v.x), bfhi(v.x), bflo(v.y), bfhi(v.y), bflo(v.z), bfhi(v.z), bflo(v.w), bfhi(v.w)};
#pragma unroll
                for (int k = 0; k < 8; ++k) { s[k] += f[k]; if (i == 0) self[k] = f[k]; }
            }
            const float iw = 1.0f / (float)w;
            u32x4 o; o.x = pk2(s[0] * iw - self[0], s[1] * iw - self[1]); o.y = pk2(s[2] * iw - self[2], s[3] * iw - self[3]);
            o.z = pk2(s[4] * iw - self[4], s[5] * iw - self[5]); o.w = pk2(s[6] * iw - self[6], s[7] * iw - self[7]);
            *(u32x4*)(MIX + (size_t)row * DM + c0) = o;
        }
        GRID_BAR();
    }
    if (IN(7)) {
        E.mode = 4;
        pg8::Gemm g{MIX, W4, MREAL, DM, 512, DM, 512, 2, 512}; pg8::StaticOrder S; S.init(MREAL, DM, F.G, (int)blockIdx.x);
        pg8::gemm_phase<true>(F.lds, g, S, E);
        GRID_BAR();
    }
    if (IN(8)) {
        E.mode = 5; E.Y = Y1;
        pg8::Gemm g{GATED1, W5, MREAL, DM, DM, DM, DM, 1 << 30, 0}; pg8::StaticOrder S; S.init(MREAL, DM, F.G, (int)blockIdx.x);
        pg8::gemm_phase<true>(F.lds, g, S, E);
        GRID_BAR();
    }
    if (IN(9)) {
        for (int m = gw; m < MREAL; m += NGW) {
            f32x4 y1[8], acc[8]; load_row(Y1 + (size_t)m * DM, F.lane, y1); load_row(x + (size_t)m * DM, F.lane, acc);
            const float r0 = rstd0[m];
            const float r1 = __builtin_amdgcn_rsqf(row_ss(y1) * (1.0f / DM) + RMS_EPS);
#pragma unroll
            for (int j = 0; j < 8; ++j) {
                const int e = 4 * (64 * j + F.lane);
                const f32x4 y0 = *(const f32x4*)(Y0 + (size_t)m * DM + e);
                acc[j] = acc[j] + y0 * r0 * *(const f32x4*)(post_g + e) + y1[j] * r1 * *(const f32x4*)(post_g + DM + e);
                *(f32x4*)(args.out + (size_t)m * DM + e) = acc[j];
            }
        }
    }
#undef IN
#undef GRID_BAR
}

extern "C" void kernel_launch(void* const* d_in, const int* in_sizes, int n_in, void* d_out, int out_size, void* d_ws, size_t ws_size, hipStream_t stream) {
    static int grid = 0;
    if (grid == 0) {
        if (n_in != 15 || in_sizes[0] != NB * SEQ * DM || out_size != NB * SEQ * DM || ws_size < WS_END) {
            fprintf(stderr, "kernel_launch: unexpected shapes (n_in %d, in0 %d, out %d, ws %zu)\n", n_in, n_in > 0 ? in_sizes[0] : -1, out_size, ws_size); grid = -1; return; }
        int dev = 0, cus = 0, per_cu = 0;
        if (hipGetDevice(&dev) != hipSuccess || hipDeviceGetAttribute(&cus, hipDeviceAttributeMultiprocessorCount, dev) != hipSuccess) { grid = -1; return; }
        if (hipFuncSetAttribute((const void*)trunk_fwd, hipFuncAttributeMaxDynamicSharedMemorySize, LDS_BYTES) != hipSuccess) { fprintf(stderr, "kernel_launch: hipFuncSetAttribute failed\n"); grid = -1; return; }
        if (hipOccupancyMaxActiveBlocksPerMultiprocessor(&per_cu, (const void*)trunk_fwd, 512, LDS_BYTES) != hipSuccess || per_cu < 1) {
            fprintf(stderr, "kernel_launch: occupancy query reports %d workgroups per CU\n", per_cu); (void)hipGetLastError(); grid = -1; return; }
        grid = cus;
    }
    if (grid < 0) return;
    (void)hipMemsetAsync((char*)d_ws + WS_CTL, 0, CTL_ZERO_BYTES, stream);
    Args a{};
    for (int i = 0; i < 15; ++i) a.in[i] = (const float*)d_in[i];
    a.out = (float*)d_out; a.ws = (unsigned char*)d_ws;
    for (int i = 0; i < 16; ++i) a.inv_freq[i] = (float)pow(500000.0, -(double)i / 16.0);
#if MK_N_LAUNCHES == 1
    a.ph_lo = 0; a.ph_hi = 10; a.li = 0;
    hipLaunchKernelGGL(trunk_fwd, dim3(grid), dim3(512), LDS_BYTES, stream, a);
#else
    for (int p = 0; p < 10; ++p) { a.ph_lo = p; a.ph_hi = p + 1; a.li = p; hipLaunchKernelGGL(trunk_fwd, dim3(grid), dim3(512), LDS_BYTES, stream, a); }
#endif
    const hipError_t le = hipPeekAtLastError();
    if (le != hipSuccess) fprintf(stderr, "kernel_launch: launch failed: %s\n", hipGetErrorName(le));
}
```

```cpp
#include <hip/hip_runtime.h>
#include <cstdio>
#include <cstdint>
#include <cmath>

#ifndef MK_N_LAUNCHES
#define MK_N_LAUNCHES 1
#endif
#ifndef PROBE_PH
#define PROBE_PH (-1)
#endif
#ifndef PROBE_REP
#define PROBE_REP 0
#endif

#define LAS __attribute__((address_space(3)))
#define GAS __attribute__((address_space(1)))
typedef unsigned short bf16_t;
typedef short bf16x8 __attribute__((ext_vector_type(8)));
typedef short s16x4 __attribute__((ext_vector_type(4)));
typedef float f32x4 __attribute__((ext_vector_type(4)));
typedef float f32x16 __attribute__((ext_vector_type(16)));
typedef unsigned u32x4 __attribute__((ext_vector_type(4)));
typedef unsigned u32x2 __attribute__((ext_vector_type(2)));

constexpr int DM = 2048, SEQ = 4096, NB = 2, NMETA = 16, LTOT = SEQ + NMETA;
constexpr int MREAL = NB * SEQ;
constexpr int MROWS = MREAL + NMETA;
constexpr int NH = 8, HD = 128, VD = 256;
constexpr int NTILE = 65;
constexpr int KTILE_B = 64 * 128 * 2, VTILE_B = 64 * 256 * 2;
constexpr float RMS_EPS = 1e-6f;
constexpr float C2 = 0.08838834764831845f * 1.4426950408889634f;
constexpr float LOG2E = 1.4426950408889634f;

constexpr size_t MiB = 1u << 20;
constexpr size_t WS_CTL = 0, CTL_ZERO_BYTES = 65536;
constexpr size_t WS_ROPEC = 1 * MiB, WS_ROPES = 1 * MiB + 512 * 1024;
constexpr size_t WS_RSTD0 = 2 * MiB;
constexpr size_t WS_W1 = 4 * MiB, WS_W2 = 36 * MiB, WS_W3 = 44 * MiB, WS_W4 = 60 * MiB, WS_W5 = 62 * MiB;
constexpr size_t WS_XN = 70 * MiB, WS_G = 104 * MiB, WS_QO = 138 * MiB, WS_K = 172 * MiB;
constexpr size_t KIMG_BYTES = (size_t)NB * NH * 2 * NTILE * KTILE_B, VIMG_BYTES = (size_t)NB * NH * NTILE * VTILE_B;
constexpr size_t WS_V = WS_K + KIMG_BYTES;
constexpr size_t WS_Y0 = WS_K;
constexpr size_t WS_U = WS_QO, WS_G1 = WS_G, WS_MIX = WS_XN, WS_GATED1 = WS_QO, WS_Y1 = WS_XN;
constexpr size_t WS_END = WS_V + VIMG_BYTES;
static_assert(WS_END <= 240 * MiB && WS_Y0 + (size_t)MROWS * DM * 2 <= WS_END && WS_Y1 + (size_t)MROWS * DM * 2 <= WS_G, "ws map");
constexpr int CW_BAR = 4096;

constexpr int RING_BYTES = 131072, LDSCTL_OFF = RING_BYTES, MISC_OFF = LDSCTL_OFF + 320, LDS_BYTES = 147456;

__device__ __forceinline__ unsigned pk2(float lo, float hi) {
    typedef float f2_t __attribute__((ext_vector_type(2))); typedef __bf16 b2_t __attribute__((ext_vector_type(2)));
    f2_t v = {lo, hi}; b2_t b = __builtin_convertvector(v, b2_t); return __builtin_bit_cast(unsigned, b);
}
__device__ __forceinline__ float bflo(unsigned u) { return __uint_as_float(u << 16); }
__device__ __forceinline__ float bfhi(unsigned u) { return __uint_as_float(u & 0xffff0000u); }
__device__ __forceinline__ float siluf(float x) { return x * __builtin_amdgcn_rcpf(1.0f + __builtin_amdgcn_exp2f(-x * LOG2E)); }
__device__ __forceinline__ float wave_sum(float v) {
#pragma unroll
    for (int o = 1; o < 64; o <<= 1) v += __shfl_xor(v, o);
    return v;
}
__device__ __forceinline__ u32x4 pack8(f32x4 a, f32x4 b) { u32x4 w; w.x = pk2(a[0], a[1]); w.y = pk2(a[2], a[3]); w.z = pk2(b[0], b[1]); w.w = pk2(b[2], b[3]); return w; }

struct Epi {
    int mode;
    bf16_t* Q; unsigned char* Kimg; unsigned char* Vimg; bf16_t* G; const float* ropec; const float* ropes;
    bf16_t* Y;
    bf16_t* U; bf16_t* G1;
    bf16_t* GATED1; const float* pool_scale;
    template <int MODE> __device__ __forceinline__ void emit(int row, int col, f32x4 a, f32x4 b) const {
        if constexpr (MODE == 1) {
            if (col < 4096) {
                const int c = col & 2047, dim = c & 127;
                if (dim < 32) {
                    f32x4 pa, pb;
#pragma unroll
                    for (int i = 0; i < 4; ++i) { pa[i] = __shfl_xor(a[i], 32); pb[i] = __shfl_xor(b[i], 32); }
                    const int pos = row < MREAL ? NMETA + (row & (SEQ - 1)) : row - MREAL;
                    const float* cs = ropec + pos * 16 + (dim & 15); const float* sn = ropes + pos * 16 + (dim & 15);
                    const f32x4 c0 = *(const f32x4*)cs, c1 = *(const f32x4*)(cs + 4), s0 = *(const f32x4*)sn, s1 = *(const f32x4*)(sn + 4);
                    if (dim < 16) { a = a * c0 - pa * s0; b = b * c1 - pb * s1; } else { a = a * c0 + pa * s0; b = b * c1 + pb * s1; }
                }
                if (col < 2048) { a = a * C2; b = b * C2; *(u32x4*)(Q + (size_t)row * DM + c) = pack8(a, b); }
                else {
                    const int h = c >> 8, mp = (c >> 7) & 1; const u32x4 w = pack8(a, b);
                    const size_t inner = (size_t)(dim >> 3) * 1024;
                    if (row < MREAL) { const int bb = row >> 12, j = row & (SEQ - 1), tile = 1 + (j >> 6), key = j & 63;
                        *(u32x4*)(Kimg + ((size_t)((bb * NH + h) * 2 + mp) * NTILE + tile) * KTILE_B + inner + key * 16) = w; }
                    else { const int key = row - MREAL;
#pragma unroll
                        for (int bb = 0; bb < NB; ++bb) *(u32x4*)(Kimg + ((size_t)((bb * NH + h) * 2 + mp) * NTILE) * KTILE_B + inner + key * 16) = w; }
                }
            } else if (col < 6144) {
                const int c = col - 4096, h = c >> 8, d = c & 255; const u32x4 w = pack8(a, b);
                if (row < MREAL) { const int bb = row >> 12, j = row & (SEQ - 1), tile = 1 + (j >> 6), key = j & 63;
                    *(u32x4*)(Vimg + ((size_t)(bb * NH + h) * NTILE + tile) * VTILE_B + ((key >> 3) * 8 + (d >> 5)) * 512 + (key & 7) * 64 + (d & 31) * 2) = w; }
                else { const int key = row - MREAL;
#pragma unroll
                    for (int bb = 0; bb < NB; ++bb) *(u32x4*)(Vimg + ((size_t)(bb * NH + h) * NTILE) * VTILE_B + ((key >> 3) * 8 + (d >> 5)) * 512 + (key & 7) * 64 + (d & 31) * 2) = w; }
            } else {
                const int c = col - 6144;
#pragma unroll
                for (int i = 0; i < 4; ++i) { a[i] = siluf(a[i]); b[i] = siluf(b[i]); }
                *(u32x4*)(G + (size_t)row * DM + c) = pack8(a, b);
            }
        } else if constexpr (MODE == 2 || MODE == 5) {
            *(u32x4*)(Y + (size_t)row * DM + col) = pack8(a, b);
        } else if constexpr (MODE == 3) {
            if (col < 2048) { *(u32x4*)(U + (size_t)row * DM + col) = pack8(a, b); }
            else { const int c = col - 2048;
#pragma unroll
                for (int i = 0; i < 4; ++i) { a[i] = siluf(a[i]); b[i] = siluf(b[i]); }
                *(u32x4*)(G1 + (size_t)row * DM + c) = pack8(a, b); }
        } else {
            const f32x4 s0 = *(const f32x4*)(pool_scale + col), s1 = *(const f32x4*)(pool_scale + col + 4);
            const u32x4 g = *(const u32x4*)(G1 + (size_t)row * DM + col);
            a[0] *= s0[0] * bflo(g.x); a[1] *= s0[1] * bfhi(g.x); a[2] *= s0[2] * bflo(g.y); a[3] *= s0[3] * bfhi(g.y);
            b[0] *= s1[0] * bflo(g.z); b[1] *= s1[1] * bfhi(g.z); b[2] *= s1[2] * bflo(g.w); b[3] *= s1[3] * bfhi(g.w);
            *(u32x4*)(GATED1 + (size_t)row * DM + col) = pack8(a, b);
        }
    }
    __device__ __forceinline__ void emit_rt(int row, int col, f32x4 a, f32x4 b) const {
        if (mode == 1) emit<1>(row, col, a, b); else if (mode == 2 || mode == 5) emit<2>(row, col, a, b); else if (mode == 3) emit<3>(row, col, a, b); else emit<4>(row, col, a, b);
    }
};

namespace pg8 {
constexpr int BM = 256, BK = 64, HALF = 128, HTB = HALF * BK * 2, STAGE_BYTES = 8 * HTB, NXCD = 8, WGM = 8;
__host__ __device__ __forceinline__ int lds_byte(int r, int c) { const int st = (r >> 4) * 2 + (c >> 5), rr = r & 15, cc = c & 31, ob = rr * 64 + cc * 2; return st * 1024 + (ob ^ (((ob >> 9) & 1) << 5)); }
__host__ __device__ __forceinline__ void stage_rc(int b, int& R, int& C) { const int st = b / 1024, sb = b % 1024, swz = sb ^ (((sb >> 9) & 1) << 5); R = (st >> 1) * 16 + swz / 64; C = (st & 1) * 32 + (swz % 64) / 2; }
__host__ __device__ __forceinline__ int perm32(int rho) { const int n = rho >> 4, i = rho & 15; return 8 * (i >> 2) + 4 * n + (i & 3); }
struct Unit { int pm, pn; };
struct Gemm { const bf16_t* A; const bf16_t* Bt; int M, N, K, lda, ldb, pn_per_grp, a_grp_cols; };
struct StaticOrder {
    int nM, nN, nwg, G, c;
    __device__ void init(int M, int N, int G_, int c_) { nM = M / BM; nN = N / BM; nwg = nM * nN; G = G_; c = c_; }
    __device__ bool next(int i, Unit& u) const {
        const long L = (long)i * G + c; if (L >= nwg) return false;
        int wgid = (int)L; { const int q = nwg / NXCD, r = nwg % NXCD, xcd = wgid % NXCD, off = wgid / NXCD; wgid = (xcd < r ? xcd * (q + 1) : r * (q + 1) + (xcd - r) * q) + off; }
        const int nig = WGM * nN, gid = wgid / nig, fm = gid * WGM, gsz = (nM - fm) < WGM ? (nM - fm) : WGM;
        u.pm = fm + ((wgid % nig) % gsz); u.pn = (wgid % nig) / gsz; return true;
    }
};
template <int MODE>
__device__ __forceinline__ void run_epi_m(const Epi& E, const f32x4 (&acc)[2][2][4][2], const Unit& u, int wr, int wc) {
    int lane = threadIdx.x & 63; asm volatile("" : "+v"(lane));
    const int fr = lane & 15, fq = lane >> 4;
#pragma unroll
    for (int ai = 0; ai < 2; ++ai)
#pragma unroll
        for (int m = 0; m < 4; ++m) { const int row = u.pm * BM + ai * HALF + wr * 64 + m * 16 + fr;
#pragma unroll
            for (int bj = 0; bj < 2; ++bj) { const int col = u.pn * BM + bj * HALF + wc * 32 + 8 * fq; E.emit<MODE>(row, col, acc[ai][bj][m][0], acc[ai][bj][m][1]); asm volatile("" ::: "memory"); } }
}
__device__ __forceinline__ void run_epi(const Epi& E, const f32x4 (&acc)[2][2][4][2], const Unit& u, int wr, int wc, int fr, int fq) {
    if (E.mode == 1) run_epi_m<1>(E, acc, u, wr, wc); else if (E.mode == 2 || E.mode == 5) run_epi_m<2>(E, acc, u, wr, wc);
    else if (E.mode == 3) run_epi_m<3>(E, acc, u, wr, wc); else run_epi_m<4>(E, acc, u, wr, wc);
}
template <bool ALIGN_EPI>
__device__ __forceinline__ void gemm_phase(LAS unsigned char* lds, const Gemm g, const StaticOrder& S, const Epi& E) {
    int tid_o = threadIdx.x; asm volatile("" : "+v"(tid_o));
    const int tid = tid_o, wid = __builtin_amdgcn_readfirstlane(tid >> 6), lane = tid & 63, wr = wid >> 2, wc = wid & 3, fr = lane & 15, fq = lane >> 4;
    const int K = g.K, nt = K / BK;
    unsigned voffA[2], voffB[2];
#pragma unroll
    for (int i = 0; i < 2; ++i) { int R, C; stage_rc(tid * 16 + i * 8192, R, C); const int Rb = (R & ~31) + perm32(R & 31);
        voffA[i] = (unsigned)(R * g.lda + C) * 2u; voffB[i] = (unsigned)(Rb * g.ldb + C) * 2u; }
    const size_t kstep = (size_t)(BK * 2);
    const size_t hstepA = (size_t)HALF * g.lda * 2, hstepB = (size_t)HALF * g.ldb * 2;
    const size_t tstepA = 2 * hstepA, tstepB = 2 * hstepB;
    const unsigned ldsw = (unsigned)wid * 1024u;
    const int aoff = lds_byte(wr * 64 + fr, fq * 8), boff = lds_byte(wc * 32 + fr, fq * 8);
#define PG8_SA(b, h) (((b) * 2 + (h)) * HTB)
#define PG8_SB(b, h) ((4 + (b) * 2 + (h)) * HTB)
#define PG8_STAGE(bufoff, gbase, voff) do { _Pragma("unroll") for (int _i = 0; _i < 2; ++_i) \
        __builtin_amdgcn_global_load_lds((const unsigned*)((const char*)(gbase) + (voff)[_i]), (LAS unsigned*)(lds + (bufoff) + ldsw + _i * 8192), 16, 0, 0); } while (0)
#define PG8_LDA(dst, b, h) do { _Pragma("unroll") for (int m = 0; m < 4; ++m) _Pragma("unroll") for (int k = 0; k < 2; ++k) dst[m][k] = *(const LAS bf16x8*)(lds + PG8_SA(b, h) + aoff + m * 2048 + k * 1024); } while (0)
#define PG8_LDB(dst, b, h) do { _Pragma("unroll") for (int n = 0; n < 2; ++n) _Pragma("unroll") for (int k = 0; k < 2; ++k) dst[n][k] = *(const LAS bf16x8*)(lds + PG8_SB(b, h) + boff + n * 2048 + k * 1024); } while (0)
#define PG8_MMA(ai, bj, At, Bt) do { __builtin_amdgcn_s_setprio(1); _Pragma("unroll") for (int m = 0; m < 4; ++m) _Pragma("unroll") for (int n = 0; n < 2; ++n) _Pragma("unroll") for (int k = 0; k < 2; ++k) \
        acc[ai][bj][m][n] = __builtin_amdgcn_mfma_f32_16x16x32_bf16(Bt[n][k], At[m][k], acc[ai][bj][m][n], 0, 0, 0); __builtin_amdgcn_s_setprio(0); } while (0)
#define PG8_WAIT_V(n) asm volatile("s_waitcnt vmcnt(" #n ")" ::: "memory")
#define PG8_WAIT_L(n) asm volatile("s_waitcnt lgkmcnt(" #n ")" ::: "memory")
#define PG8_BAR __builtin_amdgcn_s_barrier()
#define PG8_SCHED __builtin_amdgcn_sched_barrier(0)
#define PG8_ABASE(u) ((const char*)g.A + (size_t)(u).pm * tstepA + (size_t)((u).pn / g.pn_per_grp) * g.a_grp_cols * 2)
    Unit cur, nxt; int ui = 0;
    if (!S.next(0, cur)) return;
    f32x4 acc[2][2][4][2];
#pragma unroll
    for (int a = 0; a < 2; ++a)
#pragma unroll
        for (int b = 0; b < 2; ++b)
#pragma unroll
            for (int m = 0; m < 4; ++m)
#pragma unroll
                for (int n = 0; n < 2; ++n) acc[a][b][m][n] = (f32x4){0.f, 0.f, 0.f, 0.f};
    bf16x8 At[4][2], B0[2][2], B1[2][2];
    const char* cA = PG8_ABASE(cur); const char* cB = (const char*)g.Bt + (size_t)cur.pn * tstepB;
    PG8_STAGE(PG8_SB(0, 0), cB, voffB); PG8_STAGE(PG8_SB(0, 1), cB + hstepB, voffB); PG8_STAGE(PG8_SA(0, 0), cA, voffA); PG8_STAGE(PG8_SA(0, 1), cA + hstepA, voffA);
    if (wr == 1) PG8_BAR;
    PG8_WAIT_V(2); PG8_BAR;
    PG8_STAGE(PG8_SB(1, 0), cB + kstep, voffB); PG8_STAGE(PG8_SA(1, 0), cA + kstep, voffA); PG8_STAGE(PG8_SB(1, 1), cB + hstepB + kstep, voffB);
    PG8_WAIT_V(6); PG8_BAR;
    for (;;) {
        const bool has_next = S.next(ui + 1, nxt);
        const char* nA = has_next ? PG8_ABASE(nxt) : cA; const char* nB = has_next ? (const char*)g.Bt + (size_t)nxt.pn * tstepB : cB;
        for (int t = 0; t < nt; t += 2) {
            const bool last = (t == nt - 2);
            const char* a1 = cA + (size_t)(t + 1) * kstep;
            const char* a2 = last ? nA : cA + (size_t)(t + 2) * kstep; const char* b2 = last ? nB : cB + (size_t)(t + 2) * kstep;
            const char* a3 = a2 + kstep; const char* b3 = b2 + kstep;
            PG8_LDB(B0, 0, 0); PG8_LDB(B1, 0, 1); PG8_SCHED; PG8_LDA(At, 0, 0); PG8_STAGE(PG8_SA(1, 1), a1 + hstepA, voffA);
            PG8_WAIT_V(8); PG8_WAIT_L(0); PG8_BAR; PG8_MMA(0, 0, At, B0); PG8_MMA(0, 1, At, B1); PG8_BAR; PG8_SCHED;
            PG8_LDA(At, 0, 1); PG8_STAGE(PG8_SB(0, 0), b2, voffB); PG8_STAGE(PG8_SB(0, 1), b2 + hstepB, voffB); PG8_STAGE(PG8_SA(0, 0), a2, voffA);
            PG8_WAIT_V(8); PG8_WAIT_L(0); PG8_BAR; PG8_MMA(1, 0, At, B0); PG8_MMA(1, 1, At, B1); PG8_BAR; PG8_SCHED;
            PG8_LDB(B0, 1, 0); PG8_LDB(B1, 1, 1); PG8_SCHED; PG8_LDA(At, 1, 0); PG8_STAGE(PG8_SA(0, 1), a2 + hstepA, voffA);
            PG8_WAIT_V(8); PG8_WAIT_L(0); PG8_BAR; PG8_MMA(0, 0, At, B0); PG8_MMA(0, 1, At, B1); PG8_BAR; PG8_SCHED;
            PG8_LDA(At, 1, 1); PG8_STAGE(PG8_SB(1, 0), b3, voffB); PG8_STAGE(PG8_SB(1, 1), b3 + hstepB, voffB); PG8_STAGE(PG8_SA(1, 0), a3, voffA);
            PG8_WAIT_V(8); PG8_WAIT_L(0); PG8_BAR; PG8_MMA(1, 0, At, B0); PG8_MMA(1, 1, At, B1); PG8_BAR; PG8_SCHED;
        }
        if constexpr (ALIGN_EPI) { if (wr == 0) PG8_BAR; }
        run_epi(E, acc, cur, wr, wc, fr, fq);
        if (!has_next) break;
#pragma unroll
        for (int a = 0; a < 2; ++a)
#pragma unroll
            for (int b = 0; b < 2; ++b)
#pragma unroll
                for (int m = 0; m < 4; ++m)
#pragma unroll
                    for (int n = 0; n < 2; ++n) acc[a][b][m][n] = (f32x4){0.f, 0.f, 0.f, 0.f};
        cur = nxt; cA = nA; cB = nB; ++ui;
        if constexpr (ALIGN_EPI) { if (wr == 1) PG8_BAR; }
    }
    PG8_WAIT_V(0);
    if constexpr (!ALIGN_EPI) { if (wr == 0) PG8_BAR; }
    PG8_BAR;
#undef PG8_SA
#undef PG8_SB
#undef PG8_STAGE
#undef PG8_LDA
#undef PG8_LDB
#undef PG8_MMA
#undef PG8_WAIT_V
#undef PG8_WAIT_L
#undef PG8_BAR
#undef PG8_SCHED
#undef PG8_ABASE
}
}

typedef GAS unsigned gu32;
#define RLX_AGENT __ATOMIC_RELAXED, __HIP_MEMORY_SCOPE_AGENT
#define XB_TMO      128
#define XB_XCNT(j)  (256  + 64 * (j))
#define XB_XSUB(j)  (1280 + 64 * (j))
#define XB_XGEN(j)  (2304 + 64 * (j))
#define XB_TOP      3328
#define XB_TOPGEN   3392
#define XCD_BAR_WORDS 3456
#define XB_SPIN_CAP (1u << 18)
__device__ __forceinline__ unsigned xb_ld(unsigned* p)              { return __hip_atomic_load(p, __ATOMIC_RELAXED, __HIP_MEMORY_SCOPE_AGENT); }
__device__ __forceinline__ unsigned xb_add(unsigned* p, unsigned v) { return __hip_atomic_fetch_add(p, v, __ATOMIC_RELAXED, __HIP_MEMORY_SCOPE_AGENT); }
__device__ __forceinline__ unsigned xb_xcc_id() { return (unsigned)__builtin_amdgcn_s_getreg((3 << 11) | 20) & 0xFu; }
#define XB_SPIN(cond, bar) do { unsigned _sp = 0; while (cond) { __builtin_amdgcn_s_sleep(1); \
    if ((++_sp & 255u) == 0u) { if (xb_ld(&(bar)[XB_TMO])) break; if (_sp > XB_SPIN_CAP) { atomicAdd(&(bar)[XB_TMO], 1u); break; } } } } while (0)
struct XcdBarrier { unsigned* bar; unsigned x; volatile LAS unsigned* st; };
__device__ __forceinline__ XcdBarrier xcd_barrier_post(unsigned* bar, volatile LAS unsigned* st) {
    XcdBarrier b; b.bar = bar; b.x = xb_xcc_id(); b.st = st;
    if (threadIdx.x == 0) (void)xb_add(&bar[XB_XCNT(b.x)], 1u);
    return b;
}
__device__ __forceinline__ void xcd_barrier_complete(unsigned* bar, unsigned x, unsigned& nloc, unsigned& nx) {
    const unsigned G = gridDim.x * gridDim.y * gridDim.z;
    unsigned sum, cnt, mine, sp = 0u;
    for (;;) {
        sum = 0u; cnt = 0u; mine = 0u;
#pragma unroll
        for (unsigned j = 0; j < 16; ++j) { const unsigned c = xb_ld(&bar[XB_XCNT(j)]); sum += c; cnt += (c > 0u) ? 1u : 0u; mine = (j == x) ? c : mine; }
        if (sum == G) break;
        __builtin_amdgcn_s_sleep(1);
        if ((++sp & 255u) == 0u) { if (xb_ld(&bar[XB_TMO])) break; if (sp > XB_SPIN_CAP) { atomicAdd(&bar[XB_TMO], 1u); break; } }
    }
    nloc = mine > 0u ? mine : 1u; nx = cnt > 0u ? cnt : 1u;
}
__device__ __forceinline__ void xcd_barrier(const XcdBarrier& b) {
    asm volatile("s_waitcnt vmcnt(0)" ::: "memory");
    __syncthreads();
    if (threadIdx.x == 0) {
        unsigned* bar = b.bar;
        __builtin_amdgcn_s_waitcnt(0);
        unsigned nloc = b.st[0], nx = b.st[1];
        if (nloc == 0u) { xcd_barrier_complete(bar, b.x, nloc, nx); b.st[0] = nloc; b.st[1] = nx; }
        const unsigned old = xb_add(&bar[XB_XSUB(b.x)], 1u);
        const unsigned gen = old / nloc;
        if (old + 1u == (gen + 1u) * nloc) {
            __builtin_amdgcn_fence(__ATOMIC_RELEASE, "agent");
            asm volatile("s_waitcnt vmcnt(0)" ::: "memory");
            const unsigned og = xb_add(&bar[XB_TOP], 1u);
            const unsigned tg = og / nx;
            if (og + 1u == (tg + 1u) * nx) xb_add(&bar[XB_TOPGEN], 1u);
            else XB_SPIN(xb_ld(&bar[XB_TOPGEN]) == tg, bar);
            __builtin_amdgcn_fence(__ATOMIC_ACQUIRE, "agent");
            xb_add(&bar[XB_XGEN(b.x)], 1u);
            asm volatile("s_waitcnt vmcnt(0)" ::: "memory");
        } else {
            XB_SPIN(xb_ld(&bar[XB_XGEN(b.x)]) == gen, bar);
            __builtin_amdgcn_fence(__ATOMIC_ACQUIRE, "agent");
            asm volatile("s_waitcnt vmcnt(0)" ::: "memory");
        }
    }
    __syncthreads();
}

struct Args {
    const float* in[15]; float* out; unsigned char* ws;
    float inv_freq[16];
    int ph_lo, ph_hi, li, pad;
};
struct Frame {
    LAS unsigned char* lds; int tid, lane, wave, vcu, G;
};

__device__ __forceinline__ void p0_transpose_item(const float* W, int N, bf16_t* WT, int ldt, int row_off, LAS float* scr, int item, int lane) {
    const int nblk = N / 32, kb = item / nblk, nb = item % nblk, k0 = 64 * kb, n0 = 32 * nb;
#pragma unroll 8
    for (int i = 0; i < 32; ++i) { const int kk = 2 * i + (lane >> 5); scr[kk * 33 + (lane & 31)] = W[(size_t)(k0 + kk) * N + n0 + (lane & 31)]; }
    asm volatile("s_waitcnt lgkmcnt(0)" ::: "memory");
    const int c = lane & 7;
#pragma unroll
    for (int j = 0; j < 4; ++j) { const int n = (lane >> 3) + 8 * j; const LAS float* s = scr + (8 * c) * 33 + n;
        u32x4 o; o.x = pk2(s[0 * 33], s[1 * 33]); o.y = pk2(s[2 * 33], s[3 * 33]); o.z = pk2(s[4 * 33], s[5 * 33]); o.w = pk2(s[6 * 33], s[7 * 33]);
        *(u32x4*)(WT + (size_t)(row_off + n0 + n) * ldt + k0 + 8 * c) = o; }
    asm volatile("s_waitcnt lgkmcnt(0)" ::: "memory");
}
__device__ __forceinline__ void load_row(const float* p, int lane, f32x4 (&v)[8]) {
#pragma unroll
    for (int j = 0; j < 8; ++j) v[j] = *(const f32x4*)(p + 4 * (64 * j + lane));
}
__device__ __forceinline__ void load_row_bf16(const bf16_t* p, int lane, f32x4 (&v)[8]) {
#pragma unroll
    for (int j = 0; j < 8; ++j) { const u32x2 w = *(const u32x2*)(p + 4 * (64 * j + lane)); v[j] = (f32x4){bflo(w.x), bfhi(w.x), bflo(w.y), bfhi(w.y)}; }
}
__device__ __forceinline__ float row_ss(const f32x4 (&v)[8]) {
    float s = 0.f;
#pragma unroll
    for (int j = 0; j < 8; ++j) s += (v[j][0] * v[j][0] + v[j][1] * v[j][1]) + (v[j][2] * v[j][2] + v[j][3] * v[j][3]);
    return wave_sum(s);
}
__device__ __forceinline__ void store_row_bf16(bf16_t* p, int lane, const f32x4 (&v)[8]) {
#pragma unroll
    for (int j = 0; j < 8; ++j) { u32x2 w; w.x = pk2(v[j][0], v[j][1]); w.y = pk2(v[j][2], v[j][3]); *(u32x2*)(p + 4 * (64 * j + lane)) = w; }
}

__device__ __forceinline__ void rows16_phase(const Frame& F, const bf16_t* A16, int lda, const bf16_t* Bt, int ldb, int K, int ntasks, int a_grp_cols, int tasks_per_grp, const Epi& E) {
    int lane_o = threadIdx.x & 63; asm volatile("" : "+v"(lane_o));
    const int lane = lane_o, m = lane & 15, fq = lane >> 4;
    LAS float* red = (LAS float*)F.lds;
    const int stride = F.G / ntasks > 0 ? F.G / ntasks : 1;
    for (int task0 = F.vcu; task0 < ntasks * stride; task0 += F.G) {
        if (task0 % stride) continue;
        const int task = task0 / stride;
        const int n0 = task * 32, kslice = K / 8, kb = F.wave * kslice;
        const bf16_t* ap = A16 + (size_t)m * lda + (task / tasks_per_grp) * a_grp_cols + kb + 8 * fq;
        const bf16_t* bp0 = Bt + (size_t)(n0 + 8 * (m >> 2) + (m & 3)) * ldb + kb + 8 * fq;
        const bf16_t* bp1 = bp0 + (size_t)4 * ldb;
        f32x4 acc0 = {0.f, 0.f, 0.f, 0.f}, acc1 = {0.f, 0.f, 0.f, 0.f};
        for (int ks = 0; ks < kslice; ks += 32) {
            const bf16x8 a = *(const bf16x8*)(ap + ks), b0 = *(const bf16x8*)(bp0 + ks), b1 = *(const bf16x8*)(bp1 + ks);
            acc0 = __builtin_amdgcn_mfma_f32_16x16x32_bf16(b0, a, acc0, 0, 0, 0);
            acc1 = __builtin_amdgcn_mfma_f32_16x16x32_bf16(b1, a, acc1, 0, 0, 0);
        }
        *(LAS f32x4*)(red + (F.wave * 2 + 0) * 256 + lane * 4) = acc0;
        *(LAS f32x4*)(red + (F.wave * 2 + 1) * 256 + lane * 4) = acc1;
        __syncthreads();
        if (F.wave == 0) {
            f32x4 s0 = {0.f, 0.f, 0.f, 0.f}, s1 = {0.f, 0.f, 0.f, 0.f};
#pragma unroll
            for (int w = 0; w < 8; ++w) { s0 += *(const LAS f32x4*)(red + (w * 2 + 0) * 256 + lane * 4); s1 += *(const LAS f32x4*)(red + (w * 2 + 1) * 256 + lane * 4); }
            E.emit_rt(MREAL + m, n0 + 8 * fq, s0, s1);
        }
        __syncthreads();
    }
}

template <int W> __device__ __forceinline__ void mix_strip(const bf16_t* U, bf16_t* MIXo, int strip, int c0) {
    const int row0 = strip * 16, bb = row0 >> 12, p0 = NMETA + (row0 & (SEQ - 1));
    u32x4 buf[W - 1 + 16];
#pragma unroll
    for (int i = 0; i < W - 1 + 16; ++i) { const int pp = p0 - (W - 1) + i; const int r = pp >= NMETA ? bb * SEQ + pp - NMETA : MREAL + pp;
        buf[i] = *(const u32x4*)(U + (size_t)r * DM + c0); }
    float s[8] = {0.f, 0.f, 0.f, 0.f, 0.f, 0.f, 0.f, 0.f};
#define MIX_UNPK(v, f) const float f[8] = {bflo(v.x), bfhi(v.x), bflo(v.y), bfhi(v.y), bflo(v.z), bfhi(v.z), bflo(v.w), bfhi(v.w)}
#pragma unroll
    for (int i = 0; i < W - 1; ++i) { MIX_UNPK(buf[i], f);
#pragma unroll
        for (int k = 0; k < 8; ++k) s[k] += f[k]; }
    constexpr float iw = 1.0f / (float)W;
#pragma unroll
    for (int t = 0; t < 16; ++t) {
        MIX_UNPK(buf[W - 1 + t], f);
#pragma unroll
        for (int k = 0; k < 8; ++k) s[k] += f[k];
        u32x4 o; o.x = pk2(s[0] * iw - f[0], s[1] * iw - f[1]); o.y = pk2(s[2] * iw - f[2], s[3] * iw - f[3]);
        o.z = pk2(s[4] * iw - f[4], s[5] * iw - f[5]); o.w = pk2(s[6] * iw - f[6], s[7] * iw - f[7]);
        *(u32x4*)(MIXo + (size_t)(row0 + t) * DM + c0) = o;
        MIX_UNPK(buf[t], g);
#pragma unroll
        for (int k = 0; k < 8; ++k) s[k] -= g[k];
    }
#undef MIX_UNPK
}

namespace att {
__device__ __forceinline__ int crow(int r, int hi) { return (r & 3) + 8 * (r >> 2) + 4 * hi; }
__device__ __forceinline__ float xch32(float v) { return __shfl_xor(v, 32); }
constexpr float THRL = 6.0f;
template <int OFF> __device__ __forceinline__ s16x4 tr_read(int vb) {
    s16x4 r; asm volatile("ds_read_b64_tr_b16 %0, %1 offset:%2" : "=&v"(r) : "v"(vb), "i"(OFF) : "memory"); return r;
}
template <int D0> __device__ __forceinline__ void pv_one(f32x16& od, int vb, const u32x4 (&pw)[4]) {
    const s16x4 l0 = tr_read<(0 * 8 + D0) * 512>(vb), h0 = tr_read<(1 * 8 + D0) * 512>(vb), l1 = tr_read<(2 * 8 + D0) * 512>(vb), h1 = tr_read<(3 * 8 + D0) * 512>(vb);
    const s16x4 l2 = tr_read<(4 * 8 + D0) * 512>(vb), h2 = tr_read<(5 * 8 + D0) * 512>(vb), l3 = tr_read<(6 * 8 + D0) * 512>(vb), h3 = tr_read<(7 * 8 + D0) * 512>(vb);
    asm volatile("s_waitcnt lgkmcnt(0)" ::: "memory"); __builtin_amdgcn_sched_barrier(0);
#define ATT_PK(L, H) (bf16x8){L[0], L[1], L[2], L[3], H[0], H[1], H[2], H[3]}
    od = __builtin_amdgcn_mfma_f32_32x32x16_bf16(ATT_PK(l0, h0), __builtin_bit_cast(bf16x8, pw[0]), od, 0, 0, 0);
    od = __builtin_amdgcn_mfma_f32_32x32x16_bf16(ATT_PK(l1, h1), __builtin_bit_cast(bf16x8, pw[1]), od, 0, 0, 0);
    od = __builtin_amdgcn_mfma_f32_32x32x16_bf16(ATT_PK(l2, h2), __builtin_bit_cast(bf16x8, pw[2]), od, 0, 0, 0);
    od = __builtin_amdgcn_mfma_f32_32x32x16_bf16(ATT_PK(l3, h3), __builtin_bit_cast(bf16x8, pw[3]), od, 0, 0, 0);
#undef ATT_PK
}
__device__ __forceinline__ void attn_unit(const Frame& F, const bf16_t* Q, const unsigned char* Kimg, const unsigned char* Vimg, const bf16_t* Gt, bf16_t* O,
                                          const float* subln_g, int b, int h, int qb) {
    LAS unsigned char* lds = F.lds;
    int lane_o = threadIdx.x & 63; asm volatile("" : "+v"(lane_o));
    const int lane = lane_o, r32 = lane & 31, hi = lane >> 5, wid = F.wave, mp = wid >> 2, rg = wid & 3;
    const bool meta = qb < 0;
    const size_t qrow = meta ? (size_t)(MREAL + (r32 & 15)) : (size_t)b * SEQ + qb * 128 + rg * 32 + r32;
    const int NT = meta ? 1 : 2 * qb + 3;
    const int tmax = meta ? 0 : 2 * qb + 1 + (rg >> 1);
    bf16x8 qr[8];
    { const bf16_t* qp = Q + qrow * DM + h * 256 + mp * 128 + hi * 8;
#pragma unroll
      for (int d0 = 0; d0 < 8; ++d0) qr[d0] = *(const bf16x8*)(qp + 16 * d0); }
    const int bsel = meta ? 0 : b;
    const unsigned char* src; size_t tstride;
    if (wid < 2)      { src = Kimg + ((size_t)((bsel * NH + h) * 2 + 0) * NTILE) * KTILE_B + wid * 8192; tstride = KTILE_B; }
    else if (wid < 4) { src = Kimg + ((size_t)((bsel * NH + h) * 2 + 1) * NTILE) * KTILE_B + (wid - 2) * 8192; tstride = KTILE_B; }
    else              { src = Vimg + ((size_t)(bsel * NH + h) * NTILE) * VTILE_B + (wid - 4) * 8192; tstride = VTILE_B; }
    src += lane * 16;
#define ATT_DMA(t, st) do { _Pragma("unroll") for (int _i = 0; _i < 8; ++_i) \
        __builtin_amdgcn_global_load_lds((const unsigned*)(src + (size_t)(t) * tstride + _i * 1024), (LAS unsigned*)(lds + (st) * 65536 + wid * 8192 + _i * 1024), 16, 0, 0); } while (0)
    f32x16 o[8];
#pragma unroll
    for (int d = 0; d < 8; ++d) o[d] = (f32x16){0.f, 0.f, 0.f, 0.f, 0.f, 0.f, 0.f, 0.f, 0.f, 0.f, 0.f, 0.f, 0.f, 0.f, 0.f, 0.f};
    float m_run = -1e30f, l_run = 0.f;
    const int vbase = (4 * hi + ((lane & 15) >> 2)) * 64 + ((lane >> 4) & 1) * 32 + (lane & 3) * 8;
    ATT_DMA(0, 0);
    for (int t = 0; t < NT; ++t) {
        asm volatile("s_waitcnt vmcnt(0)" ::: "memory"); __builtin_amdgcn_s_barrier(); asm volatile("" ::: "memory");
        if (t + 1 < NT) ATT_DMA(t + 1, (t + 1) & 1);
        if (t <= tmax) {
            const LAS unsigned char* Kst = lds + (t & 1) * 65536 + mp * KTILE_B + hi * 1024 + r32 * 16;
            const LAS unsigned char* Vst = lds + (t & 1) * 65536 + 32768 + vbase;
            f32x16 p0 = (f32x16){0.f, 0.f, 0.f, 0.f, 0.f, 0.f, 0.f, 0.f, 0.f, 0.f, 0.f, 0.f, 0.f, 0.f, 0.f, 0.f}, p1 = p0;
#pragma unroll
            for (int d0 = 0; d0 < 8; ++d0) {
                const bf16x8 a0 = *(const LAS bf16x8*)(Kst + d0 * 2048), a1 = *(const LAS bf16x8*)(Kst + d0 * 2048 + 512);
                p0 = __builtin_amdgcn_mfma_f32_32x32x16_bf16(a0, qr[d0], p0, 0, 0, 0);
                p1 = __builtin_amdgcn_mfma_f32_32x32x16_bf16(a1, qr[d0], p1, 0, 0, 0);
            }
            if (t == 0) {
#pragma unroll
                for (int r = 8; r < 16; ++r) p0[r] = -INFINITY;
#pragma unroll
                for (int r = 0; r < 16; ++r) p1[r] = -INFINITY;
            }
            float rm = p0[0];
#pragma unroll
            for (int r = 1; r < 16; ++r) rm = fmaxf(rm, p0[r]);
#pragma unroll
            for (int r = 0; r < 16; ++r) rm = fmaxf(rm, p1[r]);
            rm = fmaxf(rm, xch32(rm));
            if (__any(rm > m_run + THRL)) {
                const float mn = fmaxf(m_run, rm), alpha = __builtin_amdgcn_exp2f(m_run - mn);
                m_run = mn; l_run *= alpha;
#pragma unroll
                for (int d = 0; d < 8; ++d)
#pragma unroll
                    for (int r = 0; r < 16; ++r) o[d][r] *= alpha;
            }
            float ps = 0.f;
#pragma unroll
            for (int r = 0; r < 16; ++r) { p0[r] = __builtin_amdgcn_exp2f(p0[r] - m_run); ps += p0[r]; }
#pragma unroll
            for (int r = 0; r < 16; ++r) { p1[r] = __builtin_amdgcn_exp2f(p1[r] - m_run); ps += p1[r]; }
            l_run += ps;
            u32x4 pw[4];
            pw[0] = (u32x4){pk2(p0[0], p0[1]), pk2(p0[2], p0[3]), pk2(p0[4], p0[5]), pk2(p0[6], p0[7])};
            pw[1] = (u32x4){pk2(p0[8], p0[9]), pk2(p0[10], p0[11]), pk2(p0[12], p0[13]), pk2(p0[14], p0[15])};
            pw[2] = (u32x4){pk2(p1[0], p1[1]), pk2(p1[2], p1[3]), pk2(p1[4], p1[5]), pk2(p1[6], p1[7])};
            pw[3] = (u32x4){pk2(p1[8], p1[9]), pk2(p1[10], p1[11]), pk2(p1[12], p1[13]), pk2(p1[14], p1[15])};
            const int vb = (int)(unsigned)(uintptr_t)Vst;
            pv_one<0>(o[0], vb, pw); pv_one<1>(o[1], vb, pw); pv_one<2>(o[2], vb, pw); pv_one<3>(o[3], vb, pw);
            pv_one<4>(o[4], vb, pw); pv_one<5>(o[5], vb, pw); pv_one<6>(o[6], vb, pw); pv_one<7>(o[7], vb, pw);
        }
    }
    asm volatile("s_waitcnt vmcnt(0) lgkmcnt(0)" ::: "memory"); __builtin_amdgcn_s_barrier(); asm volatile("" ::: "memory");
    const float ltot = l_run + xch32(l_run);
    const float inv = __builtin_amdgcn_rcpf(ltot);
    LAS float* xb = (LAS float*)lds + (size_t)rg * 8192;
    if (mp == 1) {
        const float sc = *(const LAS float*)(lds + MISC_OFF + 64) * inv;
#pragma unroll
        for (int d = 0; d < 8; ++d) {
#pragma unroll
            for (int r = 0; r < 16; ++r) xb[(d * 16 + r) * 64 + lane] = o[d][r] * sc;
            asm volatile("" ::: "memory"); }
    }
    asm volatile("s_waitcnt lgkmcnt(0)" ::: "memory"); __builtin_amdgcn_s_barrier(); asm volatile("" ::: "memory");
    if (mp == 0) {
        float ss = 0.f;
#pragma unroll
        for (int d = 0; d < 8; ++d) {
#pragma unroll
            for (int r = 0; r < 16; ++r) { const float v = o[d][r] * inv - xb[(d * 16 + r) * 64 + lane]; o[d][r] = v; ss = fmaf(v, v, ss); }
            asm volatile("" : "+v"(ss) :: "memory"); }
        ss += xch32(ss);
        const float rstd = __builtin_amdgcn_rsqf(ss * (1.0f / 256.0f) + RMS_EPS) * 0.8f;
        const bool valid = !meta || r32 < 16;
        const bf16_t* gp = Gt + qrow * DM + h * 256; bf16_t* op = O + qrow * DM + h * 256;
#pragma unroll
        for (int d = 0; d < 8; ++d)
#pragma unroll
            for (int rq = 0; rq < 4; ++rq) {
                const int dd = 32 * d + 8 * rq + 4 * hi;
                const u32x2 g = *(const u32x2*)(gp + dd); const f32x4 sg = *(const f32x4*)(subln_g + dd);
                const float v0 = o[d][4 * rq + 0] * rstd * sg[0] * bflo(g.x), v1 = o[d][4 * rq + 1] * rstd * sg[1] * bfhi(g.x);
                const float v2 = o[d][4 * rq + 2] * rstd * sg[2] * bflo(g.y), v3 = o[d][4 * rq + 3] * rstd * sg[3] * bfhi(g.y);
                u32x2 w; w.x = pk2(v0, v1); w.y = pk2(v2, v3);
                if (valid) *(u32x2*)(op + dd) = w;
                asm volatile("" ::: "memory");
            }
    }
    asm volatile("s_waitcnt lgkmcnt(0)" ::: "memory"); __builtin_amdgcn_s_barrier(); asm volatile("" ::: "memory");
#undef ATT_DMA
}
}

__global__ void __launch_bounds__(512, 2) trunk_fwd(Args args) {
    extern __shared__ __attribute__((aligned(16))) unsigned char lds_raw[];
    Frame F;
    F.lds = (LAS unsigned char*)lds_raw;
    F.tid = threadIdx.x; F.lane = F.tid & 63; F.wave = __builtin_amdgcn_readfirstlane(F.tid >> 6);
    F.G = gridDim.x; { const int bx = blockIdx.x; F.vcu = (F.G % 8 == 0) ? (bx % 8) * (F.G / 8) + bx / 8 : bx; }
    volatile LAS unsigned* MISC = (volatile LAS unsigned*)(F.lds + MISC_OFF);
    unsigned char* ws = args.ws;
    gu32* ctl = (gu32*)(ws + WS_CTL);
    for (int u = F.tid; u < (LDS_BYTES - LDSCTL_OFF) / 4; u += 512) ((LAS unsigned*)(F.lds + LDSCTL_OFF))[u] = 0u;
    __syncthreads();
    XcdBarrier bar; bar.bar = (unsigned*)(ctl + CW_BAR); bar.x = 0; bar.st = nullptr;
    if (MK_N_LAUNCHES == 1) bar = xcd_barrier_post((unsigned*)(ctl + CW_BAR), MISC + 8);
#define GRID_BAR() do { if (MK_N_LAUNCHES == 1) xcd_barrier(bar); } while (0)
    const int lo = args.ph_lo, hi = args.ph_hi;
#define IN(k) (lo <= (k) && (k) < hi)
#define REPS(k) for (int rep_ = 0; rep_ < ((k) == PROBE_PH ? 1 + PROBE_REP : 1); ++rep_)

    const float* x = args.in[0]; const float* meta_tok = args.in[1]; const float* pre_g = args.in[2]; const float* post_g = args.in[3];
    const float* attn_w_in = args.in[4]; const float* attn_w_out = args.in[5];
    const float* lq1 = args.in[6]; const float* lk1 = args.in[7]; const float* lq2 = args.in[8]; const float* lk2 = args.in[9];
    const float* subln_g = args.in[10];
    const float* pool_w_in = args.in[11]; const float* pool_w_group = args.in[12]; const float* pool_scale = args.in[13]; const float* pool_w_out = args.in[14];
    bf16_t* W1 = (bf16_t*)(ws + WS_W1); bf16_t* W2 = (bf16_t*)(ws + WS_W2); bf16_t* W3 = (bf16_t*)(ws + WS_W3); bf16_t* W4 = (bf16_t*)(ws + WS_W4); bf16_t* W5 = (bf16_t*)(ws + WS_W5);
    bf16_t* XN = (bf16_t*)(ws + WS_XN); bf16_t* GB = (bf16_t*)(ws + WS_G); bf16_t* QO = (bf16_t*)(ws + WS_QO);
    unsigned char* Kimg = ws + WS_K; unsigned char* Vimg = ws + WS_V;
    bf16_t* Y0 = (bf16_t*)(ws + WS_Y0); bf16_t* Y1 = (bf16_t*)(ws + WS_Y1);
    bf16_t* UB = (bf16_t*)(ws + WS_U); bf16_t* G1 = (bf16_t*)(ws + WS_G1); bf16_t* MIX = (bf16_t*)(ws + WS_MIX); bf16_t* GATED1 = (bf16_t*)(ws + WS_GATED1);
    float* ropec = (float*)(ws + WS_ROPEC); float* ropes = (float*)(ws + WS_ROPES); float* rstd0 = (float*)(ws + WS_RSTD0);
    const int gw = F.vcu * 8 + F.wave, NGW = F.G * 8;
    const int gtid = F.vcu * 512 + F.tid, NGT = F.G * 512;

    Epi E; E.mode = 0; E.Q = QO; E.Kimg = Kimg; E.Vimg = Vimg; E.G = GB; E.ropec = ropec; E.ropes = ropes; E.Y = Y0; E.U = UB; E.G1 = G1; E.GATED1 = GATED1; E.pool_scale = pool_scale;

    if (IN(0)) REPS(0) {
        LAS float* scr = (LAS float*)(F.lds + F.wave * 16384);
        constexpr int I1 = (DM / 64) * (4 * DM / 32), I2 = (DM / 64) * (DM / 32), I3 = (DM / 64) * (2 * DM / 32), I4 = (512 / 64) * (512 / 32), I5 = I2;
        constexpr int NITEMS = I1 + I2 + I3 + 4 * I4 + I5;
        for (int it = gw; it < NITEMS; it += NGW) {
            int r = it;
            if (r < I1) { p0_transpose_item(attn_w_in, 4 * DM, W1, DM, 0, scr, r, F.lane); continue; } r -= I1;
            if (r < I2) { p0_transpose_item(attn_w_out, DM, W2, DM, 0, scr, r, F.lane); continue; } r -= I2;
            if (r < I3) { p0_transpose_item(pool_w_in, 2 * DM, W3, DM, 0, scr, r, F.lane); continue; } r -= I3;
            if (r < 4 * I4) { const int g = r / I4; p0_transpose_item(pool_w_group + (size_t)g * 512 * 512, 512, W4, 512, g * 512, scr, r % I4, F.lane); continue; } r -= 4 * I4;
            p0_transpose_item(pool_w_out, DM, W5, DM, 0, scr, r, F.lane);
        }
        for (int i = gtid; i < LTOT * 16; i += NGT) {
            const int pos = i >> 4, k = i & 15; const float ang = (float)pos * args.inv_freq[k];
            double rev = (double)ang * 0.15915494309189535; rev -= floor(rev);
            const float fr = (float)rev; ropec[i] = __builtin_amdgcn_cosf(fr); ropes[i] = __builtin_amdgcn_sinf(fr);
        }
        for (int m = gw; m < MROWS; m += NGW) {
            const float* src = m < MREAL ? x + (size_t)m * DM : meta_tok + (size_t)(m - MREAL) * DM;
            f32x4 v[8]; load_row(src, F.lane, v);
            const float rstd = __builtin_amdgcn_rsqf(row_ss(v) * (1.0f / DM) + RMS_EPS);
#pragma unroll
            for (int j = 0; j < 8; ++j) v[j] = v[j] * rstd * *(const f32x4*)(pre_g + 4 * (64 * j + F.lane));
            store_row_bf16(XN + (size_t)m * DM, F.lane, v);
        }
        const u32x4 z = {0u, 0u, 0u, 0u};
        for (int i = gtid; i < NB * NH * 2 * 1024; i += NGT) *(u32x4*)(Kimg + (size_t)(i >> 10) * NTILE * KTILE_B + (i & 1023) * 16) = z;
        for (int i = gtid; i < NB * NH * 2048; i += NGT) *(u32x4*)(Vimg + (size_t)(i >> 11) * NTILE * VTILE_B + (i & 2047) * 16) = z;
        GRID_BAR();
    }
    if (IN(1)) REPS(1) {
        E.mode = 1;
        rows16_phase(F, XN + (size_t)MREAL * DM, DM, W1, DM, DM, 4 * DM / 32, 0, 1 << 30, E);
        pg8::Gemm g{XN, W1, MREAL, 4 * DM, DM, DM, DM, 1 << 30, 0}; pg8::StaticOrder S; S.init(MREAL, 4 * DM, F.G, (int)blockIdx.x);
        pg8::gemm_phase<true>(F.lds, g, S, E);
        GRID_BAR();
    }
    if (IN(2)) REPS(2) {
        float d1 = 0.f, d2 = 0.f;
#pragma unroll
        for (int j = 0; j < 2; ++j) { d1 += lq1[F.lane + 64 * j] * lk1[F.lane + 64 * j]; d2 += lq2[F.lane + 64 * j] * lk2[F.lane + 64 * j]; }
        const float lam = expf(wave_sum(d1)) - expf(wave_sum(d2)) + 0.2f;
        if (F.tid == 0) *(LAS float*)(F.lds + MISC_OFF + 64) = lam;
        __syncthreads();
        for (int u = F.vcu; u < 520; u += F.G) {
            int bh, qb;
            if (u < 256) { bh = u >> 4; qb = u & 15; } else if (u < 512) { bh = (u - 256) >> 4; qb = 31 - ((u - 256) & 15); } else { bh = u - 512; qb = -1; }
            att::attn_unit(F, QO, Kimg, Vimg, GB, XN, subln_g, bh >> 3, bh & 7, qb);
        }
        GRID_BAR();
    }
    if (IN(3)) REPS(3) {
        E.mode = 2; E.Y = Y0;
        rows16_phase(F, XN + (size_t)MREAL * DM, DM, W2, DM, DM, DM / 32, 0, 1 << 30, E);
        pg8::Gemm g{XN, W2, MREAL, DM, DM, DM, DM, 1 << 30, 0}; pg8::StaticOrder S; S.init(MREAL, DM, F.G, (int)blockIdx.x);
        pg8::gemm_phase<true>(F.lds, g, S, E);
        GRID_BAR();
    }
    if (IN(4)) REPS(4) {
        for (int m = gw; m < MROWS; m += NGW) {
            f32x4 y[8], hrow[8]; load_row_bf16(Y0 + (size_t)m * DM, F.lane, y);
            load_row(m < MREAL ? x + (size_t)m * DM : meta_tok + (size_t)(m - MREAL) * DM, F.lane, hrow);
            const float r0 = __builtin_amdgcn_rsqf(row_ss(y) * (1.0f / DM) + RMS_EPS);
            if (F.lane == 0) rstd0[m] = r0;
#pragma unroll
            for (int j = 0; j < 8; ++j) hrow[j] = hrow[j] + y[j] * r0 * *(const f32x4*)(post_g + 4 * (64 * j + F.lane));
            const float r1 = __builtin_amdgcn_rsqf(row_ss(hrow) * (1.0f / DM) + RMS_EPS);
#pragma unroll
            for (int j = 0; j < 8; ++j) hrow[j] = hrow[j] * r1 * *(const f32x4*)(pre_g + DM + 4 * (64 * j + F.lane));
            store_row_bf16(XN + (size_t)m * DM, F.lane, hrow);
        }
        GRID_BAR();
    }
    if (IN(5)) REPS(5) {
        E.mode = 3;
        rows16_phase(F, XN + (size_t)MREAL * DM, DM, W3, DM, DM, DM / 32, 0, 1 << 30, E);
        pg8::Gemm g{XN, W3, MREAL, 2 * DM, DM, DM, DM, 1 << 30, 0}; pg8::StaticOrder S; S.init(MREAL, 2 * DM, F.G, (int)blockIdx.x);
        pg8::gemm_phase<true>(F.lds, g, S, E);
        GRID_BAR();
    }
    if (IN(6)) REPS(6) {
        for (int idx = gtid; idx < (MREAL / 16) * 256; idx += NGT) {
            const int strip = idx >> 8, c0 = (idx & 255) * 8, gi = c0 >> 9;
            if (gi == 0) mix_strip<2>(UB, MIX, strip, c0); else if (gi == 1) mix_strip<4>(UB, MIX, strip, c0);
            else if (gi == 2) mix_strip<8>(UB, MIX, strip, c0); else mix_strip<16>(UB, MIX, strip, c0);
        }
        GRID_BAR();
    }
    if (IN(7)) REPS(7) {
        E.mode = 4;
        pg8::Gemm g{MIX, W4, MREAL, DM, 512, DM, 512, 2, 512}; pg8::StaticOrder S; S.init(MREAL, DM, F.G, (int)blockIdx.x);
        pg8::gemm_phase<true>(F.lds, g, S, E);
        GRID_BAR();
    }
    if (IN(8)) REPS(8) {
        E.mode = 5; E.Y = Y1;
        pg8::Gemm g{GATED1, W5, MREAL, DM, DM, DM, DM, 1 << 30, 0}; pg8::StaticOrder S; S.init(MREAL, DM, F.G, (int)blockIdx.x);
        pg8::gemm_phase<true>(F.lds, g, S, E);
        GRID_BAR();
    }
    if (IN(9)) REPS(9) {
        for (int m = gw; m < MREAL; m += NGW) {
            f32x4 y1[8], acc[8]; load_row_bf16(Y1 + (size_t)m * DM, F.lane, y1); load_row(x + (size_t)m * DM, F.lane, acc);
            const float r0 = rstd0[m];
            const float r1 = __builtin_amdgcn_rsqf(row_ss(y1) * (1.0f / DM) + RMS_EPS);
#pragma unroll
            for (int j = 0; j < 8; ++j) {
                const int e = 4 * (64 * j + F.lane);
                const u32x2 y0w = *(const u32x2*)(Y0 + (size_t)m * DM + e); const f32x4 y0 = {bflo(y0w.x), bfhi(y0w.x), bflo(y0w.y), bfhi(y0w.y)};
                acc[j] = acc[j] + y0 * r0 * *(const f32x4*)(post_g + e) + y1[j] * r1 * *(const f32x4*)(post_g + DM + e);
                *(f32x4*)(args.out + (size_t)m * DM + e) = acc[j];
            }
        }
    }
#undef IN
#undef GRID_BAR
}

extern "C" void kernel_launch(void* const* d_in, const int* in_sizes, int n_in, void* d_out, int out_size, void* d_ws, size_t ws_size, hipStream_t stream) {
    static int grid = 0;
    if (grid == 0) {
        if (n_in != 15 || in_sizes[0] != NB * SEQ * DM || out_size != NB * SEQ * DM || ws_size < WS_END) {
            fprintf(stderr, "kernel_launch: unexpected shapes (n_in %d, in0 %d, out %d, ws %zu)\n", n_in, n_in > 0 ? in_sizes[0] : -1, out_size, ws_size); grid = -1; return; }
        int dev = 0, cus = 0, per_cu = 0;
        if (hipGetDevice(&dev) != hipSuccess || hipDeviceGetAttribute(&cus, hipDeviceAttributeMultiprocessorCount, dev) != hipSuccess) { grid = -1; return; }
        if (hipFuncSetAttribute((const void*)trunk_fwd, hipFuncAttributeMaxDynamicSharedMemorySize, LDS_BYTES) != hipSuccess) { fprintf(stderr, "kernel_launch: hipFuncSetAttribute failed\n"); grid = -1; return; }
        if (hipOccupancyMaxActiveBlocksPerMultiprocessor(&per_cu, (const void*)trunk_fwd, 512, LDS_BYTES) != hipSuccess || per_cu < 1) {
            fprintf(stderr, "kernel_launch: occupancy query reports %d workgroups per CU\n", per_cu); (void)hipGetLastError(); grid = -1; return; }
        grid = cus;
    }
    if (grid < 0) return;
    (void)hipMemsetAsync((char*)d_ws + WS_CTL, 0, CTL_ZERO_BYTES, stream);
    Args a{};
    for (int i = 0; i < 15; ++i) a.in[i] = (const float*)d_in[i];
    a.out = (float*)d_out; a.ws = (unsigned char*)d_ws;
    for (int i = 0; i < 16; ++i) a.inv_freq[i] = (float)pow(500000.0, -(double)i / 16.0);
#if MK_N_LAUNCHES == 1
    a.ph_lo = 0; a.ph_hi = 10; a.li = 0;
    hipLaunchKernelGGL(trunk_fwd, dim3(grid), dim3(512), LDS_BYTES, stream, a);
#else
    for (int p = 0; p < 10; ++p) { a.ph_lo = p; a.ph_hi = p + 1; a.li = p; hipLaunchKernelGGL(trunk_fwd, dim3(grid), dim3(512), LDS_BYTES, stream, a); }
#endif
    const hipError_t le = hipPeekAtLastError();
    if (le != hipSuccess) fprintf(stderr, "kernel_launch: launch failed: %s\n", hipGetErrorName(le));
}
```

```cpp
#include <hip/hip_runtime.h>
#include <cstdio>
#include <cstdint>
#include <cmath>

#ifndef MK_N_LAUNCHES
#define MK_N_LAUNCHES 1
#endif
#ifndef PROBE_PH
#define PROBE_PH (-1)
#endif
#ifndef PROBE_REP
#define PROBE_REP 0
#endif

#define LAS __attribute__((address_space(3)))
#define GAS __attribute__((address_space(1)))
typedef unsigned short bf16_t;
typedef short bf16x8 __attribute__((ext_vector_type(8)));
typedef short s16x4 __attribute__((ext_vector_type(4)));
typedef float f32x4 __attribute__((ext_vector_type(4)));
typedef float f32x16 __attribute__((ext_vector_type(16)));
typedef unsigned u32x4 __attribute__((ext_vector_type(4)));
typedef unsigned u32x2 __attribute__((ext_vector_type(2)));

constexpr int DM = 2048, SEQ = 4096, NB = 2, NMETA = 16, LTOT = SEQ + NMETA;
constexpr int MREAL = NB * SEQ;
constexpr int MROWS = MREAL + NMETA;
constexpr int NH = 8, HD = 128, VD = 256;
constexpr int NTILE = 65;
constexpr int KTILE_B = 64 * 128 * 2, VTILE_B = 64 * 256 * 2;
constexpr float RMS_EPS = 1e-6f;
constexpr float C2 = 0.08838834764831845f * 1.4426950408889634f;
constexpr float LOG2E = 1.4426950408889634f;

constexpr size_t MiB = 1u << 20;
constexpr size_t WS_CTL = 0, CTL_ZERO_BYTES = 65536;
constexpr size_t WS_ROPEC = 1 * MiB, WS_ROPES = 1 * MiB + 512 * 1024;
constexpr size_t WS_RSTD0 = 2 * MiB;
constexpr size_t WS_W1 = 4 * MiB, WS_W2 = 36 * MiB, WS_W3 = 44 * MiB, WS_W4 = 60 * MiB, WS_W5 = 62 * MiB;
constexpr size_t WS_XN = 70 * MiB, WS_G = 104 * MiB, WS_QO = 138 * MiB, WS_K = 172 * MiB;
constexpr size_t KIMG_BYTES = (size_t)NB * NH * 2 * NTILE * KTILE_B, VIMG_BYTES = (size_t)NB * NH * NTILE * VTILE_B;
constexpr size_t WS_V = WS_K + KIMG_BYTES;
constexpr size_t WS_Y0 = WS_K;
constexpr size_t WS_U = WS_QO, WS_G1 = WS_G, WS_MIX = WS_XN, WS_GATED1 = WS_QO, WS_Y1 = WS_XN;
constexpr size_t WS_END = WS_V + VIMG_BYTES;
static_assert(WS_END <= 240 * MiB && WS_Y0 + (size_t)MROWS * DM * 2 <= WS_END && WS_Y1 + (size_t)MROWS * DM * 2 <= WS_G, "ws map");
constexpr int CW_BAR = 4096;

constexpr int RING_BYTES = 131072, LDSCTL_OFF = RING_BYTES, MISC_OFF = LDSCTL_OFF + 320, LDS_BYTES = 147456;

__device__ __forceinline__ unsigned pk2(float lo, float hi) {
    typedef float f2_t __attribute__((ext_vector_type(2))); typedef __bf16 b2_t __attribute__((ext_vector_type(2)));
    f2_t v = {lo, hi}; b2_t b = __builtin_convertvector(v, b2_t); return __builtin_bit_cast(unsigned, b);
}
__device__ __forceinline__ float bflo(unsigned u) { return __uint_as_float(u << 16); }
__device__ __forceinline__ float bfhi(unsigned u) { return __uint_as_float(u & 0xffff0000u); }
__device__ __forceinline__ float siluf(float x) { return x * __builtin_amdgcn_rcpf(1.0f + __builtin_amdgcn_exp2f(-x * LOG2E)); }
__device__ __forceinline__ float wave_sum(float v) {
#pragma unroll
    for (int o = 1; o < 64; o <<= 1) v += __shfl_xor(v, o);
    return v;
}
__device__ __forceinline__ u32x4 pack8(f32x4 a, f32x4 b) { u32x4 w; w.x = pk2(a[0], a[1]); w.y = pk2(a[2], a[3]); w.z = pk2(b[0], b[1]); w.w = pk2(b[2], b[3]); return w; }

struct Epi {
    int mode;
    bf16_t* Q; unsigned char* Kimg; unsigned char* Vimg; bf16_t* G; const float* ropec; const float* ropes;
    bf16_t* Y;
    bf16_t* U; bf16_t* G1;
    bf16_t* GATED1; const float* pool_scale;
    template <int MODE> __device__ __forceinline__ void emit(int row, int col, f32x4 a, f32x4 b) const {
        if constexpr (MODE == 1) {
            if (col < 4096) {
                const int c = col & 2047, dim = c & 127;
                if (dim < 32) {
                    f32x4 pa, pb;
#pragma unroll
                    for (int i = 0; i < 4; ++i) { pa[i] = __shfl_xor(a[i], 32); pb[i] = __shfl_xor(b[i], 32); }
                    const int pos = row < MREAL ? NMETA + (row & (SEQ - 1)) : row - MREAL;
                    const float* cs = ropec + pos * 16 + (dim & 15); const float* sn = ropes + pos * 16 + (dim & 15);
                    const f32x4 c0 = *(const f32x4*)cs, c1 = *(const f32x4*)(cs + 4), s0 = *(const f32x4*)sn, s1 = *(const f32x4*)(sn + 4);
                    if (dim < 16) { a = a * c0 - pa * s0; b = b * c1 - pb * s1; } else { a = a * c0 + pa * s0; b = b * c1 + pb * s1; }
                }
                if (col < 2048) { a = a * C2; b = b * C2; *(u32x4*)(Q + (size_t)row * DM + c) = pack8(a, b); }
                else {
                    const int h = c >> 8, mp = (c >> 7) & 1; const u32x4 w = pack8(a, b);
                    const size_t inner = (size_t)(dim >> 3) * 1024;
                    if (row < MREAL) { const int bb = row >> 12, j = row & (SEQ - 1), tile = 1 + (j >> 6), key = j & 63;
                        *(u32x4*)(Kimg + ((size_t)((bb * NH + h) * 2 + mp) * NTILE + tile) * KTILE_B + inner + key * 16) = w; }
                    else { const int key = row - MREAL;
#pragma unroll
                        for (int bb = 0; bb < NB; ++bb) *(u32x4*)(Kimg + ((size_t)((bb * NH + h) * 2 + mp) * NTILE) * KTILE_B + inner + key * 16) = w; }
                }
            } else if (col < 6144) {
                const int c = col - 4096, h = c >> 8, d = c & 255; const u32x4 w = pack8(a, b);
                if (row < MREAL) { const int bb = row >> 12, j = row & (SEQ - 1), tile = 1 + (j >> 6), key = j & 63;
                    *(u32x4*)(Vimg + ((size_t)(bb * NH + h) * NTILE + tile) * VTILE_B + ((key >> 3) * 8 + (d >> 5)) * 512 + (key & 7) * 64 + (d & 31) * 2) = w; }
                else { const int key = row - MREAL;
#pragma unroll
                    for (int bb = 0; bb < NB; ++bb) *(u32x4*)(Vimg + ((size_t)(bb * NH + h) * NTILE) * VTILE_B + ((key >> 3) * 8 + (d >> 5)) * 512 + (key & 7) * 64 + (d & 31) * 2) = w; }
            } else {
                const int c = col - 6144;
#pragma unroll
                for (int i = 0; i < 4; ++i) { a[i] = siluf(a[i]); b[i] = siluf(b[i]); }
                *(u32x4*)(G + (size_t)row * DM + c) = pack8(a, b);
            }
        } else if constexpr (MODE == 2 || MODE == 5) {
            *(u32x4*)(Y + (size_t)row * DM + col) = pack8(a, b);
        } else if constexpr (MODE == 3) {
            if (col < 2048) { *(u32x4*)(U + (size_t)row * DM + col) = pack8(a, b); }
            else { const int c = col - 2048;
#pragma unroll
                for (int i = 0; i < 4; ++i) { a[i] = siluf(a[i]); b[i] = siluf(b[i]); }
                *(u32x4*)(G1 + (size_t)row * DM + c) = pack8(a, b); }
        } else {
            const f32x4 s0 = *(const f32x4*)(pool_scale + col), s1 = *(const f32x4*)(pool_scale + col + 4);
            const u32x4 g = *(const u32x4*)(G1 + (size_t)row * DM + col);
            a[0] *= s0[0] * bflo(g.x); a[1] *= s0[1] * bfhi(g.x); a[2] *= s0[2] * bflo(g.y); a[3] *= s0[3] * bfhi(g.y);
            b[0] *= s1[0] * bflo(g.z); b[1] *= s1[1] * bfhi(g.z); b[2] *= s1[2] * bflo(g.w); b[3] *= s1[3] * bfhi(g.w);
            *(u32x4*)(GATED1 + (size_t)row * DM + col) = pack8(a, b);
        }
    }
    __device__ __forceinline__ void emit_rt(int row, int col, f32x4 a, f32x4 b) const {
        if (mode == 1) emit<1>(row, col, a, b); else if (mode == 2 || mode == 5) emit<2>(row, col, a, b); else if (mode == 3) emit<3>(row, col, a, b); else emit<4>(row, col, a, b);
    }
};

namespace pg8 {
constexpr int BM = 256, BK = 64, HALF = 128, HTB = HALF * BK * 2, STAGE_BYTES = 8 * HTB, NXCD = 8, WGM = 8;
__host__ __device__ __forceinline__ int lds_byte(int r, int c) { const int st = (r >> 4) * 2 + (c >> 5), rr = r & 15, cc = c & 31, ob = rr * 64 + cc * 2; return st * 1024 + (ob ^ (((ob >> 9) & 1) << 5)); }
__host__ __device__ __forceinline__ void stage_rc(int b, int& R, int& C) { const int st = b / 1024, sb = b % 1024, swz = sb ^ (((sb >> 9) & 1) << 5); R = (st >> 1) * 16 + swz / 64; C = (st & 1) * 32 + (swz % 64) / 2; }
__host__ __device__ __forceinline__ int perm32(int rho) { const int n = rho >> 4, i = rho & 15; return 8 * (i >> 2) + 4 * n + (i & 3); }
struct Unit { int pm, pn; };
struct Gemm { const bf16_t* A; const bf16_t* Bt; int M, N, K, lda, ldb, pn_per_grp, a_grp_cols; };
struct StaticOrder {
    int nM, nN, nwg, G, c;
    __device__ void init(int M, int N, int G_, int c_) { nM = M / BM; nN = N / BM; nwg = nM * nN; G = G_; c = c_; }
    __device__ bool next(int i, Unit& u) const {
        const long L = (long)i * G + c; if (L >= nwg) return false;
        int wgid = (int)L; { const int q = nwg / NXCD, r = nwg % NXCD, xcd = wgid % NXCD, off = wgid / NXCD; wgid = (xcd < r ? xcd * (q + 1) : r * (q + 1) + (xcd - r) * q) + off; }
        const int nig = WGM * nN, gid = wgid / nig, fm = gid * WGM, gsz = (nM - fm) < WGM ? (nM - fm) : WGM;
        u.pm = fm + ((wgid % nig) % gsz); u.pn = (wgid % nig) / gsz; return true;
    }
};
template <int MODE>
__device__ __forceinline__ void run_epi_m(const Epi& E, const f32x4 (&acc)[2][2][4][2], const Unit& u, int wr, int wc) {
    int lane = threadIdx.x & 63; asm volatile("" : "+v"(lane));
    const int fr = lane & 15, fq = lane >> 4;
#pragma unroll
    for (int ai = 0; ai < 2; ++ai)
#pragma unroll
        for (int m = 0; m < 4; ++m) { const int row = u.pm * BM + ai * HALF + wr * 64 + m * 16 + fr;
#pragma unroll
            for (int bj = 0; bj < 2; ++bj) { const int col = u.pn * BM + bj * HALF + wc * 32 + 8 * fq; E.emit<MODE>(row, col, acc[ai][bj][m][0], acc[ai][bj][m][1]); asm volatile("" ::: "memory"); } }
}
__device__ __forceinline__ void run_epi(const Epi& E, const f32x4 (&acc)[2][2][4][2], const Unit& u, int wr, int wc, int fr, int fq) {
    if (E.mode == 1) run_epi_m<1>(E, acc, u, wr, wc); else if (E.mode == 2 || E.mode == 5) run_epi_m<2>(E, acc, u, wr, wc);
    else if (E.mode == 3) run_epi_m<3>(E, acc, u, wr, wc); else run_epi_m<4>(E, acc, u, wr, wc);
}
template <bool ALIGN_EPI>
__device__ __forceinline__ void gemm_phase(LAS unsigned char* lds, const Gemm g, const StaticOrder& S, const Epi& E) {
    int tid_o = threadIdx.x; asm volatile("" : "+v"(tid_o));
    const int tid = tid_o, wid = __builtin_amdgcn_readfirstlane(tid >> 6), lane = tid & 63, wr = wid >> 2, wc = wid & 3, fr = lane & 15, fq = lane >> 4;
    const int K = g.K, nt = K / BK;
    unsigned voffA[2], voffB[2];
#pragma unroll
    for (int i = 0; i < 2; ++i) { int R, C; stage_rc(tid * 16 + i * 8192, R, C); const int Rb = (R & ~31) + perm32(R & 31);
        voffA[i] = (unsigned)(R * g.lda + C) * 2u; voffB[i] = (unsigned)(Rb * g.ldb + C) * 2u; }
    const size_t kstep = (size_t)(BK * 2);
    const size_t hstepA = (size_t)HALF * g.lda * 2, hstepB = (size_t)HALF * g.ldb * 2;
    const size_t tstepA = 2 * hstepA, tstepB = 2 * hstepB;
    const unsigned ldsw = (unsigned)wid * 1024u;
    const int aoff = lds_byte(wr * 64 + fr, fq * 8), boff = lds_byte(wc * 32 + fr, fq * 8);
#define PG8_SA(b, h) (((b) * 2 + (h)) * HTB)
#define PG8_SB(b, h) ((4 + (b) * 2 + (h)) * HTB)
#define PG8_STAGE(bufoff, gbase, voff) do { _Pragma("unroll") for (int _i = 0; _i < 2; ++_i) \
        __builtin_amdgcn_global_load_lds((const unsigned*)((const char*)(gbase) + (voff)[_i]), (LAS unsigned*)(lds + (bufoff) + ldsw + _i * 8192), 16, 0, 0); } while (0)
#define PG8_LDA(dst, b, h) do { _Pragma("unroll") for (int m = 0; m < 4; ++m) _Pragma("unroll") for (int k = 0; k < 2; ++k) dst[m][k] = *(const LAS bf16x8*)(lds + PG8_SA(b, h) + aoff + m * 2048 + k * 1024); } while (0)
#define PG8_LDB(dst, b, h) do { _Pragma("unroll") for (int n = 0; n < 2; ++n) _Pragma("unroll") for (int k = 0; k < 2; ++k) dst[n][k] = *(const LAS bf16x8*)(lds + PG8_SB(b, h) + boff + n * 2048 + k * 1024); } while (0)
#define PG8_MMA(ai, bj, At, Bt) do { __builtin_amdgcn_s_setprio(1); _Pragma("unroll") for (int m = 0; m < 4; ++m) _Pragma("unroll") for (int n = 0; n < 2; ++n) _Pragma("unroll") for (int k = 0; k < 2; ++k) \
        acc[ai][bj][m][n] = __builtin_amdgcn_mfma_f32_16x16x32_bf16(Bt[n][k], At[m][k], acc[ai][bj][m][n], 0, 0, 0); __builtin_amdgcn_s_setprio(0); } while (0)
#define PG8_WAIT_V(n) asm volatile("s_waitcnt vmcnt(" #n ")" ::: "memory")
#define PG8_WAIT_L(n) asm volatile("s_waitcnt lgkmcnt(" #n ")" ::: "memory")
#define PG8_BAR __builtin_amdgcn_s_barrier()
#define PG8_SCHED __builtin_amdgcn_sched_barrier(0)
#define PG8_ABASE(u) ((const char*)g.A + (size_t)(u).pm * tstepA + (size_t)((u).pn / g.pn_per_grp) * g.a_grp_cols * 2)
    Unit cur, nxt; int ui = 0;
    if (!S.next(0, cur)) return;
    f32x4 acc[2][2][4][2];
#pragma unroll
    for (int a = 0; a < 2; ++a)
#pragma unroll
        for (int b = 0; b < 2; ++b)
#pragma unroll
            for (int m = 0; m < 4; ++m)
#pragma unroll
                for (int n = 0; n < 2; ++n) acc[a][b][m][n] = (f32x4){0.f, 0.f, 0.f, 0.f};
    bf16x8 At[4][2], B0[2][2], B1[2][2];
    const char* cA = PG8_ABASE(cur); const char* cB = (const char*)g.Bt + (size_t)cur.pn * tstepB;
    PG8_STAGE(PG8_SB(0, 0), cB, voffB); PG8_STAGE(PG8_SB(0, 1), cB + hstepB, voffB); PG8_STAGE(PG8_SA(0, 0), cA, voffA); PG8_STAGE(PG8_SA(0, 1), cA + hstepA, voffA);
    if (wr == 1) PG8_BAR;
    PG8_WAIT_V(2); PG8_BAR;
    PG8_STAGE(PG8_SB(1, 0), cB + kstep, voffB); PG8_STAGE(PG8_SA(1, 0), cA + kstep, voffA); PG8_STAGE(PG8_SB(1, 1), cB + hstepB + kstep, voffB);
    PG8_WAIT_V(6); PG8_BAR;
    for (;;) {
        const bool has_next = S.next(ui + 1, nxt);
        const char* nA = has_next ? PG8_ABASE(nxt) : cA; const char* nB = has_next ? (const char*)g.Bt + (size_t)nxt.pn * tstepB : cB;
        for (int t = 0; t < nt; t += 2) {
            const bool last = (t == nt - 2);
            const char* a1 = cA + (size_t)(t + 1) * kstep;
            const char* a2 = last ? nA : cA + (size_t)(t + 2) * kstep; const char* b2 = last ? nB : cB + (size_t)(t + 2) * kstep;
            const char* a3 = a2 + kstep; const char* b3 = b2 + kstep;
            PG8_LDB(B0, 0, 0); PG8_LDB(B1, 0, 1); PG8_SCHED; PG8_LDA(At, 0, 0); PG8_STAGE(PG8_SA(1, 1), a1 + hstepA, voffA);
            PG8_WAIT_V(8); PG8_WAIT_L(0); PG8_BAR; PG8_MMA(0, 0, At, B0); PG8_MMA(0, 1, At, B1); PG8_BAR; PG8_SCHED;
            PG8_LDA(At, 0, 1); PG8_STAGE(PG8_SB(0, 0), b2, voffB); PG8_STAGE(PG8_SB(0, 1), b2 + hstepB, voffB); PG8_STAGE(PG8_SA(0, 0), a2, voffA);
            PG8_WAIT_V(8); PG8_WAIT_L(0); PG8_BAR; PG8_MMA(1, 0, At, B0); PG8_MMA(1, 1, At, B1); PG8_BAR; PG8_SCHED;
            PG8_LDB(B0, 1, 0); PG8_LDB(B1, 1, 1); PG8_SCHED; PG8_LDA(At, 1, 0); PG8_STAGE(PG8_SA(0, 1), a2 + hstepA, voffA);
            PG8_WAIT_V(8); PG8_WAIT_L(0); PG8_BAR; PG8_MMA(0, 0, At, B0); PG8_MMA(0, 1, At, B1); PG8_BAR; PG8_SCHED;
            PG8_LDA(At, 1, 1); PG8_STAGE(PG8_SB(1, 0), b3, voffB); PG8_STAGE(PG8_SB(1, 1), b3 + hstepB, voffB); PG8_STAGE(PG8_SA(1, 0), a3, voffA);
            PG8_WAIT_V(8); PG8_WAIT_L(0); PG8_BAR; PG8_MMA(1, 0, At, B0); PG8_MMA(1, 1, At, B1); PG8_BAR; PG8_SCHED;
        }
        if constexpr (ALIGN_EPI) { if (wr == 0) PG8_BAR; }
        run_epi(E, acc, cur, wr, wc, fr, fq);
        if (!has_next) break;
#pragma unroll
        for (int a = 0; a < 2; ++a)
#pragma unroll
            for (int b = 0; b < 2; ++b)
#pragma unroll
                for (int m = 0; m < 4; ++m)
#pragma unroll
                    for (int n = 0; n < 2; ++n) acc[a][b][m][n] = (f32x4){0.f, 0.f, 0.f, 0.f};
        cur = nxt; cA = nA; cB = nB; ++ui;
        if constexpr (ALIGN_EPI) { if (wr == 1) PG8_BAR; }
    }
    PG8_WAIT_V(0);
    if constexpr (!ALIGN_EPI) { if (wr == 0) PG8_BAR; }
    PG8_BAR;
#undef PG8_SA
#undef PG8_SB
#undef PG8_STAGE
#undef PG8_LDA
#undef PG8_LDB
#undef PG8_MMA
#undef PG8_WAIT_V
#undef PG8_WAIT_L
#undef PG8_BAR
#undef PG8_SCHED
#undef PG8_ABASE
}
}

typedef GAS unsigned gu32;
#define RLX_AGENT __ATOMIC_RELAXED, __HIP_MEMORY_SCOPE_AGENT
#define XB_TMO      128
#define XB_XCNT(j)  (256  + 64 * (j))
#define XB_XSUB(j)  (1280 + 64 * (j))
#define XB_XGEN(j)  (2304 + 64 * (j))
#define XB_TOP      3328
#define XB_TOPGEN   3392
#define XCD_BAR_WORDS 3456
#define XB_SPIN_CAP (1u << 18)
__device__ __forceinline__ unsigned xb_ld(unsigned* p)              { return __hip_atomic_load(p, __ATOMIC_RELAXED, __HIP_MEMORY_SCOPE_AGENT); }
__device__ __forceinline__ unsigned xb_add(unsigned* p, unsigned v) { return __hip_atomic_fetch_add(p, v, __ATOMIC_RELAXED, __HIP_MEMORY_SCOPE_AGENT); }
__device__ __forceinline__ unsigned xb_xcc_id() { return (unsigned)__builtin_amdgcn_s_getreg((3 << 11) | 20) & 0xFu; }
#define XB_SPIN(cond, bar) do { unsigned _sp = 0; while (cond) { __builtin_amdgcn_s_sleep(1); \
    if ((++_sp & 255u) == 0u) { if (xb_ld(&(bar)[XB_TMO])) break; if (_sp > XB_SPIN_CAP) { atomicAdd(&(bar)[XB_TMO], 1u); break; } } } } while (0)
struct XcdBarrier { unsigned* bar; unsigned x; volatile LAS unsigned* st; };
__device__ __forceinline__ XcdBarrier xcd_barrier_post(unsigned* bar, volatile LAS unsigned* st) {
    XcdBarrier b; b.bar = bar; b.x = xb_xcc_id(); b.st = st;
    if (threadIdx.x == 0) (void)xb_add(&bar[XB_XCNT(b.x)], 1u);
    return b;
}
__device__ __forceinline__ void xcd_barrier_complete(unsigned* bar, unsigned x, unsigned& nloc, unsigned& nx) {
    const unsigned G = gridDim.x * gridDim.y * gridDim.z;
    unsigned sum, cnt, mine, sp = 0u;
    for (;;) {
        sum = 0u; cnt = 0u; mine = 0u;
#pragma unroll
        for (unsigned j = 0; j < 16; ++j) { const unsigned c = xb_ld(&bar[XB_XCNT(j)]); sum += c; cnt += (c > 0u) ? 1u : 0u; mine = (j == x) ? c : mine; }
        if (sum == G) break;
        __builtin_amdgcn_s_sleep(1);
        if ((++sp & 255u) == 0u) { if (xb_ld(&bar[XB_TMO])) break; if (sp > XB_SPIN_CAP) { atomicAdd(&bar[XB_TMO], 1u); break; } }
    }
    nloc = mine > 0u ? mine : 1u; nx = cnt > 0u ? cnt : 1u;
}
__device__ __forceinline__ void xcd_barrier(const XcdBarrier& b) {
    asm volatile("s_waitcnt vmcnt(0)" ::: "memory");
    __syncthreads();
    if (threadIdx.x == 0) {
        unsigned* bar = b.bar;
        __builtin_amdgcn_s_waitcnt(0);
        unsigned nloc = b.st[0], nx = b.st[1];
        if (nloc == 0u) { xcd_barrier_complete(bar, b.x, nloc, nx); b.st[0] = nloc; b.st[1] = nx; }
        const unsigned old = xb_add(&bar[XB_XSUB(b.x)], 1u);
        const unsigned gen = old / nloc;
        if (old + 1u == (gen + 1u) * nloc) {
            __builtin_amdgcn_fence(__ATOMIC_RELEASE, "agent");
            asm volatile("s_waitcnt vmcnt(0)" ::: "memory");
            const unsigned og = xb_add(&bar[XB_TOP], 1u);
            const unsigned tg = og / nx;
            if (og + 1u == (tg + 1u) * nx) xb_add(&bar[XB_TOPGEN], 1u);
            else XB_SPIN(xb_ld(&bar[XB_TOPGEN]) == tg, bar);
            __builtin_amdgcn_fence(__ATOMIC_ACQUIRE, "agent");
            xb_add(&bar[XB_XGEN(b.x)], 1u);
            asm volatile("s_waitcnt vmcnt(0)" ::: "memory");
        } else {
            XB_SPIN(xb_ld(&bar[XB_XGEN(b.x)]) == gen, bar);
            __builtin_amdgcn_fence(__ATOMIC_ACQUIRE, "agent");
            asm volatile("s_waitcnt vmcnt(0)" ::: "memory");
        }
    }
    __syncthreads();
}

struct Args {
    const float* in[15]; float* out; unsigned char* ws;
    float inv_freq[16];
    int ph_lo, ph_hi, li, pad;
};
struct Frame {
    LAS unsigned char* lds; int tid, lane, wave, vcu, G;
};

__device__ __forceinline__ void p0_transpose_item(const float* W, int N, bf16_t* WT, int ldt, int row_off, LAS float* scr, int item, int lane) {
    const int nblk = N / 32, kb = item / nblk, nb = item % nblk, k0 = 64 * kb, n0 = 32 * nb;
#pragma unroll 8
    for (int i = 0; i < 32; ++i) { const int kk = 2 * i + (lane >> 5); scr[kk * 33 + (lane & 31)] = W[(size_t)(k0 + kk) * N + n0 + (lane & 31)]; }
    asm volatile("s_waitcnt lgkmcnt(0)" ::: "memory");
    const int c = lane & 7;
#pragma unroll
    for (int j = 0; j < 4; ++j) { const int n = (lane >> 3) + 8 * j; const LAS float* s = scr + (8 * c) * 33 + n;
        u32x4 o; o.x = pk2(s[0 * 33], s[1 * 33]); o.y = pk2(s[2 * 33], s[3 * 33]); o.z = pk2(s[4 * 33], s[5 * 33]); o.w = pk2(s[6 * 33], s[7 * 33]);
        *(u32x4*)(WT + (size_t)(row_off + n0 + n) * ldt + k0 + 8 * c) = o; }
    asm volatile("s_waitcnt lgkmcnt(0)" ::: "memory");
}
__device__ __forceinline__ void load_row(const float* p, int lane, f32x4 (&v)[8]) {
#pragma unroll
    for (int j = 0; j < 8; ++j) v[j] = *(const f32x4*)(p + 4 * (64 * j + lane));
}
__device__ __forceinline__ void load_row_bf16(const bf16_t* p, int lane, f32x4 (&v)[8]) {
#pragma unroll
    for (int j = 0; j < 8; ++j) { const u32x2 w = *(const u32x2*)(p + 4 * (64 * j + lane)); v[j] = (f32x4){bflo(w.x), bfhi(w.x), bflo(w.y), bfhi(w.y)}; }
}
__device__ __forceinline__ float row_ss(const f32x4 (&v)[8]) {
    float s = 0.f;
#pragma unroll
    for (int j = 0; j < 8; ++j) s += (v[j][0] * v[j][0] + v[j][1] * v[j][1]) + (v[j][2] * v[j][2] + v[j][3] * v[j][3]);
    return wave_sum(s);
}
__device__ __forceinline__ void store_row_bf16(bf16_t* p, int lane, const f32x4 (&v)[8]) {
#pragma unroll
    for (int j = 0; j < 8; ++j) { u32x2 w; w.x = pk2(v[j][0], v[j][1]); w.y = pk2(v[j][2], v[j][3]); *(u32x2*)(p + 4 * (64 * j + lane)) = w; }
}

__device__ __forceinline__ void rows16_phase(const Frame& F, const bf16_t* A16, int lda, const bf16_t* Bt, int ldb, int K, int ntasks, int a_grp_cols, int tasks_per_grp, const Epi& E) {
    int lane_o = threadIdx.x & 63; asm volatile("" : "+v"(lane_o));
    const int lane = lane_o, m = lane & 15, fq = lane >> 4;
    LAS float* red = (LAS float*)F.lds;
    const int stride = F.G / ntasks > 0 ? F.G / ntasks : 1;
    for (int task0 = F.vcu; task0 < ntasks * stride; task0 += F.G) {
        if (task0 % stride) continue;
        const int task = task0 / stride;
        const int n0 = task * 32, kslice = K / 8, kb = F.wave * kslice;
        const bf16_t* ap = A16 + (size_t)m * lda + (task / tasks_per_grp) * a_grp_cols + kb + 8 * fq;
        const bf16_t* bp0 = Bt + (size_t)(n0 + 8 * (m >> 2) + (m & 3)) * ldb + kb + 8 * fq;
        const bf16_t* bp1 = bp0 + (size_t)4 * ldb;
        f32x4 acc0 = {0.f, 0.f, 0.f, 0.f}, acc1 = {0.f, 0.f, 0.f, 0.f};
        for (int ks = 0; ks < kslice; ks += 32) {
            const bf16x8 a = *(const bf16x8*)(ap + ks), b0 = *(const bf16x8*)(bp0 + ks), b1 = *(const bf16x8*)(bp1 + ks);
            acc0 = __builtin_amdgcn_mfma_f32_16x16x32_bf16(b0, a, acc0, 0, 0, 0);
            acc1 = __builtin_amdgcn_mfma_f32_16x16x32_bf16(b1, a, acc1, 0, 0, 0);
        }
        *(LAS f32x4*)(red + (F.wave * 2 + 0) * 256 + lane * 4) = acc0;
        *(LAS f32x4*)(red + (F.wave * 2 + 1) * 256 + lane * 4) = acc1;
        __syncthreads();
        if (F.wave == 0) {
            f32x4 s0 = {0.f, 0.f, 0.f, 0.f}, s1 = {0.f, 0.f, 0.f, 0.f};
#pragma unroll
            for (int w = 0; w < 8; ++w) { s0 += *(const LAS f32x4*)(red + (w * 2 + 0) * 256 + lane * 4); s1 += *(const LAS f32x4*)(red + (w * 2 + 1) * 256 + lane * 4); }
            E.emit_rt(MREAL + m, n0 + 8 * fq, s0, s1);
        }
        __syncthreads();
    }
}

template <int W> __device__ __forceinline__ void mix_strip(const bf16_t* U, bf16_t* MIXo, int strip, int c0) {
    const int row0 = strip * 16, bb = row0 >> 12, p0 = NMETA + (row0 & (SEQ - 1));
    u32x4 buf[W - 1 + 16];
#pragma unroll
    for (int i = 0; i < W - 1 + 16; ++i) { const int pp = p0 - (W - 1) + i; const int r = pp >= NMETA ? bb * SEQ + pp - NMETA : MREAL + pp;
        buf[i] = *(const u32x4*)(U + (size_t)r * DM + c0); }
    float s[8] = {0.f, 0.f, 0.f, 0.f, 0.f, 0.f, 0.f, 0.f};
#define MIX_UNPK(v, f) const float f[8] = {bflo(v.x), bfhi(v.x), bflo(v.y), bfhi(v.y), bflo(v.z), bfhi(v.z), bflo(v.w), bfhi(v.w)}
#pragma unroll
    for (int i = 0; i < W - 1; ++i) { MIX_UNPK(buf[i], f);
#pragma unroll
        for (int k = 0; k < 8; ++k) s[k] += f[k]; }
    constexpr float iw = 1.0f / (float)W;
#pragma unroll
    for (int t = 0; t < 16; ++t) {
        MIX_UNPK(buf[W - 1 + t], f);
#pragma unroll
        for (int k = 0; k < 8; ++k) s[k] += f[k];
        u32x4 o; o.x = pk2(s[0] * iw - f[0], s[1] * iw - f[1]); o.y = pk2(s[2] * iw - f[2], s[3] * iw - f[3]);
        o.z = pk2(s[4] * iw - f[4], s[5] * iw - f[5]); o.w = pk2(s[6] * iw - f[6], s[7] * iw - f[7]);
        *(u32x4*)(MIXo + (size_t)(row0 + t) * DM + c0) = o;
        MIX_UNPK(buf[t], g);
#pragma unroll
        for (int k = 0; k < 8; ++k) s[k] -= g[k];
    }
#undef MIX_UNPK
}

namespace att {
__device__ __forceinline__ int crow(int r, int hi) { return (r & 3) + 8 * (r >> 2) + 4 * hi; }
__device__ __forceinline__ float xch32(float v) { return __shfl_xor(v, 32); }
#ifndef ATT_VPREFETCH
#define ATT_VPREFETCH 1
#endif
#ifndef ATT_PROBE
#define ATT_PROBE 0
#endif
#ifndef ATT_STAGGER
#define ATT_STAGGER 1
#endif
#ifndef ATT_SETPRIO
#define ATT_SETPRIO 0
#endif
constexpr float THRL = 6.0f;
template <int OFF> __device__ __forceinline__ s16x4 tr_read(int vb) {
    s16x4 r; asm volatile("ds_read_b64_tr_b16 %0, %1 offset:%2" : "=&v"(r) : "v"(vb), "i"(OFF) : "memory"); return r;
}
template <int D0> __device__ __forceinline__ void pv_read(s16x4 (&v)[8], int vb) {
    v[0] = tr_read<(0 * 8 + D0) * 512>(vb); v[1] = tr_read<(1 * 8 + D0) * 512>(vb); v[2] = tr_read<(2 * 8 + D0) * 512>(vb); v[3] = tr_read<(3 * 8 + D0) * 512>(vb);
    v[4] = tr_read<(4 * 8 + D0) * 512>(vb); v[5] = tr_read<(5 * 8 + D0) * 512>(vb); v[6] = tr_read<(6 * 8 + D0) * 512>(vb); v[7] = tr_read<(7 * 8 + D0) * 512>(vb);
}
__device__ __forceinline__ void pv_mma(f32x16& od, const s16x4 (&v)[8], const u32x4 (&pw)[4]) {
#define ATT_PK(L, H) (bf16x8){L[0], L[1], L[2], L[3], H[0], H[1], H[2], H[3]}
    if (ATT_SETPRIO) __builtin_amdgcn_s_setprio(1);
    od = __builtin_amdgcn_mfma_f32_32x32x16_bf16(ATT_PK(v[0], v[1]), __builtin_bit_cast(bf16x8, pw[0]), od, 0, 0, 0);
    od = __builtin_amdgcn_mfma_f32_32x32x16_bf16(ATT_PK(v[2], v[3]), __builtin_bit_cast(bf16x8, pw[1]), od, 0, 0, 0);
    od = __builtin_amdgcn_mfma_f32_32x32x16_bf16(ATT_PK(v[4], v[5]), __builtin_bit_cast(bf16x8, pw[2]), od, 0, 0, 0);
    od = __builtin_amdgcn_mfma_f32_32x32x16_bf16(ATT_PK(v[6], v[7]), __builtin_bit_cast(bf16x8, pw[3]), od, 0, 0, 0);
    if (ATT_SETPRIO) __builtin_amdgcn_s_setprio(0);
#undef ATT_PK
}
#define ATT_WL(n) do { __builtin_amdgcn_sched_barrier(0); asm volatile("s_waitcnt lgkmcnt(" #n ")" ::: "memory"); __builtin_amdgcn_sched_barrier(0); } while (0)
__device__ __forceinline__ void pv_all(f32x16 (&o)[8], int vb, const u32x4 (&pw)[4]) {
#if ATT_VPREFETCH
    s16x4 va[8], vc[8];
    pv_read<0>(va, vb); ATT_WL(0);
    pv_read<1>(vc, vb); pv_mma(o[0], va, pw); ATT_WL(0);
    pv_read<2>(va, vb); pv_mma(o[1], vc, pw); ATT_WL(0);
    pv_read<3>(vc, vb); pv_mma(o[2], va, pw); ATT_WL(0);
    pv_read<4>(va, vb); pv_mma(o[3], vc, pw); ATT_WL(0);
    pv_read<5>(vc, vb); pv_mma(o[4], va, pw); ATT_WL(0);
    pv_read<6>(va, vb); pv_mma(o[5], vc, pw); ATT_WL(0);
    pv_read<7>(vc, vb); pv_mma(o[6], va, pw); ATT_WL(0);
    pv_mma(o[7], vc, pw);
#else
    s16x4 va[8];
    pv_read<0>(va, vb); ATT_WL(0); pv_mma(o[0], va, pw);
    pv_read<1>(va, vb); ATT_WL(0); pv_mma(o[1], va, pw);
    pv_read<2>(va, vb); ATT_WL(0); pv_mma(o[2], va, pw);
    pv_read<3>(va, vb); ATT_WL(0); pv_mma(o[3], va, pw);
    pv_read<4>(va, vb); ATT_WL(0); pv_mma(o[4], va, pw);
    pv_read<5>(va, vb); ATT_WL(0); pv_mma(o[5], va, pw);
    pv_read<6>(va, vb); ATT_WL(0); pv_mma(o[6], va, pw);
    pv_read<7>(va, vb); ATT_WL(0); pv_mma(o[7], va, pw);
#endif
}
template <int OFF> __device__ __forceinline__ bf16x8 k_read1(int kb) {
    bf16x8 r; asm volatile("ds_read_b128 %0, %1 offset:%2" : "=&v"(r) : "v"(kb), "i"(OFF) : "memory"); return r;
}
template <int G> __device__ __forceinline__ void k_read(bf16x8 (&k)[4], int kb) {
    k[0] = k_read1<(2 * G) * 2048>(kb); k[1] = k_read1<(2 * G) * 2048 + 512>(kb); k[2] = k_read1<(2 * G + 1) * 2048>(kb); k[3] = k_read1<(2 * G + 1) * 2048 + 512>(kb);
}
template <int G> __device__ __forceinline__ void qk_mma(f32x16& p0, f32x16& p1, const bf16x8 (&k)[4], const bf16x8 (&qr)[8]) {
    p0 = __builtin_amdgcn_mfma_f32_32x32x16_bf16(k[0], qr[2 * G], p0, 0, 0, 0);
    p1 = __builtin_amdgcn_mfma_f32_32x32x16_bf16(k[1], qr[2 * G], p1, 0, 0, 0);
    p0 = __builtin_amdgcn_mfma_f32_32x32x16_bf16(k[2], qr[2 * G + 1], p0, 0, 0, 0);
    p1 = __builtin_amdgcn_mfma_f32_32x32x16_bf16(k[3], qr[2 * G + 1], p1, 0, 0, 0);
}
__device__ __forceinline__ void qk_sm(f32x16 (&o)[8], float& m_run, float& l_run, u32x4 (&pw)[4], const LAS unsigned char* Kst, const bf16x8 (&qr)[8], bool meta_tile) {
    f32x16 p0 = (f32x16){0.f, 0.f, 0.f, 0.f, 0.f, 0.f, 0.f, 0.f, 0.f, 0.f, 0.f, 0.f, 0.f, 0.f, 0.f, 0.f}, p1 = p0;
    {
        const int kb = (int)(unsigned)(uintptr_t)Kst;
        bf16x8 ka[4], kc[4];
        k_read<0>(ka, kb); ATT_WL(0);
        k_read<1>(kc, kb); qk_mma<0>(p0, p1, ka, qr); ATT_WL(0);
        k_read<2>(ka, kb); qk_mma<1>(p0, p1, kc, qr); ATT_WL(0);
        k_read<3>(kc, kb); qk_mma<2>(p0, p1, ka, qr); ATT_WL(0);
        qk_mma<3>(p0, p1, kc, qr);
    }
    if (ATT_PROBE == 2) {
        asm volatile("" : "+v"(p0), "+v"(p1));
        p0 = (f32x16){0.f, 0.f, 0.f, 0.f, 0.f, 0.f, 0.f, 0.f, 0.f, 0.f, 0.f, 0.f, 0.f, 0.f, 0.f, 0.f}; p1 = p0;
#pragma unroll
        for (int d0 = 0; d0 < 8; ++d0) {
            const bf16x8 a0 = *(const LAS bf16x8*)(Kst + d0 * 2048), a1 = *(const LAS bf16x8*)(Kst + d0 * 2048 + 512);
            p0 = __builtin_amdgcn_mfma_f32_32x32x16_bf16(a0, qr[d0], p0, 0, 0, 0);
            p1 = __builtin_amdgcn_mfma_f32_32x32x16_bf16(a1, qr[d0], p1, 0, 0, 0);
        }
    }
    if (meta_tile) {
#pragma unroll
        for (int r = 8; r < 16; ++r) p0[r] = -INFINITY;
#pragma unroll
        for (int r = 0; r < 16; ++r) p1[r] = -INFINITY;
    }
    float rm = fmaxf(fmaxf(p0[0], p0[1]), p0[2]);
#pragma unroll
    for (int r = 3; r < 15; r += 2) rm = fmaxf(fmaxf(rm, p0[r]), p0[r + 1]);
    rm = fmaxf(rm, p0[15]);
#pragma unroll
    for (int r = 0; r < 16; r += 2) rm = fmaxf(fmaxf(rm, p1[r]), p1[r + 1]);
    rm = fmaxf(rm, xch32(rm));
    if (__any(rm > m_run + THRL)) {
        const float mn = fmaxf(m_run, rm), alpha = __builtin_amdgcn_exp2f(m_run - mn);
        m_run = mn; l_run *= alpha;
#pragma unroll
        for (int d = 0; d < 8; ++d)
#pragma unroll
            for (int r = 0; r < 16; ++r) o[d][r] *= alpha;
    }
    float ps = 0.f;
#pragma unroll
    for (int r = 0; r < 16; ++r) { float xx = p0[r] - m_run; p0[r] = __builtin_amdgcn_exp2f(xx); if (ATT_PROBE == 3) { asm volatile("" : "+v"(xx)); p0[r] = (p0[r] + __builtin_amdgcn_exp2f(xx)) * 0.5f; } ps += p0[r]; }
#pragma unroll
    for (int r = 0; r < 16; ++r) { float xx = p1[r] - m_run; p1[r] = __builtin_amdgcn_exp2f(xx); if (ATT_PROBE == 3) { asm volatile("" : "+v"(xx)); p1[r] = (p1[r] + __builtin_amdgcn_exp2f(xx)) * 0.5f; } ps += p1[r]; }
    l_run += ps;
    pw[0] = (u32x4){pk2(p0[0], p0[1]), pk2(p0[2], p0[3]), pk2(p0[4], p0[5]), pk2(p0[6], p0[7])};
    pw[1] = (u32x4){pk2(p0[8], p0[9]), pk2(p0[10], p0[11]), pk2(p0[12], p0[13]), pk2(p0[14], p0[15])};
    pw[2] = (u32x4){pk2(p1[0], p1[1]), pk2(p1[2], p1[3]), pk2(p1[4], p1[5]), pk2(p1[6], p1[7])};
    pw[3] = (u32x4){pk2(p1[8], p1[9]), pk2(p1[10], p1[11]), pk2(p1[12], p1[13]), pk2(p1[14], p1[15])};
}
__device__ __forceinline__ void attn_unit(const Frame& F, const bf16_t* Q, const unsigned char* Kimg, const unsigned char* Vimg, const bf16_t* Gt, bf16_t* O,
                                          const float* subln_g, int b, int h, int qb, int desc) {
    LAS unsigned char* lds = F.lds;
    int lane_o = threadIdx.x & 63; asm volatile("" : "+v"(lane_o));
    const int lane = lane_o, r32 = lane & 31, hi = lane >> 5, wid = F.wave, mp = wid >> 2, rg = wid & 3;
    const bool meta = qb < 0;
    const size_t qrow = meta ? (size_t)(MREAL + (r32 & 15)) : (size_t)b * SEQ + qb * 128 + rg * 32 + r32;
    const int NT = meta ? 1 : 2 * qb + 3;
    const int tmax = meta ? 0 : 2 * qb + 1 + (rg >> 1);
    bf16x8 qr[8];
    { const bf16_t* qp = Q + qrow * DM + h * 256 + mp * 128 + hi * 8;
#pragma unroll
      for (int d0 = 0; d0 < 8; ++d0) qr[d0] = *(const bf16x8*)(qp + 16 * d0); }
    const int bsel = meta ? 0 : b;
    const unsigned char* srcK = Kimg + ((size_t)((bsel * NH + h) * 2 + mp) * NTILE) * KTILE_B + rg * 4096 + lane * 16;
    const unsigned char* srcV = Vimg + ((size_t)(bsel * NH + h) * NTILE) * VTILE_B + wid * 4096 + lane * 16;
#define ATT_TILE(k) (desc ? NT - 1 - (k) : (k))
#define ATT_DMA_K(k) do { const int _tl = ATT_TILE(k); _Pragma("unroll") for (int _i = 0; _i < (ATT_PROBE == 1 ? 8 : 4); ++_i) \
        __builtin_amdgcn_global_load_lds((const unsigned*)(srcK + (size_t)_tl * KTILE_B + (_i & 3) * 1024), (LAS unsigned*)(lds + ((k) & 1) * 32768 + wid * 4096 + (_i & 3) * 1024), 16, 0, 0); } while (0)
#define ATT_DMA_V(k) do { const int _tl = ATT_TILE(k); _Pragma("unroll") for (int _i = 0; _i < (ATT_PROBE == 1 ? 8 : 4); ++_i) \
        __builtin_amdgcn_global_load_lds((const unsigned*)(srcV + (size_t)_tl * VTILE_B + (_i & 3) * 1024), (LAS unsigned*)(lds + 65536 + ((k) & 1) * 32768 + wid * 4096 + (_i & 3) * 1024), 16, 0, 0); } while (0)
#define ATT_WAITBAR(n) do { if (ATT_PROBE == 1 && n == 4) asm volatile("s_waitcnt vmcnt(8)" ::: "memory"); else asm volatile("s_waitcnt vmcnt(" #n ")" ::: "memory"); __builtin_amdgcn_s_barrier(); asm volatile("" ::: "memory"); } while (0)
    f32x16 o[8];
#pragma unroll
    for (int d = 0; d < 8; ++d) o[d] = (f32x16){0.f, 0.f, 0.f, 0.f, 0.f, 0.f, 0.f, 0.f, 0.f, 0.f, 0.f, 0.f, 0.f, 0.f, 0.f, 0.f};
    float m_run = -1e30f, l_run = 0.f;
    u32x4 pw[4] = {{0u, 0u, 0u, 0u}, {0u, 0u, 0u, 0u}, {0u, 0u, 0u, 0u}, {0u, 0u, 0u, 0u}};
    const int vbase = (4 * hi + ((lane & 15) >> 2)) * 64 + ((lane >> 4) & 1) * 32 + (lane & 3) * 8;
    const int kbase = mp * KTILE_B + hi * 1024 + r32 * 16;
    ATT_DMA_K(0); ATT_DMA_V(0);
#define ATT_VADDR(tt) ((int)(unsigned)(uintptr_t)(lds + 65536 + ((tt) & 1) * 32768 + vbase))
    if (mp == 0 || !ATT_STAGGER) {
        for (int t = 0; t < NT; ++t) {
            const int tl = ATT_TILE(t);
            ATT_WAITBAR(4);
            if (t + 1 < NT) ATT_DMA_K(t + 1);
            if (tl <= tmax) qk_sm(o, m_run, l_run, pw, lds + (t & 1) * 32768 + kbase, qr, tl == 0);
            if (t + 1 < NT) { ATT_WAITBAR(4); ATT_DMA_V(t + 1); } else ATT_WAITBAR(0);
            if (tl <= tmax) pv_all(o, ATT_VADDR(t), pw);
        }
        ATT_WAITBAR(0);
    } else {
        for (int t = 0; t < NT; ++t) {
            const int tl = ATT_TILE(t);
            ATT_WAITBAR(4);
            if (t + 1 < NT) ATT_DMA_K(t + 1);
            if (t >= 1 && ATT_TILE(t - 1) <= tmax) pv_all(o, ATT_VADDR(t - 1), pw);
            if (t + 1 < NT) { ATT_WAITBAR(4); ATT_DMA_V(t + 1); } else ATT_WAITBAR(0);
            if (tl <= tmax) qk_sm(o, m_run, l_run, pw, lds + (t & 1) * 32768 + kbase, qr, tl == 0);
        }
        ATT_WAITBAR(0);
        if (ATT_TILE(NT - 1) <= tmax) pv_all(o, ATT_VADDR(NT - 1), pw);
    }
#undef ATT_VADDR
    asm volatile("s_waitcnt vmcnt(0) lgkmcnt(0)" ::: "memory"); __builtin_amdgcn_s_barrier(); asm volatile("" ::: "memory");
    const float ltot = l_run + xch32(l_run);
    const float inv = __builtin_amdgcn_rcpf(ltot);
    LAS float* xb = (LAS float*)lds + (size_t)rg * 8192;
    if (mp == 1) {
        const float sc = *(const LAS float*)(lds + MISC_OFF + 64) * inv;
#pragma unroll
        for (int d = 0; d < 8; ++d) {
#pragma unroll
            for (int r = 0; r < 16; ++r) xb[(d * 16 + r) * 64 + lane] = o[d][r] * sc;
            asm volatile("" ::: "memory"); }
    }
    asm volatile("s_waitcnt lgkmcnt(0)" ::: "memory"); __builtin_amdgcn_s_barrier(); asm volatile("" ::: "memory");
    if (mp == 0) {
        float ss = 0.f;
#pragma unroll
        for (int d = 0; d < 8; ++d) {
#pragma unroll
            for (int r = 0; r < 16; ++r) { const float v = o[d][r] * inv - xb[(d * 16 + r) * 64 + lane]; o[d][r] = v; ss = fmaf(v, v, ss); }
            asm volatile("" : "+v"(ss) :: "memory"); }
        ss += xch32(ss);
        const float rstd = __builtin_amdgcn_rsqf(ss * (1.0f / 256.0f) + RMS_EPS) * 0.8f;
        const bool valid = !meta || r32 < 16;
        const bf16_t* gp = Gt + qrow * DM + h * 256; bf16_t* op = O + qrow * DM + h * 256;
#pragma unroll
        for (int d = 0; d < 8; ++d)
#pragma unroll
            for (int rq = 0; rq < 4; ++rq) {
                const int dd = 32 * d + 8 * rq + 4 * hi;
                const u32x2 g = *(const u32x2*)(gp + dd); const f32x4 sg = *(const f32x4*)(subln_g + dd);
                const float v0 = o[d][4 * rq + 0] * rstd * sg[0] * bflo(g.x), v1 = o[d][4 * rq + 1] * rstd * sg[1] * bfhi(g.x);
                const float v2 = o[d][4 * rq + 2] * rstd * sg[2] * bflo(g.y), v3 = o[d][4 * rq + 3] * rstd * sg[3] * bfhi(g.y);
                u32x2 w; w.x = pk2(v0, v1); w.y = pk2(v2, v3);
                if (valid) *(u32x2*)(op + dd) = w;
                asm volatile("" ::: "memory");
            }
    }
    asm volatile("s_waitcnt vmcnt(0) lgkmcnt(0)" ::: "memory"); __builtin_amdgcn_s_barrier(); asm volatile("" ::: "memory");
#undef ATT_TILE
#undef ATT_DMA_K
#undef ATT_DMA_V
#undef ATT_WAITBAR
}
#undef ATT_WL
}

__global__ void __launch_bounds__(512, 2) trunk_fwd(Args args) {
    extern __shared__ __attribute__((aligned(16))) unsigned char lds_raw[];
    Frame F;
    F.lds = (LAS unsigned char*)lds_raw;
    F.tid = threadIdx.x; F.lane = F.tid & 63; F.wave = __builtin_amdgcn_readfirstlane(F.tid >> 6);
    F.G = gridDim.x; { const int bx = blockIdx.x; F.vcu = (F.G % 8 == 0) ? (bx % 8) * (F.G / 8) + bx / 8 : bx; }
    volatile LAS unsigned* MISC = (volatile LAS unsigned*)(F.lds + MISC_OFF);
    unsigned char* ws = args.ws;
    gu32* ctl = (gu32*)(ws + WS_CTL);
    for (int u = F.tid; u < (LDS_BYTES - LDSCTL_OFF) / 4; u += 512) ((LAS unsigned*)(F.lds + LDSCTL_OFF))[u] = 0u;
    __syncthreads();
    XcdBarrier bar; bar.bar = (unsigned*)(ctl + CW_BAR); bar.x = 0; bar.st = nullptr;
    if (MK_N_LAUNCHES == 1) bar = xcd_barrier_post((unsigned*)(ctl + CW_BAR), MISC + 8);
#define GRID_BAR() do { if (MK_N_LAUNCHES == 1) xcd_barrier(bar); } while (0)
    const int lo = args.ph_lo, hi = args.ph_hi;
#define IN(k) (lo <= (k) && (k) < hi)
#define REPS(k) for (int rep_ = 0; rep_ < ((k) == PROBE_PH ? 1 + PROBE_REP : 1); ++rep_)

    const float* x = args.in[0]; const float* meta_tok = args.in[1]; const float* pre_g = args.in[2]; const float* post_g = args.in[3];
    const float* attn_w_in = args.in[4]; const float* attn_w_out = args.in[5];
    const float* lq1 = args.in[6]; const float* lk1 = args.in[7]; const float* lq2 = args.in[8]; const float* lk2 = args.in[9];
    const float* subln_g = args.in[10];
    const float* pool_w_in = args.in[11]; const float* pool_w_group = args.in[12]; const float* pool_scale = args.in[13]; const float* pool_w_out = args.in[14];
    bf16_t* W1 = (bf16_t*)(ws + WS_W1); bf16_t* W2 = (bf16_t*)(ws + WS_W2); bf16_t* W3 = (bf16_t*)(ws + WS_W3); bf16_t* W4 = (bf16_t*)(ws + WS_W4); bf16_t* W5 = (bf16_t*)(ws + WS_W5);
    bf16_t* XN = (bf16_t*)(ws + WS_XN); bf16_t* GB = (bf16_t*)(ws + WS_G); bf16_t* QO = (bf16_t*)(ws + WS_QO);
    unsigned char* Kimg = ws + WS_K; unsigned char* Vimg = ws + WS_V;
    bf16_t* Y0 = (bf16_t*)(ws + WS_Y0); bf16_t* Y1 = (bf16_t*)(ws + WS_Y1);
    bf16_t* UB = (bf16_t*)(ws + WS_U); bf16_t* G1 = (bf16_t*)(ws + WS_G1); bf16_t* MIX = (bf16_t*)(ws + WS_MIX); bf16_t* GATED1 = (bf16_t*)(ws + WS_GATED1);
    float* ropec = (float*)(ws + WS_ROPEC); float* ropes = (float*)(ws + WS_ROPES); float* rstd0 = (float*)(ws + WS_RSTD0);
    const int gw = F.vcu * 8 + F.wave, NGW = F.G * 8;
    const int gtid = F.vcu * 512 + F.tid, NGT = F.G * 512;

    Epi E; E.mode = 0; E.Q = QO; E.Kimg = Kimg; E.Vimg = Vimg; E.G = GB; E.ropec = ropec; E.ropes = ropes; E.Y = Y0; E.U = UB; E.G1 = G1; E.GATED1 = GATED1; E.pool_scale = pool_scale;

    if (IN(0)) REPS(0) {
        LAS float* scr = (LAS float*)(F.lds + F.wave * 16384);
        constexpr int I1 = (DM / 64) * (4 * DM / 32), I2 = (DM / 64) * (DM / 32), I3 = (DM / 64) * (2 * DM / 32), I4 = (512 / 64) * (512 / 32), I5 = I2;
        constexpr int NITEMS = I1 + I2 + I3 + 4 * I4 + I5;
        for (int it = gw; it < NITEMS; it += NGW) {
            int r = it;
            if (r < I1) { p0_transpose_item(attn_w_in, 4 * DM, W1, DM, 0, scr, r, F.lane); continue; } r -= I1;
            if (r < I2) { p0_transpose_item(attn_w_out, DM, W2, DM, 0, scr, r, F.lane); continue; } r -= I2;
            if (r < I3) { p0_transpose_item(pool_w_in, 2 * DM, W3, DM, 0, scr, r, F.lane); continue; } r -= I3;
            if (r < 4 * I4) { const int g = r / I4; p0_transpose_item(pool_w_group + (size_t)g * 512 * 512, 512, W4, 512, g * 512, scr, r % I4, F.lane); continue; } r -= 4 * I4;
            p0_transpose_item(pool_w_out, DM, W5, DM, 0, scr, r, F.lane);
        }
        for (int i = gtid; i < LTOT * 16; i += NGT) {
            const int pos = i >> 4, k = i & 15; const float ang = (float)pos * args.inv_freq[k];
            double rev = (double)ang * 0.15915494309189535; rev -= floor(rev);
            const float fr = (float)rev; ropec[i] = __builtin_amdgcn_cosf(fr); ropes[i] = __builtin_amdgcn_sinf(fr);
        }
        for (int m = gw; m < MROWS; m += NGW) {
            const float* src = m < MREAL ? x + (size_t)m * DM : meta_tok + (size_t)(m - MREAL) * DM;
            f32x4 v[8]; load_row(src, F.lane, v);
            const float rstd = __builtin_amdgcn_rsqf(row_ss(v) * (1.0f / DM) + RMS_EPS);
#pragma unroll
            for (int j = 0; j < 8; ++j) v[j] = v[j] * rstd * *(const f32x4*)(pre_g + 4 * (64 * j + F.lane));
            store_row_bf16(XN + (size_t)m * DM, F.lane, v);
        }
        const u32x4 z = {0u, 0u, 0u, 0u};
        for (int i = gtid; i < NB * NH * 2 * 1024; i += NGT) *(u32x4*)(Kimg + (size_t)(i >> 10) * NTILE * KTILE_B + (i & 1023) * 16) = z;
        for (int i = gtid; i < NB * NH * 2048; i += NGT) *(u32x4*)(Vimg + (size_t)(i >> 11) * NTILE * VTILE_B + (i & 2047) * 16) = z;
        GRID_BAR();
    }
    if (IN(1)) REPS(1) {
        E.mode = 1;
        rows16_phase(F, XN + (size_t)MREAL * DM, DM, W1, DM, DM, 4 * DM / 32, 0, 1 << 30, E);
        pg8::Gemm g{XN, W1, MREAL, 4 * DM, DM, DM, DM, 1 << 30, 0}; pg8::StaticOrder S; S.init(MREAL, 4 * DM, F.G, (int)blockIdx.x);
        pg8::gemm_phase<true>(F.lds, g, S, E);
        GRID_BAR();
    }
    if (IN(2)) REPS(2) {
        float d1 = 0.f, d2 = 0.f;
#pragma unroll
        for (int j = 0; j < 2; ++j) { d1 += lq1[F.lane + 64 * j] * lk1[F.lane + 64 * j]; d2 += lq2[F.lane + 64 * j] * lk2[F.lane + 64 * j]; }
        const float lam = expf(wave_sum(d1)) - expf(wave_sum(d2)) + 0.2f;
        if (F.tid == 0) *(LAS float*)(F.lds + MISC_OFF + 64) = lam;
        __syncthreads();
        const bool g256 = false && F.G == 256; const int xg = F.vcu >> 5, li = F.vcu & 31;
        for (int r = 0; g256 ? r < 3 : F.vcu + r * F.G < 520; ++r) {
            int bh, qb, desc;
            if (g256) { if (r == 2 && li != 0) break; bh = r == 2 ? xg : 2 * xg + r; qb = r == 0 ? li : (r == 1 ? 31 - li : -1); desc = r == 1; }
            else { const int u = F.vcu + r * F.G; desc = 0; if (u < 256) { bh = u >> 4; qb = u & 15; } else if (u < 512) { bh = (u - 256) >> 4; qb = 31 - ((u - 256) & 15); } else { bh = u - 512; qb = -1; } }
            att::attn_unit(F, QO, Kimg, Vimg, GB, XN, subln_g, bh >> 3, bh & 7, qb, desc);
        }
        GRID_BAR();
    }
    if (IN(3)) REPS(3) {
        E.mode = 2; E.Y = Y0;
        rows16_phase(F, XN + (size_t)MREAL * DM, DM, W2, DM, DM, DM / 32, 0, 1 << 30, E);
        pg8::Gemm g{XN, W2, MREAL, DM, DM, DM, DM, 1 << 30, 0}; pg8::StaticOrder S; S.init(MREAL, DM, F.G, (int)blockIdx.x);
        pg8::gemm_phase<true>(F.lds, g, S, E);
        GRID_BAR();
    }
    if (IN(4)) REPS(4) {
        for (int m = gw; m < MROWS; m += NGW) {
            f32x4 y[8], hrow[8]; load_row_bf16(Y0 + (size_t)m * DM, F.lane, y);
            load_row(m < MREAL ? x + (size_t)m * DM : meta_tok + (size_t)(m - MREAL) * DM, F.lane, hrow);
            const float r0 = __builtin_amdgcn_rsqf(row_ss(y) * (1.0f / DM) + RMS_EPS);
            if (F.lane == 0) rstd0[m] = r0;
#pragma unroll
            for (int j = 0; j < 8; ++j) hrow[j] = hrow[j] + y[j] * r0 * *(const f32x4*)(post_g + 4 * (64 * j + F.lane));
            const float r1 = __builtin_amdgcn_rsqf(row_ss(hrow) * (1.0f / DM) + RMS_EPS);
#pragma unroll
            for (int j = 0; j < 8; ++j) hrow[j] = hrow[j] * r1 * *(const f32x4*)(pre_g + DM + 4 * (64 * j + F.lane));
            store_row_bf16(XN + (size_t)m * DM, F.lane, hrow);
        }
        GRID_BAR();
    }
    if (IN(5)) REPS(5) {
        E.mode = 3;
        rows16_phase(F, XN + (size_t)MREAL * DM, DM, W3, DM, DM, DM / 32, 0, 1 << 30, E);
        pg8::Gemm g{XN, W3, MREAL, 2 * DM, DM, DM, DM, 1 << 30, 0}; pg8::StaticOrder S; S.init(MREAL, 2 * DM, F.G, (int)blockIdx.x);
        pg8::gemm_phase<true>(F.lds, g, S, E);
        GRID_BAR();
    }
    if (IN(6)) REPS(6) {
        for (int idx = gtid; idx < (MREAL / 16) * 256; idx += NGT) {
            const int strip = idx >> 8, c0 = (idx & 255) * 8, gi = c0 >> 9;
            if (gi == 0) mix_strip<2>(UB, MIX, strip, c0); else if (gi == 1) mix_strip<4>(UB, MIX, strip, c0);
            else if (gi == 2) mix_strip<8>(UB, MIX, strip, c0); else mix_strip<16>(UB, MIX, strip, c0);
        }
        GRID_BAR();
    }
    if (IN(7)) REPS(7) {
        E.mode = 4;
        pg8::Gemm g{MIX, W4, MREAL, DM, 512, DM, 512, 2, 512}; pg8::StaticOrder S; S.init(MREAL, DM, F.G, (int)blockIdx.x);
        pg8::gemm_phase<true>(F.lds, g, S, E);
        GRID_BAR();
    }
    if (IN(8)) REPS(8) {
        E.mode = 5; E.Y = Y1;
        pg8::Gemm g{GATED1, W5, MREAL, DM, DM, DM, DM, 1 << 30, 0}; pg8::StaticOrder S; S.init(MREAL, DM, F.G, (int)blockIdx.x);
        pg8::gemm_phase<true>(F.lds, g, S, E);
        GRID_BAR();
    }
    if (IN(9)) REPS(9) {
        for (int m = gw; m < MREAL; m += NGW) {
            f32x4 y1[8], acc[8]; load_row_bf16(Y1 + (size_t)m * DM, F.lane, y1); load_row(x + (size_t)m * DM, F.lane, acc);
            const float r0 = rstd0[m];
            const float r1 = __builtin_amdgcn_rsqf(row_ss(y1) * (1.0f / DM) + RMS_EPS);
#pragma unroll
            for (int j = 0; j < 8; ++j) {
                const int e = 4 * (64 * j + F.lane);
                const u32x2 y0w = *(const u32x2*)(Y0 + (size_t)m * DM + e); const f32x4 y0 = {bflo(y0w.x), bfhi(y0w.x), bflo(y0w.y), bfhi(y0w.y)};
                acc[j] = acc[j] + y0 * r0 * *(const f32x4*)(post_g + e) + y1[j] * r1 * *(const f32x4*)(post_g + DM + e);
                *(f32x4*)(args.out + (size_t)m * DM + e) = acc[j];
            }
        }
    }
#undef IN
#undef GRID_BAR
}

extern "C" void kernel_launch(void* const* d_in, const int* in_sizes, int n_in, void* d_out, int out_size, void* d_ws, size_t ws_size, hipStream_t stream) {
    static int grid = 0;
    if (grid == 0) {
        if (n_in != 15 || in_sizes[0] != NB * SEQ * DM || out_size != NB * SEQ * DM || ws_size < WS_END) {
            fprintf(stderr, "kernel_launch: unexpected shapes (n_in %d, in0 %d, out %d, ws %zu)\n", n_in, n_in > 0 ? in_sizes[0] : -1, out_size, ws_size); grid = -1; return; }
        int dev = 0, cus = 0, per_cu = 0;
        if (hipGetDevice(&dev) != hipSuccess || hipDeviceGetAttribute(&cus, hipDeviceAttributeMultiprocessorCount, dev) != hipSuccess) { grid = -1; return; }
        if (hipFuncSetAttribute((const void*)trunk_fwd, hipFuncAttributeMaxDynamicSharedMemorySize, LDS_BYTES) != hipSuccess) { fprintf(stderr, "kernel_launch: hipFuncSetAttribute failed\n"); grid = -1; return; }
        if (hipOccupancyMaxActiveBlocksPerMultiprocessor(&per_cu, (const void*)trunk_fwd, 512, LDS_BYTES) != hipSuccess || per_cu < 1) {
            fprintf(stderr, "kernel_launch: occupancy query reports %d workgroups per CU\n", per_cu); (void)hipGetLastError(); grid = -1; return; }
        grid = cus;
    }
    if (grid < 0) return;
    (void)hipMemsetAsync((char*)d_ws + WS_CTL, 0, CTL_ZERO_BYTES, stream);
    Args a{};
    for (int i = 0; i < 15; ++i) a.in[i] = (const float*)d_in[i];
    a.out = (float*)d_out; a.ws = (unsigned char*)d_ws;
    for (int i = 0; i < 16; ++i) a.inv_freq[i] = (float)pow(500000.0, -(double)i / 16.0);
#if MK_N_LAUNCHES == 1
    a.ph_lo = 0; a.ph_hi = 10; a.li = 0;
    hipLaunchKernelGGL(trunk_fwd, dim3(grid), dim3(512), LDS_BYTES, stream, a);
#else
    for (int p = 0; p < 10; ++p) { a.ph_lo = p; a.ph_hi = p + 1; a.li = p; hipLaunchKernelGGL(trunk_fwd, dim3(grid), dim3(512), LDS_BYTES, stream, a); }
#endif
    const hipError_t le = hipPeekAtLastError();
    if (le != hipSuccess) fprintf(stderr, "kernel_launch: launch failed: %s\n", hipGetErrorName(le));
}
```

```cpp
#include <hip/hip_runtime.h>
#include <cstdio>
#include <cstdint>
#include <cmath>

#ifndef MK_N_LAUNCHES
#define MK_N_LAUNCHES 1
#endif
#ifndef PROBE_PH
#define PROBE_PH (-1)
#endif
#ifndef PROBE_REP
#define PROBE_REP 0
#endif

#define LAS __attribute__((address_space(3)))
#define GAS __attribute__((address_space(1)))
typedef unsigned short bf16_t;
typedef short bf16x8 __attribute__((ext_vector_type(8)));
typedef short s16x4 __attribute__((ext_vector_type(4)));
typedef float f32x4 __attribute__((ext_vector_type(4)));
typedef float f32x16 __attribute__((ext_vector_type(16)));
typedef unsigned u32x4 __attribute__((ext_vector_type(4)));
typedef unsigned u32x2 __attribute__((ext_vector_type(2)));

constexpr int DM = 2048, SEQ = 4096, NB = 2, NMETA = 16, LTOT = SEQ + NMETA;
constexpr int MREAL = NB * SEQ;
constexpr int MROWS = MREAL + NMETA;
constexpr int NH = 8, HD = 128, VD = 256;
constexpr int NTILE = 65;
constexpr int KTILE_B = 64 * 128 * 2, VTILE_B = 64 * 256 * 2;
constexpr float RMS_EPS = 1e-6f;
constexpr float C2 = 0.08838834764831845f * 1.4426950408889634f;
constexpr float LOG2E = 1.4426950408889634f;

constexpr size_t MiB = 1u << 20;
constexpr size_t WS_CTL = 0, CTL_ZERO_BYTES = 65536;
constexpr size_t WS_ROPEC = 1 * MiB, WS_ROPES = 1 * MiB + 512 * 1024;
constexpr size_t WS_RSTD0 = 2 * MiB;
constexpr size_t WS_W1 = 4 * MiB, WS_W2 = 36 * MiB, WS_W3 = 44 * MiB, WS_W4 = 60 * MiB, WS_W5 = 62 * MiB;
constexpr size_t WS_XN = 70 * MiB, WS_G = 104 * MiB, WS_QO = 138 * MiB, WS_K = 172 * MiB;
constexpr size_t KIMG_BYTES = (size_t)NB * NH * 2 * NTILE * KTILE_B, VIMG_BYTES = (size_t)NB * NH * NTILE * VTILE_B;
constexpr size_t WS_V = WS_K + KIMG_BYTES;
constexpr size_t WS_Y0 = WS_K;
constexpr size_t WS_U = WS_QO, WS_G1 = WS_G, WS_MIX = WS_XN, WS_GATED1 = WS_QO, WS_Y1 = WS_XN;
constexpr size_t WS_END = WS_V + VIMG_BYTES;
static_assert(WS_END <= 240 * MiB && WS_Y0 + (size_t)MROWS * DM * 2 <= WS_END && WS_Y1 + (size_t)MROWS * DM * 2 <= WS_G, "ws map");
constexpr int CW_BAR = 4096;

constexpr int RING_BYTES = 131072, LDSCTL_OFF = RING_BYTES, MISC_OFF = LDSCTL_OFF + 320, LDS_BYTES = 147456;

__device__ __forceinline__ unsigned pk2(float lo, float hi) {
    typedef float f2_t __attribute__((ext_vector_type(2))); typedef __bf16 b2_t __attribute__((ext_vector_type(2)));
    f2_t v = {lo, hi}; b2_t b = __builtin_convertvector(v, b2_t); return __builtin_bit_cast(unsigned, b);
}
__device__ __forceinline__ float bflo(unsigned u) { return __uint_as_float(u << 16); }
__device__ __forceinline__ float bfhi(unsigned u) { return __uint_as_float(u & 0xffff0000u); }
__device__ __forceinline__ float siluf(float x) { return x * __builtin_amdgcn_rcpf(1.0f + __builtin_amdgcn_exp2f(-x * LOG2E)); }
__device__ __forceinline__ float wave_sum(float v) {
#pragma unroll
    for (int o = 1; o < 64; o <<= 1) v += __shfl_xor(v, o);
    return v;
}
__device__ __forceinline__ u32x4 pack8(f32x4 a, f32x4 b) { u32x4 w; w.x = pk2(a[0], a[1]); w.y = pk2(a[2], a[3]); w.z = pk2(b[0], b[1]); w.w = pk2(b[2], b[3]); return w; }

struct Epi {
    int mode;
    bf16_t* Q; unsigned char* Kimg; unsigned char* Vimg; bf16_t* G; const float* ropec; const float* ropes;
    bf16_t* Y;
    bf16_t* U; bf16_t* G1;
    bf16_t* GATED1; const float* pool_scale;
    template <int MODE> __device__ __forceinline__ void emit(int row, int col, f32x4 a, f32x4 b) const {
        if constexpr (MODE == 1) {
            if (col < 4096) {
                const int c = col & 2047, dim = c & 127;
                if (dim < 32) {
                    f32x4 pa, pb;
#pragma unroll
                    for (int i = 0; i < 4; ++i) { pa[i] = __shfl_xor(a[i], 32); pb[i] = __shfl_xor(b[i], 32); }
                    const int pos = row < MREAL ? NMETA + (row & (SEQ - 1)) : row - MREAL;
                    const float* cs = ropec + pos * 16 + (dim & 15); const float* sn = ropes + pos * 16 + (dim & 15);
                    const f32x4 c0 = *(const f32x4*)cs, c1 = *(const f32x4*)(cs + 4), s0 = *(const f32x4*)sn, s1 = *(const f32x4*)(sn + 4);
                    if (dim < 16) { a = a * c0 - pa * s0; b = b * c1 - pb * s1; } else { a = a * c0 + pa * s0; b = b * c1 + pb * s1; }
                }
                if (col < 2048) { a = a * C2; b = b * C2; *(u32x4*)(Q + (size_t)row * DM + c) = pack8(a, b); }
                else {
                    const int h = c >> 8, mp = (c >> 7) & 1; const u32x4 w = pack8(a, b);
                    const size_t inner = (size_t)(dim >> 3) * 1024;
                    if (row < MREAL) { const int bb = row >> 12, j = row & (SEQ - 1), tile = 1 + (j >> 6), key = j & 63;
                        *(u32x4*)(Kimg + ((size_t)((bb * NH + h) * 2 + mp) * NTILE + tile) * KTILE_B + inner + key * 16) = w; }
                    else { const int key = row - MREAL;
#pragma unroll
                        for (int bb = 0; bb < NB; ++bb) *(u32x4*)(Kimg + ((size_t)((bb * NH + h) * 2 + mp) * NTILE) * KTILE_B + inner + key * 16) = w; }
                }
            } else if (col < 6144) {
                const int c = col - 4096, h = c >> 8, d0 = c & 255, key = row - MREAL;
                const int slot = (key & 3) | (((key >> 3) & 1) << 2) | (((key >> 2) & 1) << 3);
                const float vals[8] = {a[0], a[1], a[2], a[3], b[0], b[1], b[2], b[3]};
                if (row >= MREAL) {
#pragma unroll
                    for (int i = 0; i < 8; ++i) { const int d = d0 + i; const unsigned short bv = (unsigned short)(pk2(vals[i], 0.f) & 0xffffu);
                        const size_t off = (size_t)d * 128 + (((slot >> 3) ^ ((d >> 1) & 7)) * 16) + (slot & 7) * 2;
#pragma unroll
                        for (int bb = 0; bb < NB; ++bb) *(unsigned short*)(Vimg + ((size_t)(bb * NH + h) * NTILE) * VTILE_B + off) = bv; }
                }
            } else {
                const int c = col - 6144;
#pragma unroll
                for (int i = 0; i < 4; ++i) { a[i] = siluf(a[i]); b[i] = siluf(b[i]); }
                *(u32x4*)(G + (size_t)row * DM + c) = pack8(a, b);
            }
        } else if constexpr (MODE == 2 || MODE == 5) {
            *(u32x4*)(Y + (size_t)row * DM + col) = pack8(a, b);
        } else if constexpr (MODE == 3) {
            if (col < 2048) { *(u32x4*)(U + (size_t)row * DM + col) = pack8(a, b); }
            else { const int c = col - 2048;
#pragma unroll
                for (int i = 0; i < 4; ++i) { a[i] = siluf(a[i]); b[i] = siluf(b[i]); }
                *(u32x4*)(G1 + (size_t)row * DM + c) = pack8(a, b); }
        } else if constexpr (MODE == 6) {
            const int h = row >> 8, d = row & 255, bb = col >> 12, j = col & (SEQ - 1), tile = 1 + (j >> 6), k0 = j & 63, sidx = k0 >> 4, aa = (k0 >> 3) & 1;
            unsigned char* base = Vimg + ((size_t)(bb * NH + h) * NTILE + tile) * VTILE_B + (size_t)d * 128 + 8 * aa; const int x = (d >> 1) & 7;
            u32x2 w0, w1; w0.x = pk2(a[0], a[1]); w0.y = pk2(a[2], a[3]); w1.x = pk2(b[0], b[1]); w1.y = pk2(b[2], b[3]);
            *(u32x2*)(base + (((2 * sidx) ^ x) * 16)) = w0; *(u32x2*)(base + (((2 * sidx + 1) ^ x) * 16)) = w1;
        } else {
            const f32x4 s0 = *(const f32x4*)(pool_scale + col), s1 = *(const f32x4*)(pool_scale + col + 4);
            const u32x4 g = *(const u32x4*)(G1 + (size_t)row * DM + col);
            a[0] *= s0[0] * bflo(g.x); a[1] *= s0[1] * bfhi(g.x); a[2] *= s0[2] * bflo(g.y); a[3] *= s0[3] * bfhi(g.y);
            b[0] *= s1[0] * bflo(g.z); b[1] *= s1[1] * bfhi(g.z); b[2] *= s1[2] * bflo(g.w); b[3] *= s1[3] * bfhi(g.w);
            *(u32x4*)(GATED1 + (size_t)row * DM + col) = pack8(a, b);
        }
    }
    __device__ __forceinline__ void emit_rt(int row, int col, f32x4 a, f32x4 b) const {
        if (mode == 1) emit<1>(row, col, a, b); else if (mode == 2 || mode == 5) emit<2>(row, col, a, b); else if (mode == 3) emit<3>(row, col, a, b); else if (mode == 6) emit<6>(row, col, a, b); else emit<4>(row, col, a, b);
    }
};

namespace pg8 {
constexpr int BM = 256, BK = 64, HALF = 128, HTB = HALF * BK * 2, STAGE_BYTES = 8 * HTB, NXCD = 8, WGM = 8;
__host__ __device__ __forceinline__ int lds_byte(int r, int c) { const int st = (r >> 4) * 2 + (c >> 5), rr = r & 15, cc = c & 31, ob = rr * 64 + cc * 2; return st * 1024 + (ob ^ (((ob >> 9) & 1) << 5)); }
__host__ __device__ __forceinline__ void stage_rc(int b, int& R, int& C) { const int st = b / 1024, sb = b % 1024, swz = sb ^ (((sb >> 9) & 1) << 5); R = (st >> 1) * 16 + swz / 64; C = (st & 1) * 32 + (swz % 64) / 2; }
__host__ __device__ __forceinline__ int perm32(int rho) { const int n = rho >> 4, i = rho & 15; return 8 * (i >> 2) + 4 * n + (i & 3); }
struct Unit { int pm, pn; };
struct Gemm { const bf16_t* A; const bf16_t* Bt; int M, N, K, lda, ldb, pn_per_grp, a_grp_cols; };
struct StaticOrder {
    int nM, nN, nwg, G, c, skip_from, skip_n;
    __device__ void init(int M, int N, int G_, int c_) { nM = M / BM; nN = N / BM; nwg = nM * nN; G = G_; c = c_; skip_from = 1 << 30; skip_n = 0; }
    __device__ bool next(int i, Unit& u) const {
        const long L = (long)i * G + c; if (L >= nwg) return false;
        int wgid = (int)L; { const int q = nwg / NXCD, r = nwg % NXCD, xcd = wgid % NXCD, off = wgid / NXCD; wgid = (xcd < r ? xcd * (q + 1) : r * (q + 1) + (xcd - r) * q) + off; }
        const int nig = WGM * nN, gid = wgid / nig, fm = gid * WGM, gsz = (nM - fm) < WGM ? (nM - fm) : WGM;
        u.pm = fm + ((wgid % nig) % gsz); u.pn = (wgid % nig) / gsz; if (u.pn >= skip_from) u.pn += skip_n; return true;
    }
};
template <int MODE>
__device__ __forceinline__ void run_epi_m(const Epi& E, const f32x4 (&acc)[2][2][4][2], const Unit& u, int wr, int wc) {
    int lane = threadIdx.x & 63; asm volatile("" : "+v"(lane));
    const int fr = lane & 15, fq = lane >> 4;
#pragma unroll
    for (int ai = 0; ai < 2; ++ai)
#pragma unroll
        for (int m = 0; m < 4; ++m) { const int row = u.pm * BM + ai * HALF + wr * 64 + m * 16 + fr;
#pragma unroll
            for (int bj = 0; bj < 2; ++bj) { const int col = u.pn * BM + bj * HALF + wc * 32 + 8 * fq; E.emit<MODE>(row, col, acc[ai][bj][m][0], acc[ai][bj][m][1]); asm volatile("" ::: "memory"); } }
}
__device__ __forceinline__ void run_epi(const Epi& E, const f32x4 (&acc)[2][2][4][2], const Unit& u, int wr, int wc, int fr, int fq) {
    if (E.mode == 1) run_epi_m<1>(E, acc, u, wr, wc); else if (E.mode == 2 || E.mode == 5) run_epi_m<2>(E, acc, u, wr, wc);
    else if (E.mode == 3) run_epi_m<3>(E, acc, u, wr, wc); else if (E.mode == 6) run_epi_m<6>(E, acc, u, wr, wc); else run_epi_m<4>(E, acc, u, wr, wc);
}
template <bool ALIGN_EPI>
__device__ __forceinline__ void gemm_phase(LAS unsigned char* lds, const Gemm g, const StaticOrder& S, const Epi& E) {
    int tid_o = threadIdx.x; asm volatile("" : "+v"(tid_o));
    const int tid = tid_o, wid = __builtin_amdgcn_readfirstlane(tid >> 6), lane = tid & 63, wr = wid >> 2, wc = wid & 3, fr = lane & 15, fq = lane >> 4;
    const int K = g.K, nt = K / BK;
    unsigned voffA[2], voffB[2];
#pragma unroll
    for (int i = 0; i < 2; ++i) { int R, C; stage_rc(tid * 16 + i * 8192, R, C); const int Rb = (R & ~31) + perm32(R & 31);
        voffA[i] = (unsigned)(R * g.lda + C) * 2u; voffB[i] = (unsigned)(Rb * g.ldb + C) * 2u; }
    const size_t kstep = (size_t)(BK * 2);
    const size_t hstepA = (size_t)HALF * g.lda * 2, hstepB = (size_t)HALF * g.ldb * 2;
    const size_t tstepA = 2 * hstepA, tstepB = 2 * hstepB;
    const unsigned ldsw = (unsigned)wid * 1024u;
    const int aoff = lds_byte(wr * 64 + fr, fq * 8), boff = lds_byte(wc * 32 + fr, fq * 8);
#define PG8_SA(b, h) (((b) * 2 + (h)) * HTB)
#define PG8_SB(b, h) ((4 + (b) * 2 + (h)) * HTB)
#define PG8_STAGE(bufoff, gbase, voff) do { _Pragma("unroll") for (int _i = 0; _i < 2; ++_i) \
        __builtin_amdgcn_global_load_lds((const unsigned*)((const char*)(gbase) + (voff)[_i]), (LAS unsigned*)(lds + (bufoff) + ldsw + _i * 8192), 16, 0, 0); } while (0)
#define PG8_LDA(dst, b, h) do { _Pragma("unroll") for (int m = 0; m < 4; ++m) _Pragma("unroll") for (int k = 0; k < 2; ++k) dst[m][k] = *(const LAS bf16x8*)(lds + PG8_SA(b, h) + aoff + m * 2048 + k * 1024); } while (0)
#define PG8_LDB(dst, b, h) do { _Pragma("unroll") for (int n = 0; n < 2; ++n) _Pragma("unroll") for (int k = 0; k < 2; ++k) dst[n][k] = *(const LAS bf16x8*)(lds + PG8_SB(b, h) + boff + n * 2048 + k * 1024); } while (0)
#define PG8_MMA(ai, bj, At, Bt) do { __builtin_amdgcn_s_setprio(1); _Pragma("unroll") for (int m = 0; m < 4; ++m) _Pragma("unroll") for (int n = 0; n < 2; ++n) _Pragma("unroll") for (int k = 0; k < 2; ++k) \
        acc[ai][bj][m][n] = __builtin_amdgcn_mfma_f32_16x16x32_bf16(Bt[n][k], At[m][k], acc[ai][bj][m][n], 0, 0, 0); __builtin_amdgcn_s_setprio(0); } while (0)
#define PG8_WAIT_V(n) asm volatile("s_waitcnt vmcnt(" #n ")" ::: "memory")
#define PG8_WAIT_L(n) asm volatile("s_waitcnt lgkmcnt(" #n ")" ::: "memory")
#define PG8_BAR __builtin_amdgcn_s_barrier()
#define PG8_SCHED __builtin_amdgcn_sched_barrier(0)
#define PG8_ABASE(u) ((const char*)g.A + (size_t)(u).pm * tstepA + (size_t)((u).pn / g.pn_per_grp) * g.a_grp_cols * 2)
    Unit cur, nxt; int ui = 0;
    if (!S.next(0, cur)) return;
    f32x4 acc[2][2][4][2];
#pragma unroll
    for (int a = 0; a < 2; ++a)
#pragma unroll
        for (int b = 0; b < 2; ++b)
#pragma unroll
            for (int m = 0; m < 4; ++m)
#pragma unroll
                for (int n = 0; n < 2; ++n) acc[a][b][m][n] = (f32x4){0.f, 0.f, 0.f, 0.f};
    bf16x8 At[4][2], B0[2][2], B1[2][2];
    const char* cA = PG8_ABASE(cur); const char* cB = (const char*)g.Bt + (size_t)cur.pn * tstepB;
    PG8_STAGE(PG8_SB(0, 0), cB, voffB); PG8_STAGE(PG8_SB(0, 1), cB + hstepB, voffB); PG8_STAGE(PG8_SA(0, 0), cA, voffA); PG8_STAGE(PG8_SA(0, 1), cA + hstepA, voffA);
    if (wr == 1) PG8_BAR;
    PG8_WAIT_V(2); PG8_BAR;
    PG8_STAGE(PG8_SB(1, 0), cB + kstep, voffB); PG8_STAGE(PG8_SA(1, 0), cA + kstep, voffA); PG8_STAGE(PG8_SB(1, 1), cB + hstepB + kstep, voffB);
    PG8_WAIT_V(6); PG8_BAR;
    for (;;) {
        const bool has_next = S.next(ui + 1, nxt);
        const char* nA = has_next ? PG8_ABASE(nxt) : cA; const char* nB = has_next ? (const char*)g.Bt + (size_t)nxt.pn * tstepB : cB;
        for (int t = 0; t < nt; t += 2) {
            const bool last = (t == nt - 2);
            const char* a1 = cA + (size_t)(t + 1) * kstep;
            const char* a2 = last ? nA : cA + (size_t)(t + 2) * kstep; const char* b2 = last ? nB : cB + (size_t)(t + 2) * kstep;
            const char* a3 = a2 + kstep; const char* b3 = b2 + kstep;
            PG8_LDB(B0, 0, 0); PG8_LDB(B1, 0, 1); PG8_SCHED; PG8_LDA(At, 0, 0); PG8_STAGE(PG8_SA(1, 1), a1 + hstepA, voffA);
            PG8_WAIT_V(8); PG8_WAIT_L(0); PG8_BAR; PG8_MMA(0, 0, At, B0); PG8_MMA(0, 1, At, B1); PG8_BAR; PG8_SCHED;
            PG8_LDA(At, 0, 1); PG8_STAGE(PG8_SB(0, 0), b2, voffB); PG8_STAGE(PG8_SB(0, 1), b2 + hstepB, voffB); PG8_STAGE(PG8_SA(0, 0), a2, voffA);
            PG8_WAIT_V(8); PG8_WAIT_L(0); PG8_BAR; PG8_MMA(1, 0, At, B0); PG8_MMA(1, 1, At, B1); PG8_BAR; PG8_SCHED;
            PG8_LDB(B0, 1, 0); PG8_LDB(B1, 1, 1); PG8_SCHED; PG8_LDA(At, 1, 0); PG8_STAGE(PG8_SA(0, 1), a2 + hstepA, voffA);
            PG8_WAIT_V(8); PG8_WAIT_L(0); PG8_BAR; PG8_MMA(0, 0, At, B0); PG8_MMA(0, 1, At, B1); PG8_BAR; PG8_SCHED;
            PG8_LDA(At, 1, 1); PG8_STAGE(PG8_SB(1, 0), b3, voffB); PG8_STAGE(PG8_SB(1, 1), b3 + hstepB, voffB); PG8_STAGE(PG8_SA(1, 0), a3, voffA);
            PG8_WAIT_V(8); PG8_WAIT_L(0); PG8_BAR; PG8_MMA(1, 0, At, B0); PG8_MMA(1, 1, At, B1); PG8_BAR; PG8_SCHED;
        }
        if constexpr (ALIGN_EPI) { if (wr == 0) PG8_BAR; }
        run_epi(E, acc, cur, wr, wc, fr, fq);
        if (!has_next) break;
#pragma unroll
        for (int a = 0; a < 2; ++a)
#pragma unroll
            for (int b = 0; b < 2; ++b)
#pragma unroll
                for (int m = 0; m < 4; ++m)
#pragma unroll
                    for (int n = 0; n < 2; ++n) acc[a][b][m][n] = (f32x4){0.f, 0.f, 0.f, 0.f};
        cur = nxt; cA = nA; cB = nB; ++ui;
        if constexpr (ALIGN_EPI) { if (wr == 1) PG8_BAR; }
    }
    PG8_WAIT_V(0);
    if constexpr (!ALIGN_EPI) { if (wr == 0) PG8_BAR; }
    PG8_BAR;
#undef PG8_SA
#undef PG8_SB
#undef PG8_STAGE
#undef PG8_LDA
#undef PG8_LDB
#undef PG8_MMA
#undef PG8_WAIT_V
#undef PG8_WAIT_L
#undef PG8_BAR
#undef PG8_SCHED
#undef PG8_ABASE
}
}

typedef GAS unsigned gu32;
#define RLX_AGENT __ATOMIC_RELAXED, __HIP_MEMORY_SCOPE_AGENT
#define XB_TMO      128
#define XB_XCNT(j)  (256  + 64 * (j))
#define XB_XSUB(j)  (1280 + 64 * (j))
#define XB_XGEN(j)  (2304 + 64 * (j))
#define XB_TOP      3328
#define XB_TOPGEN   3392
#define XCD_BAR_WORDS 3456
#define XB_SPIN_CAP (1u << 18)
__device__ __forceinline__ unsigned xb_ld(unsigned* p)              { return __hip_atomic_load(p, __ATOMIC_RELAXED, __HIP_MEMORY_SCOPE_AGENT); }
__device__ __forceinline__ unsigned xb_add(unsigned* p, unsigned v) { return __hip_atomic_fetch_add(p, v, __ATOMIC_RELAXED, __HIP_MEMORY_SCOPE_AGENT); }
__device__ __forceinline__ unsigned xb_xcc_id() { return (unsigned)__builtin_amdgcn_s_getreg((3 << 11) | 20) & 0xFu; }
#define XB_SPIN(cond, bar) do { unsigned _sp = 0; while (cond) { __builtin_amdgcn_s_sleep(1); \
    if ((++_sp & 255u) == 0u) { if (xb_ld(&(bar)[XB_TMO])) break; if (_sp > XB_SPIN_CAP) { atomicAdd(&(bar)[XB_TMO], 1u); break; } } } } while (0)
struct XcdBarrier { unsigned* bar; unsigned x; volatile LAS unsigned* st; };
__device__ __forceinline__ XcdBarrier xcd_barrier_post(unsigned* bar, volatile LAS unsigned* st) {
    XcdBarrier b; b.bar = bar; b.x = xb_xcc_id(); b.st = st;
    if (threadIdx.x == 0) (void)xb_add(&bar[XB_XCNT(b.x)], 1u);
    return b;
}
__device__ __forceinline__ void xcd_barrier_complete(unsigned* bar, unsigned x, unsigned& nloc, unsigned& nx) {
    const unsigned G = gridDim.x * gridDim.y * gridDim.z;
    unsigned sum, cnt, mine, sp = 0u;
    for (;;) {
        sum = 0u; cnt = 0u; mine = 0u;
#pragma unroll
        for (unsigned j = 0; j < 16; ++j) { const unsigned c = xb_ld(&bar[XB_XCNT(j)]); sum += c; cnt += (c > 0u) ? 1u : 0u; mine = (j == x) ? c : mine; }
        if (sum == G) break;
        __builtin_amdgcn_s_sleep(1);
        if ((++sp & 255u) == 0u) { if (xb_ld(&bar[XB_TMO])) break; if (sp > XB_SPIN_CAP) { atomicAdd(&bar[XB_TMO], 1u); break; } }
    }
    nloc = mine > 0u ? mine : 1u; nx = cnt > 0u ? cnt : 1u;
}
__device__ __forceinline__ void xcd_barrier(const XcdBarrier& b) {
    asm volatile("s_waitcnt vmcnt(0)" ::: "memory");
    __syncthreads();
    if (threadIdx.x == 0) {
        unsigned* bar = b.bar;
        __builtin_amdgcn_s_waitcnt(0);
        unsigned nloc = b.st[0], nx = b.st[1];
        if (nloc == 0u) { xcd_barrier_complete(bar, b.x, nloc, nx); b.st[0] = nloc; b.st[1] = nx; }
        const unsigned old = xb_add(&bar[XB_XSUB(b.x)], 1u);
        const unsigned gen = old / nloc;
        if (old + 1u == (gen + 1u) * nloc) {
            __builtin_amdgcn_fence(__ATOMIC_RELEASE, "agent");
            asm volatile("s_waitcnt vmcnt(0)" ::: "memory");
            const unsigned og = xb_add(&bar[XB_TOP], 1u);
            const unsigned tg = og / nx;
            if (og + 1u == (tg + 1u) * nx) xb_add(&bar[XB_TOPGEN], 1u);
            else XB_SPIN(xb_ld(&bar[XB_TOPGEN]) == tg, bar);
            __builtin_amdgcn_fence(__ATOMIC_ACQUIRE, "agent");
            xb_add(&bar[XB_XGEN(b.x)], 1u);
            asm volatile("s_waitcnt vmcnt(0)" ::: "memory");
        } else {
            XB_SPIN(xb_ld(&bar[XB_XGEN(b.x)]) == gen, bar);
            __builtin_amdgcn_fence(__ATOMIC_ACQUIRE, "agent");
            asm volatile("s_waitcnt vmcnt(0)" ::: "memory");
        }
    }
    __syncthreads();
}

struct Args {
    const float* in[15]; float* out; unsigned char* ws;
    float inv_freq[16];
    int ph_lo, ph_hi, li, pad;
};
struct Frame {
    LAS unsigned char* lds; int tid, lane, wave, vcu, G;
};

__device__ __forceinline__ void p0_transpose_item(const float* W, int N, bf16_t* WT, int ldt, int row_off, LAS float* scr, int item, int lane) {
    const int nblk = N / 32, kb = item / nblk, nb = item % nblk, k0 = 64 * kb, n0 = 32 * nb;
#pragma unroll 8
    for (int i = 0; i < 32; ++i) { const int kk = 2 * i + (lane >> 5); scr[kk * 33 + (lane & 31)] = W[(size_t)(k0 + kk) * N + n0 + (lane & 31)]; }
    asm volatile("s_waitcnt lgkmcnt(0)" ::: "memory");
    const int c = lane & 7;
#pragma unroll
    for (int j = 0; j < 4; ++j) { const int n = (lane >> 3) + 8 * j; const LAS float* s = scr + (8 * c) * 33 + n;
        u32x4 o; o.x = pk2(s[0 * 33], s[1 * 33]); o.y = pk2(s[2 * 33], s[3 * 33]); o.z = pk2(s[4 * 33], s[5 * 33]); o.w = pk2(s[6 * 33], s[7 * 33]);
        *(u32x4*)(WT + (size_t)(row_off + n0 + n) * ldt + k0 + 8 * c) = o; }
    asm volatile("s_waitcnt lgkmcnt(0)" ::: "memory");
}
__device__ __forceinline__ void load_row(const float* p, int lane, f32x4 (&v)[8]) {
#pragma unroll
    for (int j = 0; j < 8; ++j) v[j] = *(const f32x4*)(p + 4 * (64 * j + lane));
}
__device__ __forceinline__ void load_row_bf16(const bf16_t* p, int lane, f32x4 (&v)[8]) {
#pragma unroll
    for (int j = 0; j < 8; ++j) { const u32x2 w = *(const u32x2*)(p + 4 * (64 * j + lane)); v[j] = (f32x4){bflo(w.x), bfhi(w.x), bflo(w.y), bfhi(w.y)}; }
}
__device__ __forceinline__ float row_ss(const f32x4 (&v)[8]) {
    float s = 0.f;
#pragma unroll
    for (int j = 0; j < 8; ++j) s += (v[j][0] * v[j][0] + v[j][1] * v[j][1]) + (v[j][2] * v[j][2] + v[j][3] * v[j][3]);
    return wave_sum(s);
}
__device__ __forceinline__ void row_ss2(const f32x4 (&a)[8], const f32x4 (&b)[8], float& sa, float& sb) {
    float s = 0.f, t = 0.f;
#pragma unroll
    for (int j = 0; j < 8; ++j) { s += (a[j][0] * a[j][0] + a[j][1] * a[j][1]) + (a[j][2] * a[j][2] + a[j][3] * a[j][3]); t += (b[j][0] * b[j][0] + b[j][1] * b[j][1]) + (b[j][2] * b[j][2] + b[j][3] * b[j][3]); }
#pragma unroll
    for (int o = 1; o < 64; o <<= 1) { s += __shfl_xor(s, o); t += __shfl_xor(t, o); }
    sa = s; sb = t;
}
__device__ __forceinline__ void store_row_bf16(bf16_t* p, int lane, const f32x4 (&v)[8]) {
#pragma unroll
    for (int j = 0; j < 8; ++j) { u32x2 w; w.x = pk2(v[j][0], v[j][1]); w.y = pk2(v[j][2], v[j][3]); *(u32x2*)(p + 4 * (64 * j + lane)) = w; }
}

__device__ __forceinline__ void rows16_phase(const Frame& F, const bf16_t* A16, int lda, const bf16_t* Bt, int ldb, int K, int ntasks, int a_grp_cols, int tasks_per_grp, const Epi& E) {
    int lane_o = threadIdx.x & 63; asm volatile("" : "+v"(lane_o));
    const int lane = lane_o, m = lane & 15, fq = lane >> 4;
    LAS float* red = (LAS float*)F.lds;
    const int stride = F.G / ntasks > 0 ? F.G / ntasks : 1;
    for (int task0 = F.vcu; task0 < ntasks * stride; task0 += F.G) {
        if (task0 % stride) continue;
        const int task = task0 / stride;
        const int n0 = task * 32, kslice = K / 8, kb = F.wave * kslice;
        const bf16_t* ap = A16 + (size_t)m * lda + (task / tasks_per_grp) * a_grp_cols + kb + 8 * fq;
        const bf16_t* bp0 = Bt + (size_t)(n0 + 8 * (m >> 2) + (m & 3)) * ldb + kb + 8 * fq;
        const bf16_t* bp1 = bp0 + (size_t)4 * ldb;
        f32x4 acc0 = {0.f, 0.f, 0.f, 0.f}, acc1 = {0.f, 0.f, 0.f, 0.f};
        for (int ks = 0; ks < kslice; ks += 32) {
            const bf16x8 a = *(const bf16x8*)(ap + ks), b0 = *(const bf16x8*)(bp0 + ks), b1 = *(const bf16x8*)(bp1 + ks);
            acc0 = __builtin_amdgcn_mfma_f32_16x16x32_bf16(b0, a, acc0, 0, 0, 0);
            acc1 = __builtin_amdgcn_mfma_f32_16x16x32_bf16(b1, a, acc1, 0, 0, 0);
        }
        *(LAS f32x4*)(red + (F.wave * 2 + 0) * 256 + lane * 4) = acc0;
        *(LAS f32x4*)(red + (F.wave * 2 + 1) * 256 + lane * 4) = acc1;
        __syncthreads();
        if (F.wave == 0) {
            f32x4 s0 = {0.f, 0.f, 0.f, 0.f}, s1 = {0.f, 0.f, 0.f, 0.f};
#pragma unroll
            for (int w = 0; w < 8; ++w) { s0 += *(const LAS f32x4*)(red + (w * 2 + 0) * 256 + lane * 4); s1 += *(const LAS f32x4*)(red + (w * 2 + 1) * 256 + lane * 4); }
            E.emit_rt(MREAL + m, n0 + 8 * fq, s0, s1);
        }
        __syncthreads();
    }
}

template <int W> __device__ __forceinline__ void mix_strip(const bf16_t* U, bf16_t* MIXo, int strip, int c0) {
    const int row0 = strip * 16, bb = row0 >> 12, p0 = NMETA + (row0 & (SEQ - 1));
    u32x4 buf[W - 1 + 16];
#pragma unroll
    for (int i = 0; i < W - 1 + 16; ++i) { const int pp = p0 - (W - 1) + i; const int r = pp >= NMETA ? bb * SEQ + pp - NMETA : MREAL + pp;
        buf[i] = *(const u32x4*)(U + (size_t)r * DM + c0); }
    float s[8] = {0.f, 0.f, 0.f, 0.f, 0.f, 0.f, 0.f, 0.f};
#define MIX_UNPK(v, f) const float f[8] = {bflo(v.x), bfhi(v.x), bflo(v.y), bfhi(v.y), bflo(v.z), bfhi(v.z), bflo(v.w), bfhi(v.w)}
#pragma unroll
    for (int i = 0; i < W - 1; ++i) { MIX_UNPK(buf[i], f);
#pragma unroll
        for (int k = 0; k < 8; ++k) s[k] += f[k]; }
    constexpr float iw = 1.0f / (float)W;
#pragma unroll
    for (int t = 0; t < 16; ++t) {
        MIX_UNPK(buf[W - 1 + t], f);
#pragma unroll
        for (int k = 0; k < 8; ++k) s[k] += f[k];
        u32x4 o; o.x = pk2(s[0] * iw - f[0], s[1] * iw - f[1]); o.y = pk2(s[2] * iw - f[2], s[3] * iw - f[3]);
        o.z = pk2(s[4] * iw - f[4], s[5] * iw - f[5]); o.w = pk2(s[6] * iw - f[6], s[7] * iw - f[7]);
        *(u32x4*)(MIXo + (size_t)(row0 + t) * DM + c0) = o;
        MIX_UNPK(buf[t], g);
#pragma unroll
        for (int k = 0; k < 8; ++k) s[k] -= g[k];
    }
#undef MIX_UNPK
}

namespace att {
__device__ __forceinline__ int crow(int r, int hi) { return (r & 3) + 8 * (r >> 2) + 4 * hi; }
__device__ __forceinline__ float xch32(float v) { return __shfl_xor(v, 32); }
#ifndef ATT_VPREFETCH
#define ATT_VPREFETCH 1
#endif
#ifndef ATT_PROBE
#define ATT_PROBE 0
#endif
#ifndef ATT_STATICPRIO
#define ATT_STATICPRIO 1
#endif
#ifndef ATT_STAGGER
#define ATT_STAGGER 1
#endif
#ifndef ATT_SETPRIO
#define ATT_SETPRIO 0
#endif
constexpr float THRL = 6.0f;
template <int OFF> __device__ __forceinline__ bf16x8 v_read1(int va) {
    bf16x8 r; asm volatile("ds_read_b128 %0, %1 offset:%2" : "=&v"(r) : "v"(va), "i"(OFF) : "memory"); return r;
}
template <int D0> __device__ __forceinline__ void pv_read(bf16x8 (&v)[4], const int (&voff)[4]) {
    v[0] = v_read1<D0 * 4096>(voff[0]); v[1] = v_read1<D0 * 4096>(voff[1]); v[2] = v_read1<D0 * 4096>(voff[2]); v[3] = v_read1<D0 * 4096>(voff[3]);
}
__device__ __forceinline__ void pv_mma(f32x16& od, const bf16x8 (&v)[4], const u32x4 (&pw)[4]) {
    if (ATT_SETPRIO) __builtin_amdgcn_s_setprio(1);
    od = __builtin_amdgcn_mfma_f32_32x32x16_bf16(v[0], __builtin_bit_cast(bf16x8, pw[0]), od, 0, 0, 0);
    od = __builtin_amdgcn_mfma_f32_32x32x16_bf16(v[1], __builtin_bit_cast(bf16x8, pw[1]), od, 0, 0, 0);
    od = __builtin_amdgcn_mfma_f32_32x32x16_bf16(v[2], __builtin_bit_cast(bf16x8, pw[2]), od, 0, 0, 0);
    od = __builtin_amdgcn_mfma_f32_32x32x16_bf16(v[3], __builtin_bit_cast(bf16x8, pw[3]), od, 0, 0, 0);
    if (ATT_SETPRIO) __builtin_amdgcn_s_setprio(0);
}
#define ATT_WL(n) do { __builtin_amdgcn_sched_barrier(0); asm volatile("s_waitcnt lgkmcnt(" #n ")" ::: "memory"); __builtin_amdgcn_sched_barrier(0); } while (0)
__device__ __forceinline__ void pv_all(f32x16 (&o)[8], int vb, const int (&vsw)[4], const u32x4 (&pw)[4]) {
    const int voff[4] = {vb + vsw[0], vb + vsw[1], vb + vsw[2], vb + vsw[3]};
    bf16x8 va[4], vc[4];
    pv_read<0>(va, voff); ATT_WL(0);
    pv_read<1>(vc, voff); pv_mma(o[0], va, pw); ATT_WL(0);
    pv_read<2>(va, voff); pv_mma(o[1], vc, pw); ATT_WL(0);
    pv_read<3>(vc, voff); pv_mma(o[2], va, pw); ATT_WL(0);
    pv_read<4>(va, voff); pv_mma(o[3], vc, pw); ATT_WL(0);
    pv_read<5>(vc, voff); pv_mma(o[4], va, pw); ATT_WL(0);
    pv_read<6>(va, voff); pv_mma(o[5], vc, pw); ATT_WL(0);
    pv_read<7>(vc, voff); pv_mma(o[6], va, pw); ATT_WL(0);
    pv_mma(o[7], vc, pw);
}
template <int OFF> __device__ __forceinline__ bf16x8 k_read1(int kb) {
    bf16x8 r; asm volatile("ds_read_b128 %0, %1 offset:%2" : "=&v"(r) : "v"(kb), "i"(OFF) : "memory"); return r;
}
template <int G> __device__ __forceinline__ void k_read(bf16x8 (&k)[4], int kb) {
    k[0] = k_read1<(2 * G) * 2048>(kb); k[1] = k_read1<(2 * G) * 2048 + 512>(kb); k[2] = k_read1<(2 * G + 1) * 2048>(kb); k[3] = k_read1<(2 * G + 1) * 2048 + 512>(kb);
}
template <int G> __device__ __forceinline__ void qk_mma(f32x16& p0, f32x16& p1, const bf16x8 (&k)[4], const bf16x8 (&qr)[8]) {
    p0 = __builtin_amdgcn_mfma_f32_32x32x16_bf16(k[0], qr[2 * G], p0, 0, 0, 0);
    p1 = __builtin_amdgcn_mfma_f32_32x32x16_bf16(k[1], qr[2 * G], p1, 0, 0, 0);
    p0 = __builtin_amdgcn_mfma_f32_32x32x16_bf16(k[2], qr[2 * G + 1], p0, 0, 0, 0);
    p1 = __builtin_amdgcn_mfma_f32_32x32x16_bf16(k[3], qr[2 * G + 1], p1, 0, 0, 0);
}
__device__ __forceinline__ void qk_sm(f32x16 (&o)[8], float& m_run, float& l_run, u32x4 (&pw)[4], const LAS unsigned char* Kst, const bf16x8 (&qr)[8], bool meta_tile) {
    f32x16 p0 = (f32x16){0.f, 0.f, 0.f, 0.f, 0.f, 0.f, 0.f, 0.f, 0.f, 0.f, 0.f, 0.f, 0.f, 0.f, 0.f, 0.f}, p1 = p0;
    {
        const int kb = (int)(unsigned)(uintptr_t)Kst;
        bf16x8 ka[4], kc[4];
        k_read<0>(ka, kb); ATT_WL(0);
        k_read<1>(kc, kb); qk_mma<0>(p0, p1, ka, qr); ATT_WL(0);
        k_read<2>(ka, kb); qk_mma<1>(p0, p1, kc, qr); ATT_WL(0);
        k_read<3>(kc, kb); qk_mma<2>(p0, p1, ka, qr); ATT_WL(0);
        qk_mma<3>(p0, p1, kc, qr);
    }
    if (ATT_PROBE == 2) {
        asm volatile("" : "+v"(p0), "+v"(p1));
        p0 = (f32x16){0.f, 0.f, 0.f, 0.f, 0.f, 0.f, 0.f, 0.f, 0.f, 0.f, 0.f, 0.f, 0.f, 0.f, 0.f, 0.f}; p1 = p0;
#pragma unroll
        for (int d0 = 0; d0 < 8; ++d0) {
            const bf16x8 a0 = *(const LAS bf16x8*)(Kst + d0 * 2048), a1 = *(const LAS bf16x8*)(Kst + d0 * 2048 + 512);
            p0 = __builtin_amdgcn_mfma_f32_32x32x16_bf16(a0, qr[d0], p0, 0, 0, 0);
            p1 = __builtin_amdgcn_mfma_f32_32x32x16_bf16(a1, qr[d0], p1, 0, 0, 0);
        }
    }
    if (meta_tile) {
#pragma unroll
        for (int r = 8; r < 16; ++r) p0[r] = -INFINITY;
#pragma unroll
        for (int r = 0; r < 16; ++r) p1[r] = -INFINITY;
    }
    float rm = fmaxf(fmaxf(p0[0], p0[1]), p0[2]);
#pragma unroll
    for (int r = 3; r < 15; r += 2) rm = fmaxf(fmaxf(rm, p0[r]), p0[r + 1]);
    rm = fmaxf(rm, p0[15]);
#pragma unroll
    for (int r = 0; r < 16; r += 2) rm = fmaxf(fmaxf(rm, p1[r]), p1[r + 1]);
    rm = fmaxf(rm, xch32(rm));
    if (__any(rm > m_run + THRL)) {
        const float mn = fmaxf(m_run, rm), alpha = __builtin_amdgcn_exp2f(m_run - mn);
        m_run = mn; l_run *= alpha;
#pragma unroll
        for (int d = 0; d < 8; ++d)
#pragma unroll
            for (int r = 0; r < 16; ++r) o[d][r] *= alpha;
    }
    float ps = 0.f;
#pragma unroll
    for (int r = 0; r < 16; ++r) { float xx = p0[r] - m_run; p0[r] = __builtin_amdgcn_exp2f(xx); if (ATT_PROBE == 3) { asm volatile("" : "+v"(xx)); p0[r] = (p0[r] + __builtin_amdgcn_exp2f(xx)) * 0.5f; } ps += p0[r]; }
#pragma unroll
    for (int r = 0; r < 16; ++r) { float xx = p1[r] - m_run; p1[r] = __builtin_amdgcn_exp2f(xx); if (ATT_PROBE == 3) { asm volatile("" : "+v"(xx)); p1[r] = (p1[r] + __builtin_amdgcn_exp2f(xx)) * 0.5f; } ps += p1[r]; }
    l_run += ps;
    pw[0] = (u32x4){pk2(p0[0], p0[1]), pk2(p0[2], p0[3]), pk2(p0[4], p0[5]), pk2(p0[6], p0[7])};
    pw[1] = (u32x4){pk2(p0[8], p0[9]), pk2(p0[10], p0[11]), pk2(p0[12], p0[13]), pk2(p0[14], p0[15])};
    pw[2] = (u32x4){pk2(p1[0], p1[1]), pk2(p1[2], p1[3]), pk2(p1[4], p1[5]), pk2(p1[6], p1[7])};
    pw[3] = (u32x4){pk2(p1[8], p1[9]), pk2(p1[10], p1[11]), pk2(p1[12], p1[13]), pk2(p1[14], p1[15])};
}
__device__ __forceinline__ void attn_unit(const Frame& F, const bf16_t* Q, const unsigned char* Kimg, const unsigned char* Vimg, const bf16_t* Gt, bf16_t* O,
                                          const float* subln_g, int b, int h, int qb, int desc) {
    LAS unsigned char* lds = F.lds;
    int lane_o = threadIdx.x & 63; asm volatile("" : "+v"(lane_o));
    const int lane = lane_o, r32 = lane & 31, hi = lane >> 5, wid = F.wave, mp = wid >> 2, rg = wid & 3;
    const bool meta = qb < 0;
    const size_t qrow = meta ? (size_t)(MREAL + (r32 & 15)) : (size_t)b * SEQ + qb * 128 + rg * 32 + r32;
    const int NT = meta ? 1 : 2 * qb + 3;
    const int tmax = meta ? 0 : 2 * qb + 1 + (rg >> 1);
    bf16x8 qr[8];
    { const bf16_t* qp = Q + qrow * DM + h * 256 + mp * 128 + hi * 8;
#pragma unroll
      for (int d0 = 0; d0 < 8; ++d0) qr[d0] = *(const bf16x8*)(qp + 16 * d0); }
    const int bsel = meta ? 0 : b;
    const unsigned char* srcK = Kimg + ((size_t)((bsel * NH + h) * 2 + mp) * NTILE) * KTILE_B + rg * 4096 + lane * 16;
    const unsigned char* srcV = Vimg + ((size_t)(bsel * NH + h) * NTILE) * VTILE_B + wid * 4096 + lane * 16;
#define ATT_TILE(k) (desc ? NT - 1 - (k) : (k))
#define ATT_DMA_K(k) do { const int _tl = ATT_TILE(k); _Pragma("unroll") for (int _i = 0; _i < (ATT_PROBE == 1 ? 8 : 4); ++_i) \
        __builtin_amdgcn_global_load_lds((const unsigned*)(srcK + (size_t)_tl * KTILE_B + (_i & 3) * 1024), (LAS unsigned*)(lds + ((k) & 1) * 32768 + wid * 4096 + (_i & 3) * 1024), 16, 0, 0); } while (0)
#define ATT_DMA_V(k) do { const int _tl = ATT_TILE(k); _Pragma("unroll") for (int _i = 0; _i < (ATT_PROBE == 1 ? 8 : 4); ++_i) \
        __builtin_amdgcn_global_load_lds((const unsigned*)(srcV + (size_t)_tl * VTILE_B + (_i & 3) * 1024), (LAS unsigned*)(lds + 65536 + ((k) & 1) * 32768 + wid * 4096 + (_i & 3) * 1024), 16, 0, 0); } while (0)
#define ATT_WAITBAR(n) do { if (ATT_PROBE == 1 && n == 4) asm volatile("s_waitcnt vmcnt(8)" ::: "memory"); else asm volatile("s_waitcnt vmcnt(" #n ")" ::: "memory"); __builtin_amdgcn_s_barrier(); asm volatile("" ::: "memory"); } while (0)
    f32x16 o[8];
#pragma unroll
    for (int d = 0; d < 8; ++d) o[d] = (f32x16){0.f, 0.f, 0.f, 0.f, 0.f, 0.f, 0.f, 0.f, 0.f, 0.f, 0.f, 0.f, 0.f, 0.f, 0.f, 0.f};
    float m_run = -1e30f, l_run = 0.f;
    u32x4 pw[4] = {{0u, 0u, 0u, 0u}, {0u, 0u, 0u, 0u}, {0u, 0u, 0u, 0u}, {0u, 0u, 0u, 0u}};
    int vsw[4];
#pragma unroll
    for (int sx = 0; sx < 4; ++sx) vsw[sx] = r32 * 128 + (((2 * sx + hi) ^ ((r32 >> 1) & 7)) * 16);
    const int kbase = mp * KTILE_B + hi * 1024 + r32 * 16;
    ATT_DMA_K(0); ATT_DMA_V(0);
#define ATT_VADDR(tt) ((int)(unsigned)(uintptr_t)(lds + 65536 + ((tt) & 1) * 32768))
    if (mp == 0 || !ATT_STAGGER) {
        for (int t = 0; t < NT; ++t) {
            const int tl = ATT_TILE(t);
            ATT_WAITBAR(4);
            if (t + 1 < NT) ATT_DMA_K(t + 1);
            if (tl <= tmax) qk_sm(o, m_run, l_run, pw, lds + (t & 1) * 32768 + kbase, qr, tl == 0);
            if (t + 1 < NT) { ATT_WAITBAR(4); ATT_DMA_V(t + 1); } else ATT_WAITBAR(0);
            if (tl <= tmax) pv_all(o, ATT_VADDR(t), vsw, pw);
        }
        ATT_WAITBAR(0);
    } else {
        for (int t = 0; t < NT; ++t) {
            const int tl = ATT_TILE(t);
            ATT_WAITBAR(4);
            if (t + 1 < NT) ATT_DMA_K(t + 1);
            if (t >= 1 && ATT_TILE(t - 1) <= tmax) pv_all(o, ATT_VADDR(t - 1), vsw, pw);
            if (t + 1 < NT) { ATT_WAITBAR(4); ATT_DMA_V(t + 1); } else ATT_WAITBAR(0);
            if (tl <= tmax) qk_sm(o, m_run, l_run, pw, lds + (t & 1) * 32768 + kbase, qr, tl == 0);
        }
        ATT_WAITBAR(0);
        if (ATT_TILE(NT - 1) <= tmax) pv_all(o, ATT_VADDR(NT - 1), vsw, pw);
    }
#undef ATT_VADDR
    asm volatile("s_waitcnt vmcnt(0) lgkmcnt(0)" ::: "memory"); __builtin_amdgcn_s_barrier(); asm volatile("" ::: "memory");
    const float ltot = l_run + xch32(l_run);
    const float inv = __builtin_amdgcn_rcpf(ltot);
    LAS float* xb = (LAS float*)lds + (size_t)rg * 8192;
    if (mp == 1) {
        const float sc = *(const LAS float*)(lds + MISC_OFF + 64) * inv;
#pragma unroll
        for (int d = 0; d < 8; ++d) {
#pragma unroll
            for (int r = 0; r < 16; ++r) xb[(d * 16 + r) * 64 + lane] = o[d][r] * sc;
            asm volatile("" ::: "memory"); }
    }
    asm volatile("s_waitcnt lgkmcnt(0)" ::: "memory"); __builtin_amdgcn_s_barrier(); asm volatile("" ::: "memory");
    if (mp == 0) {
        float ss = 0.f;
#pragma unroll
        for (int d = 0; d < 8; ++d) {
#pragma unroll
            for (int r = 0; r < 16; ++r) { const float v = o[d][r] * inv - xb[(d * 16 + r) * 64 + lane]; o[d][r] = v; ss = fmaf(v, v, ss); }
            asm volatile("" : "+v"(ss) :: "memory"); }
        ss += xch32(ss);
        const float rstd = __builtin_amdgcn_rsqf(ss * (1.0f / 256.0f) + RMS_EPS) * 0.8f;
        const bool valid = !meta || r32 < 16;
        const bf16_t* gp = Gt + qrow * DM + h * 256; bf16_t* op = O + qrow * DM + h * 256;
#pragma unroll
        for (int d = 0; d < 8; ++d)
#pragma unroll
            for (int rq = 0; rq < 4; ++rq) {
                const int dd = 32 * d + 8 * rq + 4 * hi;
                const u32x2 g = *(const u32x2*)(gp + dd); const f32x4 sg = *(const f32x4*)(subln_g + dd);
                const float v0 = o[d][4 * rq + 0] * rstd * sg[0] * bflo(g.x), v1 = o[d][4 * rq + 1] * rstd * sg[1] * bfhi(g.x);
                const float v2 = o[d][4 * rq + 2] * rstd * sg[2] * bflo(g.y), v3 = o[d][4 * rq + 3] * rstd * sg[3] * bfhi(g.y);
                u32x2 w; w.x = pk2(v0, v1); w.y = pk2(v2, v3);
                if (valid) *(u32x2*)(op + dd) = w;
                asm volatile("" ::: "memory");
            }
    }
    asm volatile("s_waitcnt vmcnt(0) lgkmcnt(0)" ::: "memory"); __builtin_amdgcn_s_barrier(); asm volatile("" ::: "memory");
#undef ATT_TILE
#undef ATT_DMA_K
#undef ATT_DMA_V
#undef ATT_WAITBAR
}
#undef ATT_WL
}

__global__ void __launch_bounds__(512, 2) trunk_fwd(Args args) {
    extern __shared__ __attribute__((aligned(16))) unsigned char lds_raw[];
    Frame F;
    F.lds = (LAS unsigned char*)lds_raw;
    F.tid = threadIdx.x; F.lane = F.tid & 63; F.wave = __builtin_amdgcn_readfirstlane(F.tid >> 6);
    F.G = gridDim.x; { const int bx = blockIdx.x; F.vcu = (F.G % 8 == 0) ? (bx % 8) * (F.G / 8) + bx / 8 : bx; }
    volatile LAS unsigned* MISC = (volatile LAS unsigned*)(F.lds + MISC_OFF);
    unsigned char* ws = args.ws;
    gu32* ctl = (gu32*)(ws + WS_CTL);
    for (int u = F.tid; u < (LDS_BYTES - LDSCTL_OFF) / 4; u += 512) ((LAS unsigned*)(F.lds + LDSCTL_OFF))[u] = 0u;
    __syncthreads();
    XcdBarrier bar; bar.bar = (unsigned*)(ctl + CW_BAR); bar.x = 0; bar.st = nullptr;
    if (MK_N_LAUNCHES == 1) bar = xcd_barrier_post((unsigned*)(ctl + CW_BAR), MISC + 8);
#define GRID_BAR() do { if (MK_N_LAUNCHES == 1) xcd_barrier(bar); } while (0)
    const int lo = args.ph_lo, hi = args.ph_hi;
#define IN(k) (lo <= (k) && (k) < hi)
#define REPS(k) for (int rep_ = 0; rep_ < ((k) == PROBE_PH ? 1 + PROBE_REP : 1); ++rep_)

    const float* x = args.in[0]; const float* meta_tok = args.in[1]; const float* pre_g = args.in[2]; const float* post_g = args.in[3];
    const float* attn_w_in = args.in[4]; const float* attn_w_out = args.in[5];
    const float* lq1 = args.in[6]; const float* lk1 = args.in[7]; const float* lq2 = args.in[8]; const float* lk2 = args.in[9];
    const float* subln_g = args.in[10];
    const float* pool_w_in = args.in[11]; const float* pool_w_group = args.in[12]; const float* pool_scale = args.in[13]; const float* pool_w_out = args.in[14];
    bf16_t* W1 = (bf16_t*)(ws + WS_W1); bf16_t* W2 = (bf16_t*)(ws + WS_W2); bf16_t* W3 = (bf16_t*)(ws + WS_W3); bf16_t* W4 = (bf16_t*)(ws + WS_W4); bf16_t* W5 = (bf16_t*)(ws + WS_W5);
    bf16_t* XN = (bf16_t*)(ws + WS_XN); bf16_t* GB = (bf16_t*)(ws + WS_G); bf16_t* QO = (bf16_t*)(ws + WS_QO);
    unsigned char* Kimg = ws + WS_K; unsigned char* Vimg = ws + WS_V;
    bf16_t* Y0 = (bf16_t*)(ws + WS_Y0); bf16_t* Y1 = (bf16_t*)(ws + WS_Y1);
    bf16_t* UB = (bf16_t*)(ws + WS_U); bf16_t* G1 = (bf16_t*)(ws + WS_G1); bf16_t* MIX = (bf16_t*)(ws + WS_MIX); bf16_t* GATED1 = (bf16_t*)(ws + WS_GATED1);
    float* ropec = (float*)(ws + WS_ROPEC); float* ropes = (float*)(ws + WS_ROPES); float* rstd0 = (float*)(ws + WS_RSTD0);
    const int gw = F.vcu * 8 + F.wave, NGW = F.G * 8;
    const int gtid = F.vcu * 512 + F.tid, NGT = F.G * 512;

    Epi E; E.mode = 0; E.Q = QO; E.Kimg = Kimg; E.Vimg = Vimg; E.G = GB; E.ropec = ropec; E.ropes = ropes; E.Y = Y0; E.U = UB; E.G1 = G1; E.GATED1 = GATED1; E.pool_scale = pool_scale;

    if (IN(0)) REPS(0) {
        LAS float* scr = (LAS float*)(F.lds + F.wave * 16384);
        constexpr int I1 = (DM / 64) * (4 * DM / 32), I2 = (DM / 64) * (DM / 32), I3 = (DM / 64) * (2 * DM / 32), I4 = (512 / 64) * (512 / 32), I5 = I2;
        constexpr int NITEMS = I1 + I2 + I3 + 4 * I4 + I5;
        for (int it = gw; it < NITEMS; it += NGW) {
            int r = it;
            if (r < I1) { p0_transpose_item(attn_w_in, 4 * DM, W1, DM, 0, scr, r, F.lane); continue; } r -= I1;
            if (r < I2) { p0_transpose_item(attn_w_out, DM, W2, DM, 0, scr, r, F.lane); continue; } r -= I2;
            if (r < I3) { p0_transpose_item(pool_w_in, 2 * DM, W3, DM, 0, scr, r, F.lane); continue; } r -= I3;
            if (r < 4 * I4) { const int g = r / I4; p0_transpose_item(pool_w_group + (size_t)g * 512 * 512, 512, W4, 512, g * 512, scr, r % I4, F.lane); continue; } r -= 4 * I4;
            p0_transpose_item(pool_w_out, DM, W5, DM, 0, scr, r, F.lane);
        }
        for (int i = gtid; i < LTOT * 16; i += NGT) {
            const int pos = i >> 4, k = i & 15; const float ang = (float)pos * args.inv_freq[k];
            double rev = (double)ang * 0.15915494309189535; rev -= floor(rev);
            const float fr = (float)rev; ropec[i] = __builtin_amdgcn_cosf(fr); ropes[i] = __builtin_amdgcn_sinf(fr);
        }
        for (int m = gw; m < MROWS; m += NGW) {
            const float* src = m < MREAL ? x + (size_t)m * DM : meta_tok + (size_t)(m - MREAL) * DM;
            f32x4 v[8]; load_row(src, F.lane, v);
            const float rstd = __builtin_amdgcn_rsqf(row_ss(v) * (1.0f / DM) + RMS_EPS);
#pragma unroll
            for (int j = 0; j < 8; ++j) v[j] = v[j] * rstd * *(const f32x4*)(pre_g + 4 * (64 * j + F.lane));
            store_row_bf16(XN + (size_t)m * DM, F.lane, v);
        }
        const u32x4 z = {0u, 0u, 0u, 0u};
        for (int i = gtid; i < NB * NH * 2 * 1024; i += NGT) *(u32x4*)(Kimg + (size_t)(i >> 10) * NTILE * KTILE_B + (i & 1023) * 16) = z;
        for (int i = gtid; i < NB * NH * 2048; i += NGT) *(u32x4*)(Vimg + (size_t)(i >> 11) * NTILE * VTILE_B + (i & 2047) * 16) = z;
        GRID_BAR();
    }
    if (IN(1)) REPS(1) {
        E.mode = 1;
        rows16_phase(F, XN + (size_t)MREAL * DM, DM, W1, DM, DM, 4 * DM / 32, 0, 1 << 30, E);
        { pg8::Gemm g{XN, W1, MREAL, 3 * DM, DM, DM, DM, 1 << 30, 0}; pg8::StaticOrder S; S.init(MREAL, 3 * DM, F.G, (int)blockIdx.x); S.skip_from = 16; S.skip_n = 8;
          pg8::gemm_phase<true>(F.lds, g, S, E); }
        { E.mode = 6;
          pg8::Gemm g{W1 + (size_t)2 * DM * DM, XN, DM, MREAL, DM, DM, DM, 1 << 30, 0}; pg8::StaticOrder S; S.init(DM, MREAL, F.G, (int)blockIdx.x);
          pg8::gemm_phase<true>(F.lds, g, S, E); }
        GRID_BAR();
    }
    if (IN(2)) REPS(2) {
        float d1 = 0.f, d2 = 0.f;
#pragma unroll
        for (int j = 0; j < 2; ++j) { d1 += lq1[F.lane + 64 * j] * lk1[F.lane + 64 * j]; d2 += lq2[F.lane + 64 * j] * lk2[F.lane + 64 * j]; }
        const float lam = expf(wave_sum(d1)) - expf(wave_sum(d2)) + 0.2f;
        if (F.tid == 0) *(LAS float*)(F.lds + MISC_OFF + 64) = lam;
        __syncthreads();
        if (ATT_STATICPRIO && F.wave >= 4) __builtin_amdgcn_s_setprio(1);
        const bool g256 = false && F.G == 256; const int xg = F.vcu >> 5, li = F.vcu & 31;
        for (int r = 0; g256 ? r < 3 : F.vcu + r * F.G < 520; ++r) {
            int bh, qb, desc;
            if (g256) { if (r == 2 && li != 0) break; bh = r == 2 ? xg : 2 * xg + r; qb = r == 0 ? li : (r == 1 ? 31 - li : -1); desc = r == 1; }
            else { const int u = F.vcu + r * F.G; desc = 0; if (u < 256) { bh = u >> 4; qb = u & 15; } else if (u < 512) { bh = (u - 256) >> 4; qb = 31 - ((u - 256) & 15); } else { bh = u - 512; qb = -1; } }
            att::attn_unit(F, QO, Kimg, Vimg, GB, XN, subln_g, bh >> 3, bh & 7, qb, desc);
        }
        if (ATT_STATICPRIO) __builtin_amdgcn_s_setprio(0);
        GRID_BAR();
    }
    if (IN(3)) REPS(3) {
        E.mode = 2; E.Y = Y0;
        rows16_phase(F, XN + (size_t)MREAL * DM, DM, W2, DM, DM, DM / 32, 0, 1 << 30, E);
        pg8::Gemm g{XN, W2, MREAL, DM, DM, DM, DM, 1 << 30, 0}; pg8::StaticOrder S; S.init(MREAL, DM, F.G, (int)blockIdx.x);
        pg8::gemm_phase<true>(F.lds, g, S, E);
        GRID_BAR();
    }
    if (IN(4)) REPS(4) {
        for (int m = gw; m < MROWS; m += 2 * NGW) {
            const int mb = (m + NGW < MROWS) ? m + NGW : m;
            f32x4 ya[8], ha[8], yb[8], hb[8];
            load_row_bf16(Y0 + (size_t)m * DM, F.lane, ya); load_row_bf16(Y0 + (size_t)mb * DM, F.lane, yb);
            load_row(m < MREAL ? x + (size_t)m * DM : meta_tok + (size_t)(m - MREAL) * DM, F.lane, ha);
            load_row(mb < MREAL ? x + (size_t)mb * DM : meta_tok + (size_t)(mb - MREAL) * DM, F.lane, hb);
            float sa, sb; row_ss2(ya, yb, sa, sb);
            const float ra0 = __builtin_amdgcn_rsqf(sa * (1.0f / DM) + RMS_EPS), rb0 = __builtin_amdgcn_rsqf(sb * (1.0f / DM) + RMS_EPS);
            if (F.lane == 0) { rstd0[m] = ra0; rstd0[mb] = rb0; }
#pragma unroll
            for (int j = 0; j < 8; ++j) { const f32x4 gp = *(const f32x4*)(post_g + 4 * (64 * j + F.lane)); ha[j] = ha[j] + ya[j] * ra0 * gp; hb[j] = hb[j] + yb[j] * rb0 * gp; }
            row_ss2(ha, hb, sa, sb);
            const float ra1 = __builtin_amdgcn_rsqf(sa * (1.0f / DM) + RMS_EPS), rb1 = __builtin_amdgcn_rsqf(sb * (1.0f / DM) + RMS_EPS);
#pragma unroll
            for (int j = 0; j < 8; ++j) { const f32x4 gq = *(const f32x4*)(pre_g + DM + 4 * (64 * j + F.lane)); ha[j] = ha[j] * ra1 * gq; hb[j] = hb[j] * rb1 * gq; }
            store_row_bf16(XN + (size_t)m * DM, F.lane, ha);
            if (mb != m) store_row_bf16(XN + (size_t)mb * DM, F.lane, hb);
        }
        GRID_BAR();
    }
    if (IN(5)) REPS(5) {
        E.mode = 3;
        rows16_phase(F, XN + (size_t)MREAL * DM, DM, W3, DM, DM, DM / 32, 0, 1 << 30, E);
        pg8::Gemm g{XN, W3, MREAL, 2 * DM, DM, DM, DM, 1 << 30, 0}; pg8::StaticOrder S; S.init(MREAL, 2 * DM, F.G, (int)blockIdx.x);
        pg8::gemm_phase<true>(F.lds, g, S, E);
        GRID_BAR();
    }
    if (IN(6)) REPS(6) {
        for (int idx = gtid; idx < (MREAL / 16) * 256; idx += NGT) {
            const int strip = idx >> 8, c0 = (idx & 255) * 8, gi = c0 >> 9;
            if (gi == 0) mix_strip<2>(UB, MIX, strip, c0); else if (gi == 1) mix_strip<4>(UB, MIX, strip, c0);
            else if (gi == 2) mix_strip<8>(UB, MIX, strip, c0); else mix_strip<16>(UB, MIX, strip, c0);
        }
        GRID_BAR();
    }
    if (IN(7)) REPS(7) {
        E.mode = 4;
        pg8::Gemm g{MIX, W4, MREAL, DM, 512, DM, 512, 2, 512}; pg8::StaticOrder S; S.init(MREAL, DM, F.G, (int)blockIdx.x);
        pg8::gemm_phase<true>(F.lds, g, S, E);
        GRID_BAR();
    }
    if (IN(8)) REPS(8) {
        E.mode = 5; E.Y = Y1;
        pg8::Gemm g{GATED1, W5, MREAL, DM, DM, DM, DM, 1 << 30, 0}; pg8::StaticOrder S; S.init(MREAL, DM, F.G, (int)blockIdx.x);
        pg8::gemm_phase<true>(F.lds, g, S, E);
        GRID_BAR();
    }
    if (IN(9)) REPS(9) {
        for (int m = gw; m < MREAL; m += NGW) {
            f32x4 y1[8], acc[8]; load_row_bf16(Y1 + (size_t)m * DM, F.lane, y1); load_row(x + (size_t)m * DM, F.lane, acc);
            const float r0 = rstd0[m];
            const float r1 = __builtin_amdgcn_rsqf(row_ss(y1) * (1.0f / DM) + RMS_EPS);
#pragma unroll
            for (int j = 0; j < 8; ++j) {
                const int e = 4 * (64 * j + F.lane);
                const u32x2 y0w = *(const u32x2*)(Y0 + (size_t)m * DM + e); const f32x4 y0 = {bflo(y0w.x), bfhi(y0w.x), bflo(y0w.y), bfhi(y0w.y)};
                acc[j] = acc[j] + y0 * r0 * *(const f32x4*)(post_g + e) + y1[j] * r1 * *(const f32x4*)(post_g + DM + e);
                *(f32x4*)(args.out + (size_t)m * DM + e) = acc[j];
            }
        }
    }
#undef IN
#undef GRID_BAR
}

extern "C" void kernel_launch(void* const* d_in, const int* in_sizes, int n_in, void* d_out, int out_size, void* d_ws, size_t ws_size, hipStream_t stream) {
    static int grid = 0;
    if (grid == 0) {
        if (n_in != 15 || in_sizes[0] != NB * SEQ * DM || out_size != NB * SEQ * DM || ws_size < WS_END) {
            fprintf(stderr, "kernel_launch: unexpected shapes (n_in %d, in0 %d, out %d, ws %zu)\n", n_in, n_in > 0 ? in_sizes[0] : -1, out_size, ws_size); grid = -1; return; }
        int dev = 0, cus = 0, per_cu = 0;
        if (hipGetDevice(&dev) != hipSuccess || hipDeviceGetAttribute(&cus, hipDeviceAttributeMultiprocessorCount, dev) != hipSuccess) { grid = -1; return; }
        if (hipFuncSetAttribute((const void*)trunk_fwd, hipFuncAttributeMaxDynamicSharedMemorySize, LDS_BYTES) != hipSuccess) { fprintf(stderr, "kernel_launch: hipFuncSetAttribute failed\n"); grid = -1; return; }
        if (hipOccupancyMaxActiveBlocksPerMultiprocessor(&per_cu, (const void*)trunk_fwd, 512, LDS_BYTES) != hipSuccess || per_cu < 1) {
            fprintf(stderr, "kernel_launch: occupancy query reports %d workgroups per CU\n", per_cu); (void)hipGetLastError(); grid = -1; return; }
        grid = cus;
    }
    if (grid < 0) return;
    (void)hipMemsetAsync((char*)d_ws + WS_CTL, 0, CTL_ZERO_BYTES, stream);
    Args a{};
    for (int i = 0; i < 15; ++i) a.in[i] = (const float*)d_in[i];
    a.out = (float*)d_out; a.ws = (unsigned char*)d_ws;
    for (int i = 0; i < 16; ++i) a.inv_freq[i] = (float)pow(500000.0, -(double)i / 16.0);
#if MK_N_LAUNCHES == 1
    a.ph_lo = 0; a.ph_hi = 10; a.li = 0;
    hipLaunchKernelGGL(trunk_fwd, dim3(grid), dim3(512), LDS_BYTES, stream, a);
#else
    for (int p = 0; p < 10; ++p) { a.ph_lo = p; a.ph_hi = p + 1; a.li = p; hipLaunchKernelGGL(trunk_fwd, dim3(grid), dim3(512), LDS_BYTES, stream, a); }
#endif
    const hipError_t le = hipPeekAtLastError();
    if (le != hipSuccess) fprintf(stderr, "kernel_launch: launch failed: %s\n", hipGetErrorName(le));
}
```

```cpp
#include <hip/hip_runtime.h>
#include <cstdio>
#include <cstdint>
#include <cmath>

#ifndef MK_N_LAUNCHES
#define MK_N_LAUNCHES 1
#endif
#ifndef PROBE_PH
#define PROBE_PH (-1)
#endif
#ifndef PROBE_REP
#define PROBE_REP 0
#endif

#define LAS __attribute__((address_space(3)))
#define GAS __attribute__((address_space(1)))
typedef unsigned short bf16_t;
typedef short bf16x8 __attribute__((ext_vector_type(8)));
typedef short s16x4 __attribute__((ext_vector_type(4)));
typedef float f32x4 __attribute__((ext_vector_type(4)));
typedef float f32x16 __attribute__((ext_vector_type(16)));
typedef unsigned u32x4 __attribute__((ext_vector_type(4)));
typedef unsigned u32x2 __attribute__((ext_vector_type(2)));

constexpr int DM = 2048, SEQ = 4096, NB = 2, NMETA = 16, LTOT = SEQ + NMETA;
constexpr int MREAL = NB * SEQ;
constexpr int MROWS = MREAL + NMETA;
constexpr int NH = 8, HD = 128, VD = 256;
constexpr int NTILE = 65;
constexpr int KTILE_B = 64 * 128 * 2, VTILE_B = 64 * 256 * 2;
constexpr float RMS_EPS = 1e-6f;
constexpr float C2 = 0.08838834764831845f * 1.4426950408889634f;
constexpr float LOG2E = 1.4426950408889634f;

constexpr size_t MiB = 1u << 20;
constexpr size_t WS_CTL = 0, CTL_ZERO_BYTES = 65536;
constexpr size_t WS_ROPEC = 1 * MiB, WS_ROPES = 1 * MiB + 512 * 1024;
constexpr size_t WS_RSTD0 = 2 * MiB;
constexpr size_t WS_W1 = 4 * MiB, WS_W2 = 36 * MiB, WS_W3 = 44 * MiB, WS_W4 = 60 * MiB, WS_W5 = 62 * MiB;
constexpr size_t WS_XN = 70 * MiB, WS_G = 104 * MiB, WS_QO = 138 * MiB, WS_K = 172 * MiB;
constexpr size_t KIMG_BYTES = (size_t)NB * NH * 2 * NTILE * KTILE_B, VIMG_BYTES = (size_t)NB * NH * NTILE * VTILE_B;
constexpr size_t WS_V = WS_K + KIMG_BYTES;
constexpr size_t WS_Y0 = WS_K;
constexpr size_t WS_U = WS_QO, WS_G1 = WS_G, WS_MIX = WS_XN, WS_GATED1 = WS_QO, WS_Y1 = WS_XN;
constexpr size_t WS_END = WS_V + VIMG_BYTES;
static_assert(WS_END <= 240 * MiB && WS_Y0 + (size_t)MROWS * DM * 2 <= WS_END && WS_Y1 + (size_t)MROWS * DM * 2 <= WS_G, "ws map");
constexpr int CW_BAR = 4096;

constexpr int RING_BYTES = 131072, LDSCTL_OFF = RING_BYTES, MISC_OFF = LDSCTL_OFF + 320, LDS_BYTES = 147456;

__device__ __forceinline__ int lane_id() { int l = (int)__builtin_amdgcn_mbcnt_hi(~0u, __builtin_amdgcn_mbcnt_lo(~0u, 0u)); asm volatile("" : "+v"(l)); return l; }
__device__ __forceinline__ unsigned pk2(float lo, float hi) {
    typedef float f2_t __attribute__((ext_vector_type(2))); typedef __bf16 b2_t __attribute__((ext_vector_type(2)));
    f2_t v = {lo, hi}; b2_t b = __builtin_convertvector(v, b2_t); return __builtin_bit_cast(unsigned, b);
}
__device__ __forceinline__ float bflo(unsigned u) { return __uint_as_float(u << 16); }
__device__ __forceinline__ float bfhi(unsigned u) { return __uint_as_float(u & 0xffff0000u); }
__device__ __forceinline__ float siluf(float x) { return x * __builtin_amdgcn_rcpf(1.0f + __builtin_amdgcn_exp2f(-x * LOG2E)); }
__device__ __forceinline__ float wave_sum(float v) {
#pragma unroll
    for (int o = 1; o < 64; o <<= 1) v += __shfl_xor(v, o);
    return v;
}
__device__ __forceinline__ u32x4 pack8(f32x4 a, f32x4 b) { u32x4 w; w.x = pk2(a[0], a[1]); w.y = pk2(a[2], a[3]); w.z = pk2(b[0], b[1]); w.w = pk2(b[2], b[3]); return w; }

struct Epi {
    int mode;
    bf16_t* Q; unsigned char* Kimg; unsigned char* Vimg; bf16_t* G; const float* ropec; const float* ropes;
    bf16_t* Y;
    bf16_t* U; bf16_t* G1;
    bf16_t* GATED1; const float* pool_scale;
    template <int MODE> __device__ __forceinline__ void emit(int row, int col, f32x4 a, f32x4 b) const {
        if constexpr (MODE == 1) {
            if (col < 4096) {
                const int c = col & 2047, dim = c & 127;
                if (dim < 32) {
                    f32x4 pa, pb;
#pragma unroll
                    for (int i = 0; i < 4; ++i) { pa[i] = __shfl_xor(a[i], 32); pb[i] = __shfl_xor(b[i], 32); }
                    const int pos = row < MREAL ? NMETA + (row & (SEQ - 1)) : row - MREAL;
                    const float* cs = ropec + pos * 16 + (dim & 15); const float* sn = ropes + pos * 16 + (dim & 15);
                    const f32x4 c0 = *(const f32x4*)cs, c1 = *(const f32x4*)(cs + 4), s0 = *(const f32x4*)sn, s1 = *(const f32x4*)(sn + 4);
                    if (dim < 16) { a = a * c0 - pa * s0; b = b * c1 - pb * s1; } else { a = a * c0 + pa * s0; b = b * c1 + pb * s1; }
                }
                if (col < 2048) { a = a * C2; b = b * C2; *(u32x4*)(Q + (size_t)row * DM + c) = pack8(a, b); }
                else {
                    const int h = c >> 8, mp = (c >> 7) & 1; const u32x4 w = pack8(a, b);
                    const size_t inner = (size_t)(dim >> 3) * 1024;
                    if (row < MREAL) { const int bb = row >> 12, j = row & (SEQ - 1), tile = 1 + (j >> 6), key = j & 63;
                        *(u32x4*)(Kimg + ((size_t)((bb * NH + h) * 2 + mp) * NTILE + tile) * KTILE_B + inner + key * 16) = w; }
                    else { const int key = row - MREAL;
#pragma unroll
                        for (int bb = 0; bb < NB; ++bb) *(u32x4*)(Kimg + ((size_t)((bb * NH + h) * 2 + mp) * NTILE) * KTILE_B + inner + key * 16) = w; }
                }
            } else if (col < 6144) {
                const int c = col - 4096, h = c >> 8, d0 = c & 255, key = row - MREAL;
                const int slot = (key & 3) | (((key >> 3) & 1) << 2) | (((key >> 2) & 1) << 3);
                const float vals[8] = {a[0], a[1], a[2], a[3], b[0], b[1], b[2], b[3]};
                if (row >= MREAL) {
#pragma unroll
                    for (int i = 0; i < 8; ++i) { const int d = d0 + i; const unsigned short bv = (unsigned short)(pk2(vals[i], 0.f) & 0xffffu);
                        const size_t off = (size_t)d * 128 + (((slot >> 3) ^ ((d >> 1) & 7)) * 16) + (slot & 7) * 2;
#pragma unroll
                        for (int bb = 0; bb < NB; ++bb) *(unsigned short*)(Vimg + ((size_t)(bb * NH + h) * NTILE) * VTILE_B + off) = bv; }
                }
            } else {
                const int c = col - 6144;
#pragma unroll
                for (int i = 0; i < 4; ++i) { a[i] = siluf(a[i]); b[i] = siluf(b[i]); }
                *(u32x4*)(G + (size_t)row * DM + c) = pack8(a, b);
            }
        } else if constexpr (MODE == 2 || MODE == 5) {
            *(u32x4*)(Y + (size_t)row * DM + col) = pack8(a, b);
        } else if constexpr (MODE == 3) {
            if (col < 2048) { *(u32x4*)(U + (size_t)row * DM + col) = pack8(a, b); }
            else { const int c = col - 2048;
#pragma unroll
                for (int i = 0; i < 4; ++i) { a[i] = siluf(a[i]); b[i] = siluf(b[i]); }
                *(u32x4*)(G1 + (size_t)row * DM + c) = pack8(a, b); }
        } else if constexpr (MODE == 6) {
            const int h = row >> 8, d = row & 255, bb = col >> 12, j = col & (SEQ - 1), tile = 1 + (j >> 6), k0 = j & 63, sidx = k0 >> 4, aa = (k0 >> 3) & 1;
            unsigned char* base = Vimg + ((size_t)(bb * NH + h) * NTILE + tile) * VTILE_B + (size_t)d * 128 + 8 * aa; const int x = (d >> 1) & 7;
            u32x2 w0, w1; w0.x = pk2(a[0], a[1]); w0.y = pk2(a[2], a[3]); w1.x = pk2(b[0], b[1]); w1.y = pk2(b[2], b[3]);
            *(u32x2*)(base + (((2 * sidx) ^ x) * 16)) = w0; *(u32x2*)(base + (((2 * sidx + 1) ^ x) * 16)) = w1;
        } else {
            const f32x4 s0 = *(const f32x4*)(pool_scale + col), s1 = *(const f32x4*)(pool_scale + col + 4);
            const u32x4 g = *(const u32x4*)(G1 + (size_t)row * DM + col);
            a[0] *= s0[0] * bflo(g.x); a[1] *= s0[1] * bfhi(g.x); a[2] *= s0[2] * bflo(g.y); a[3] *= s0[3] * bfhi(g.y);
            b[0] *= s1[0] * bflo(g.z); b[1] *= s1[1] * bfhi(g.z); b[2] *= s1[2] * bflo(g.w); b[3] *= s1[3] * bfhi(g.w);
            *(u32x4*)(GATED1 + (size_t)row * DM + col) = pack8(a, b);
        }
    }
    __device__ __forceinline__ void emit_rt(int row, int col, f32x4 a, f32x4 b) const {
        if (mode == 1) emit<1>(row, col, a, b); else if (mode == 2 || mode == 5) emit<2>(row, col, a, b); else if (mode == 3) emit<3>(row, col, a, b); else if (mode == 6) emit<6>(row, col, a, b); else emit<4>(row, col, a, b);
    }
};

namespace pg8 {
constexpr int BM = 256, BK = 64, HALF = 128, HTB = HALF * BK * 2, STAGE_BYTES = 8 * HTB, NXCD = 8, WGM = 8;
__host__ __device__ __forceinline__ int lds_byte(int r, int c) { const int st = (r >> 4) * 2 + (c >> 5), rr = r & 15, cc = c & 31, ob = rr * 64 + cc * 2; return st * 1024 + (ob ^ (((ob >> 9) & 1) << 5)); }
__host__ __device__ __forceinline__ void stage_rc(int b, int& R, int& C) { const int st = b / 1024, sb = b % 1024, swz = sb ^ (((sb >> 9) & 1) << 5); R = (st >> 1) * 16 + swz / 64; C = (st & 1) * 32 + (swz % 64) / 2; }
__host__ __device__ __forceinline__ int perm32(int rho) { const int n = rho >> 4, i = rho & 15; return 8 * (i >> 2) + 4 * n + (i & 3); }
struct Unit { int pm, pn; };
struct Gemm { const bf16_t* A; const bf16_t* Bt; int M, N, K, lda, ldb, pn_per_grp, a_grp_cols; };
struct StaticOrder {
    int nM, nN, nwg, G, c, skip_from, skip_n;
    __device__ void init(int M, int N, int G_, int c_) { nM = M / BM; nN = N / BM; nwg = nM * nN; G = G_; c = c_; skip_from = 1 << 30; skip_n = 0; }
    __device__ bool next(int i, Unit& u) const {
        const long L = (long)i * G + c; if (L >= nwg) return false;
        int wgid = (int)L; { const int q = nwg / NXCD, r = nwg % NXCD, xcd = wgid % NXCD, off = wgid / NXCD; wgid = (xcd < r ? xcd * (q + 1) : r * (q + 1) + (xcd - r) * q) + off; }
        const int nig = WGM * nN, gid = wgid / nig, fm = gid * WGM, gsz = (nM - fm) < WGM ? (nM - fm) : WGM;
        u.pm = fm + ((wgid % nig) % gsz); u.pn = (wgid % nig) / gsz; if (u.pn >= skip_from) u.pn += skip_n; return true;
    }
};
template <int MODE>
__device__ __forceinline__ void run_epi_m(const Epi& E, const f32x4 (&acc)[2][2][4][2], const Unit& u, int wr, int wc) {
    int lane = lane_id();
    const int fr = lane & 15, fq = lane >> 4;
#pragma unroll
    for (int ai = 0; ai < 2; ++ai)
#pragma unroll
        for (int m = 0; m < 4; ++m) { const int row = u.pm * BM + ai * HALF + wr * 64 + m * 16 + fr;
#pragma unroll
            for (int bj = 0; bj < 2; ++bj) { const int col = u.pn * BM + bj * HALF + wc * 32 + 8 * fq; E.emit<MODE>(row, col, acc[ai][bj][m][0], acc[ai][bj][m][1]); asm volatile("" ::: "memory"); } }
}
__device__ __forceinline__ void run_epi(const Epi& E, const f32x4 (&acc)[2][2][4][2], const Unit& u, int wr, int wc, int fr, int fq) {
    if (E.mode == 1) run_epi_m<1>(E, acc, u, wr, wc); else if (E.mode == 2 || E.mode == 5) run_epi_m<2>(E, acc, u, wr, wc);
    else if (E.mode == 3) run_epi_m<3>(E, acc, u, wr, wc); else if (E.mode == 6) run_epi_m<6>(E, acc, u, wr, wc); else run_epi_m<4>(E, acc, u, wr, wc);
}
template <bool ALIGN_EPI>
__device__ __forceinline__ void gemm_phase(LAS unsigned char* lds, const Gemm g, const StaticOrder& S, const Epi& E, int wave_idx) {
    const int wid = wave_idx, lane = lane_id(), tid = wid * 64 + lane, wr = wid >> 2, wc = wid & 3, fr = lane & 15, fq = lane >> 4;
    const int K = g.K, nt = K / BK;
    unsigned voffA[2], voffB[2];
#pragma unroll
    for (int i = 0; i < 2; ++i) { int R, C; stage_rc(tid * 16 + i * 8192, R, C); const int Rb = (R & ~31) + perm32(R & 31);
        voffA[i] = (unsigned)(R * g.lda + C) * 2u; voffB[i] = (unsigned)(Rb * g.ldb + C) * 2u; }
    const size_t kstep = (size_t)(BK * 2);
    const size_t hstepA = (size_t)HALF * g.lda * 2, hstepB = (size_t)HALF * g.ldb * 2;
    const size_t tstepA = 2 * hstepA, tstepB = 2 * hstepB;
    const unsigned ldsw = (unsigned)wid * 1024u;
    const int aoff = lds_byte(wr * 64 + fr, fq * 8), boff = lds_byte(wc * 32 + fr, fq * 8);
#define PG8_SA(b, h) (((b) * 2 + (h)) * HTB)
#define PG8_SB(b, h) ((4 + (b) * 2 + (h)) * HTB)
#define PG8_STAGE(bufoff, gbase, voff) do { _Pragma("unroll") for (int _i = 0; _i < 2; ++_i) \
        __builtin_amdgcn_global_load_lds((const unsigned*)((const char*)(gbase) + (voff)[_i]), (LAS unsigned*)(lds + (bufoff) + ldsw + _i * 8192), 16, 0, 0); } while (0)
#define PG8_LDA(dst, b, h) do { _Pragma("unroll") for (int m = 0; m < 4; ++m) _Pragma("unroll") for (int k = 0; k < 2; ++k) dst[m][k] = *(const LAS bf16x8*)(lds + PG8_SA(b, h) + aoff + m * 2048 + k * 1024); } while (0)
#define PG8_LDB(dst, b, h) do { _Pragma("unroll") for (int n = 0; n < 2; ++n) _Pragma("unroll") for (int k = 0; k < 2; ++k) dst[n][k] = *(const LAS bf16x8*)(lds + PG8_SB(b, h) + boff + n * 2048 + k * 1024); } while (0)
#define PG8_MMA(ai, bj, At, Bt) do { __builtin_amdgcn_s_setprio(1); _Pragma("unroll") for (int m = 0; m < 4; ++m) _Pragma("unroll") for (int n = 0; n < 2; ++n) _Pragma("unroll") for (int k = 0; k < 2; ++k) \
        acc[ai][bj][m][n] = __builtin_amdgcn_mfma_f32_16x16x32_bf16(Bt[n][k], At[m][k], acc[ai][bj][m][n], 0, 0, 0); __builtin_amdgcn_s_setprio(0); } while (0)
#define PG8_WAIT_V(n) asm volatile("s_waitcnt vmcnt(" #n ")" ::: "memory")
#define PG8_WAIT_L(n) asm volatile("s_waitcnt lgkmcnt(" #n ")" ::: "memory")
#define PG8_BAR __builtin_amdgcn_s_barrier()
#define PG8_SCHED __builtin_amdgcn_sched_barrier(0)
#define PG8_ABASE(u) ((const char*)g.A + (size_t)(u).pm * tstepA + (size_t)((u).pn / g.pn_per_grp) * g.a_grp_cols * 2)
    Unit cur, nxt; int ui = 0;
    if (!S.next(0, cur)) return;
    f32x4 acc[2][2][4][2];
#pragma unroll
    for (int a = 0; a < 2; ++a)
#pragma unroll
        for (int b = 0; b < 2; ++b)
#pragma unroll
            for (int m = 0; m < 4; ++m)
#pragma unroll
                for (int n = 0; n < 2; ++n) acc[a][b][m][n] = (f32x4){0.f, 0.f, 0.f, 0.f};
    bf16x8 At[4][2], B0[2][2], B1[2][2];
    const char* cA = PG8_ABASE(cur); const char* cB = (const char*)g.Bt + (size_t)cur.pn * tstepB;
    PG8_STAGE(PG8_SB(0, 0), cB, voffB); PG8_STAGE(PG8_SB(0, 1), cB + hstepB, voffB); PG8_STAGE(PG8_SA(0, 0), cA, voffA); PG8_STAGE(PG8_SA(0, 1), cA + hstepA, voffA);
    if (wr == 1) PG8_BAR;
    PG8_WAIT_V(2); PG8_BAR;
    PG8_STAGE(PG8_SB(1, 0), cB + kstep, voffB); PG8_STAGE(PG8_SA(1, 0), cA + kstep, voffA); PG8_STAGE(PG8_SB(1, 1), cB + hstepB + kstep, voffB);
    PG8_WAIT_V(6); PG8_BAR;
    for (;;) {
        const bool has_next = S.next(ui + 1, nxt);
        const char* nA = has_next ? PG8_ABASE(nxt) : cA; const char* nB = has_next ? (const char*)g.Bt + (size_t)nxt.pn * tstepB : cB;
        for (int t = 0; t < nt; t += 2) {
            const bool last = (t == nt - 2);
            const char* a1 = cA + (size_t)(t + 1) * kstep;
            const char* a2 = last ? nA : cA + (size_t)(t + 2) * kstep; const char* b2 = last ? nB : cB + (size_t)(t + 2) * kstep;
            const char* a3 = a2 + kstep; const char* b3 = b2 + kstep;
            PG8_LDB(B0, 0, 0); PG8_LDB(B1, 0, 1); PG8_SCHED; PG8_LDA(At, 0, 0); PG8_STAGE(PG8_SA(1, 1), a1 + hstepA, voffA);
            PG8_WAIT_V(8); PG8_WAIT_L(0); PG8_BAR; PG8_MMA(0, 0, At, B0); PG8_MMA(0, 1, At, B1); PG8_BAR; PG8_SCHED;
            PG8_LDA(At, 0, 1); PG8_STAGE(PG8_SB(0, 0), b2, voffB); PG8_STAGE(PG8_SB(0, 1), b2 + hstepB, voffB); PG8_STAGE(PG8_SA(0, 0), a2, voffA);
            PG8_WAIT_V(8); PG8_WAIT_L(0); PG8_BAR; PG8_MMA(1, 0, At, B0); PG8_MMA(1, 1, At, B1); PG8_BAR; PG8_SCHED;
            PG8_LDB(B0, 1, 0); PG8_LDB(B1, 1, 1); PG8_SCHED; PG8_LDA(At, 1, 0); PG8_STAGE(PG8_SA(0, 1), a2 + hstepA, voffA);
            PG8_WAIT_V(8); PG8_WAIT_L(0); PG8_BAR; PG8_MMA(0, 0, At, B0); PG8_MMA(0, 1, At, B1); PG8_BAR; PG8_SCHED;
            PG8_LDA(At, 1, 1); PG8_STAGE(PG8_SB(1, 0), b3, voffB); PG8_STAGE(PG8_SB(1, 1), b3 + hstepB, voffB); PG8_STAGE(PG8_SA(1, 0), a3, voffA);
            PG8_WAIT_V(8); PG8_WAIT_L(0); PG8_BAR; PG8_MMA(1, 0, At, B0); PG8_MMA(1, 1, At, B1); PG8_BAR; PG8_SCHED;
        }
        if constexpr (ALIGN_EPI) { if (wr == 0) PG8_BAR; }
        run_epi(E, acc, cur, wr, wc, fr, fq);
        if (!has_next) break;
#pragma unroll
        for (int a = 0; a < 2; ++a)
#pragma unroll
            for (int b = 0; b < 2; ++b)
#pragma unroll
                for (int m = 0; m < 4; ++m)
#pragma unroll
                    for (int n = 0; n < 2; ++n) acc[a][b][m][n] = (f32x4){0.f, 0.f, 0.f, 0.f};
        cur = nxt; cA = nA; cB = nB; ++ui;
        if constexpr (ALIGN_EPI) { if (wr == 1) PG8_BAR; }
    }
    PG8_WAIT_V(0);
    if constexpr (!ALIGN_EPI) { if (wr == 0) PG8_BAR; }
    PG8_BAR;
#undef PG8_SA
#undef PG8_SB
#undef PG8_STAGE
#undef PG8_LDA
#undef PG8_LDB
#undef PG8_MMA
#undef PG8_WAIT_V
#undef PG8_WAIT_L
#undef PG8_BAR
#undef PG8_SCHED
#undef PG8_ABASE
}
}

typedef GAS unsigned gu32;
#define RLX_AGENT __ATOMIC_RELAXED, __HIP_MEMORY_SCOPE_AGENT
#define XB_TMO      128
#define XB_XCNT(j)  (256  + 64 * (j))
#define XB_XSUB(j)  (1280 + 64 * (j))
#define XB_XGEN(j)  (2304 + 64 * (j))
#define XB_TOP      3328
#define XB_TOPGEN   3392
#define XCD_BAR_WORDS 3456
#define XB_SPIN_CAP (1u << 18)
__device__ __forceinline__ unsigned xb_ld(unsigned* p)              { return __hip_atomic_load(p, __ATOMIC_RELAXED, __HIP_MEMORY_SCOPE_AGENT); }
__device__ __forceinline__ unsigned xb_add(unsigned* p, unsigned v) { return __hip_atomic_fetch_add(p, v, __ATOMIC_RELAXED, __HIP_MEMORY_SCOPE_AGENT); }
__device__ __forceinline__ unsigned xb_xcc_id() { return (unsigned)__builtin_amdgcn_s_getreg((3 << 11) | 20) & 0xFu; }
#define XB_SPIN(cond, bar) do { unsigned _sp = 0; while (cond) { __builtin_amdgcn_s_sleep(1); \
    if ((++_sp & 255u) == 0u) { if (xb_ld(&(bar)[XB_TMO])) break; if (_sp > XB_SPIN_CAP) { atomicAdd(&(bar)[XB_TMO], 1u); break; } } } } while (0)
struct XcdBarrier { unsigned* bar; unsigned x; volatile LAS unsigned* st; bool leader; };
__device__ __forceinline__ XcdBarrier xcd_barrier_post(unsigned* bar, volatile LAS unsigned* st, bool wave0) {
    XcdBarrier b; b.bar = bar; b.x = xb_xcc_id(); b.st = st; b.leader = wave0;
    if (wave0 && lane_id() == 0) (void)xb_add(&bar[XB_XCNT(b.x)], 1u);
    return b;
}
__device__ __forceinline__ void xcd_barrier_complete(unsigned* bar, unsigned x, unsigned& nloc, unsigned& nx) {
    const unsigned G = gridDim.x * gridDim.y * gridDim.z;
    unsigned sum, cnt, mine, sp = 0u;
    for (;;) {
        sum = 0u; cnt = 0u; mine = 0u;
#pragma unroll
        for (unsigned j = 0; j < 16; ++j) { const unsigned c = xb_ld(&bar[XB_XCNT(j)]); sum += c; cnt += (c > 0u) ? 1u : 0u; mine = (j == x) ? c : mine; }
        if (sum == G) break;
        __builtin_amdgcn_s_sleep(1);
        if ((++sp & 255u) == 0u) { if (xb_ld(&bar[XB_TMO])) break; if (sp > XB_SPIN_CAP) { atomicAdd(&bar[XB_TMO], 1u); break; } }
    }
    nloc = mine > 0u ? mine : 1u; nx = cnt > 0u ? cnt : 1u;
}
__device__ __forceinline__ void xcd_barrier(const XcdBarrier& b) {
    asm volatile("s_waitcnt vmcnt(0)" ::: "memory");
    __syncthreads();
    if (b.leader && lane_id() == 0) {
        unsigned* bar = b.bar;
        __builtin_amdgcn_s_waitcnt(0);
        unsigned nloc = b.st[0], nx = b.st[1];
        if (nloc == 0u) { xcd_barrier_complete(bar, b.x, nloc, nx); b.st[0] = nloc; b.st[1] = nx; }
        const unsigned old = xb_add(&bar[XB_XSUB(b.x)], 1u);
        const unsigned gen = old / nloc;
        if (old + 1u == (gen + 1u) * nloc) {
            __builtin_amdgcn_fence(__ATOMIC_RELEASE, "agent");
            asm volatile("s_waitcnt vmcnt(0)" ::: "memory");
            const unsigned og = xb_add(&bar[XB_TOP], 1u);
            const unsigned tg = og / nx;
            if (og + 1u == (tg + 1u) * nx) xb_add(&bar[XB_TOPGEN], 1u);
            else XB_SPIN(xb_ld(&bar[XB_TOPGEN]) == tg, bar);
            __builtin_amdgcn_fence(__ATOMIC_ACQUIRE, "agent");
            xb_add(&bar[XB_XGEN(b.x)], 1u);
            asm volatile("s_waitcnt vmcnt(0)" ::: "memory");
        } else {
            XB_SPIN(xb_ld(&bar[XB_XGEN(b.x)]) == gen, bar);
            __builtin_amdgcn_fence(__ATOMIC_ACQUIRE, "agent");
            asm volatile("s_waitcnt vmcnt(0)" ::: "memory");
        }
    }
    __syncthreads();
}

struct Args {
    const float* in[15]; float* out; unsigned char* ws;
    float inv_freq[16];
    int ph_lo, ph_hi, li, pad;
};
struct Frame {
    LAS unsigned char* lds; int wave, vcu, G;
};

__device__ __forceinline__ void p0_transpose_item(const float* W, int N, bf16_t* WT, int ldt, int row_off, LAS float* scr, int item, int lane) {
    const int nblk = N / 32, kb = item / nblk, nb = item % nblk, k0 = 64 * kb, n0 = 32 * nb;
#pragma unroll 8
    for (int i = 0; i < 32; ++i) { const int kk = 2 * i + (lane >> 5); scr[kk * 33 + (lane & 31)] = W[(size_t)(k0 + kk) * N + n0 + (lane & 31)]; }
    asm volatile("s_waitcnt lgkmcnt(0)" ::: "memory");
    const int c = lane & 7;
#pragma unroll
    for (int j = 0; j < 4; ++j) { const int n = (lane >> 3) + 8 * j; const LAS float* s = scr + (8 * c) * 33 + n;
        u32x4 o; o.x = pk2(s[0 * 33], s[1 * 33]); o.y = pk2(s[2 * 33], s[3 * 33]); o.z = pk2(s[4 * 33], s[5 * 33]); o.w = pk2(s[6 * 33], s[7 * 33]);
        *(u32x4*)(WT + (size_t)(row_off + n0 + n) * ldt + k0 + 8 * c) = o; }
    asm volatile("s_waitcnt lgkmcnt(0)" ::: "memory");
}
__device__ __forceinline__ void load_row(const float* p, int lane, f32x4 (&v)[8]) {
#pragma unroll
    for (int j = 0; j < 8; ++j) v[j] = *(const f32x4*)(p + 4 * (64 * j + lane));
}
__device__ __forceinline__ void load_row_bf16(const bf16_t* p, int lane, f32x4 (&v)[8]) {
#pragma unroll
    for (int j = 0; j < 8; ++j) { const u32x2 w = *(const u32x2*)(p + 4 * (64 * j + lane)); v[j] = (f32x4){bflo(w.x), bfhi(w.x), bflo(w.y), bfhi(w.y)}; }
}
__device__ __forceinline__ float row_ss(const f32x4 (&v)[8]) {
    float s = 0.f;
#pragma unroll
    for (int j = 0; j < 8; ++j) s += (v[j][0] * v[j][0] + v[j][1] * v[j][1]) + (v[j][2] * v[j][2] + v[j][3] * v[j][3]);
    return wave_sum(s);
}
__device__ __forceinline__ void row_ss2(const f32x4 (&a)[8], const f32x4 (&b)[8], float& sa, float& sb) {
    float s = 0.f, t = 0.f;
#pragma unroll
    for (int j = 0; j < 8; ++j) { s += (a[j][0] * a[j][0] + a[j][1] * a[j][1]) + (a[j][2] * a[j][2] + a[j][3] * a[j][3]); t += (b[j][0] * b[j][0] + b[j][1] * b[j][1]) + (b[j][2] * b[j][2] + b[j][3] * b[j][3]); }
#pragma unroll
    for (int o = 1; o < 64; o <<= 1) { s += __shfl_xor(s, o); t += __shfl_xor(t, o); }
    sa = s; sb = t;
}
__device__ __forceinline__ void store_row_bf16(bf16_t* p, int lane, const f32x4 (&v)[8]) {
#pragma unroll
    for (int j = 0; j < 8; ++j) { u32x2 w; w.x = pk2(v[j][0], v[j][1]); w.y = pk2(v[j][2], v[j][3]); *(u32x2*)(p + 4 * (64 * j + lane)) = w; }
}

__device__ __forceinline__ void rows16_phase(const Frame& F, const bf16_t* A16, int lda, const bf16_t* Bt, int ldb, int K, int ntasks, int a_grp_cols, int tasks_per_grp, const Epi& E) {
    int lane_o = lane_id();
    const int lane = lane_o, m = lane & 15, fq = lane >> 4;
    LAS float* red = (LAS float*)F.lds;
    const int stride = F.G / ntasks > 0 ? F.G / ntasks : 1;
    for (int task0 = F.vcu; task0 < ntasks * stride; task0 += F.G) {
        if (task0 % stride) continue;
        const int task = task0 / stride;
        const int n0 = task * 32, kslice = K / 8, kb = F.wave * kslice;
        const bf16_t* ap = A16 + (size_t)m * lda + (task / tasks_per_grp) * a_grp_cols + kb + 8 * fq;
        const bf16_t* bp0 = Bt + (size_t)(n0 + 8 * (m >> 2) + (m & 3)) * ldb + kb + 8 * fq;
        const bf16_t* bp1 = bp0 + (size_t)4 * ldb;
        f32x4 acc0 = {0.f, 0.f, 0.f, 0.f}, acc1 = {0.f, 0.f, 0.f, 0.f};
        for (int ks = 0; ks < kslice; ks += 32) {
            const bf16x8 a = *(const bf16x8*)(ap + ks), b0 = *(const bf16x8*)(bp0 + ks), b1 = *(const bf16x8*)(bp1 + ks);
            acc0 = __builtin_amdgcn_mfma_f32_16x16x32_bf16(b0, a, acc0, 0, 0, 0);
            acc1 = __builtin_amdgcn_mfma_f32_16x16x32_bf16(b1, a, acc1, 0, 0, 0);
        }
        *(LAS f32x4*)(red + (F.wave * 2 + 0) * 256 + lane * 4) = acc0;
        *(LAS f32x4*)(red + (F.wave * 2 + 1) * 256 + lane * 4) = acc1;
        __syncthreads();
        if (F.wave == 0) {
            f32x4 s0 = {0.f, 0.f, 0.f, 0.f}, s1 = {0.f, 0.f, 0.f, 0.f};
#pragma unroll
            for (int w = 0; w < 8; ++w) { s0 += *(const LAS f32x4*)(red + (w * 2 + 0) * 256 + lane * 4); s1 += *(const LAS f32x4*)(red + (w * 2 + 1) * 256 + lane * 4); }
            E.emit_rt(MREAL + m, n0 + 8 * fq, s0, s1);
        }
        __syncthreads();
    }
}

template <int W> __device__ __forceinline__ void mix_strip(const bf16_t* U, bf16_t* MIXo, int strip, int c0) {
    const int row0 = strip * 16, bb = row0 >> 12, p0 = NMETA + (row0 & (SEQ - 1));
    u32x4 buf[W - 1 + 16];
#pragma unroll
    for (int i = 0; i < W - 1 + 16; ++i) { const int pp = p0 - (W - 1) + i; const int r = pp >= NMETA ? bb * SEQ + pp - NMETA : MREAL + pp;
        buf[i] = *(const u32x4*)(U + (size_t)r * DM + c0); }
    float s[8] = {0.f, 0.f, 0.f, 0.f, 0.f, 0.f, 0.f, 0.f};
#define MIX_UNPK(v, f) const float f[8] = {bflo(v.x), bfhi(v.x), bflo(v.y), bfhi(v.y), bflo(v.z), bfhi(v.z), bflo(v.w), bfhi(v.w)}
#pragma unroll
    for (int i = 0; i < W - 1; ++i) { MIX_UNPK(buf[i], f);
#pragma unroll
        for (int k = 0; k < 8; ++k) s[k] += f[k]; }
    constexpr float iw = 1.0f / (float)W;
#pragma unroll
    for (int t = 0; t < 16; ++t) {
        MIX_UNPK(buf[W - 1 + t], f);
#pragma unroll
        for (int k = 0; k < 8; ++k) s[k] += f[k];
        u32x4 o; o.x = pk2(s[0] * iw - f[0], s[1] * iw - f[1]); o.y = pk2(s[2] * iw - f[2], s[3] * iw - f[3]);
        o.z = pk2(s[4] * iw - f[4], s[5] * iw - f[5]); o.w = pk2(s[6] * iw - f[6], s[7] * iw - f[7]);
        *(u32x4*)(MIXo + (size_t)(row0 + t) * DM + c0) = o;
        MIX_UNPK(buf[t], g);
#pragma unroll
        for (int k = 0; k < 8; ++k) s[k] -= g[k];
    }
#undef MIX_UNPK
}

namespace att {
__device__ __forceinline__ int crow(int r, int hi) { return (r & 3) + 8 * (r >> 2) + 4 * hi; }
__device__ __forceinline__ float xch32(float v) { return __shfl_xor(v, 32); }
#ifndef ATT_VPREFETCH
#define ATT_VPREFETCH 1
#endif
#ifndef ATT_PROBE
#define ATT_PROBE 0
#endif
#ifndef ATT_STATICPRIO
#define ATT_STATICPRIO 1
#endif
#ifndef ATT_VSETS
#define ATT_VSETS 1
#endif
#ifndef ATT_PIPE
#define ATT_PIPE 0
#endif
#ifndef ATT_STAGGER
#define ATT_STAGGER 1
#endif
#ifndef ATT_SETPRIO
#define ATT_SETPRIO 0
#endif
constexpr float THRL = 6.0f;
template <int OFF> __device__ __forceinline__ bf16x8 v_read1(int va) {
    bf16x8 r; asm volatile("ds_read_b128 %0, %1 offset:%2" : "=&v"(r) : "v"(va), "i"(OFF) : "memory"); return r;
}
template <int D0> __device__ __forceinline__ void pv_read(bf16x8 (&v)[4], const int (&voff)[4]) {
    v[0] = v_read1<D0 * 4096>(voff[0]); v[1] = v_read1<D0 * 4096>(voff[1]); v[2] = v_read1<D0 * 4096>(voff[2]); v[3] = v_read1<D0 * 4096>(voff[3]);
}
__device__ __forceinline__ void pv_mma(f32x16& od, const bf16x8 (&v)[4], const u32x4 (&pw)[4]) {
    if (ATT_SETPRIO) __builtin_amdgcn_s_setprio(1);
    od = __builtin_amdgcn_mfma_f32_32x32x16_bf16(v[0], __builtin_bit_cast(bf16x8, pw[0]), od, 0, 0, 0);
    od = __builtin_amdgcn_mfma_f32_32x32x16_bf16(v[1], __builtin_bit_cast(bf16x8, pw[1]), od, 0, 0, 0);
    od = __builtin_amdgcn_mfma_f32_32x32x16_bf16(v[2], __builtin_bit_cast(bf16x8, pw[2]), od, 0, 0, 0);
    od = __builtin_amdgcn_mfma_f32_32x32x16_bf16(v[3], __builtin_bit_cast(bf16x8, pw[3]), od, 0, 0, 0);
    if (ATT_SETPRIO) __builtin_amdgcn_s_setprio(0);
}
#define ATT_WL(n) do { __builtin_amdgcn_sched_barrier(0); asm volatile("s_waitcnt lgkmcnt(" #n ")" ::: "memory"); __builtin_amdgcn_sched_barrier(0); } while (0)
__device__ __forceinline__ void pv_all(f32x16 (&o)[8], int vb, const int (&vsw)[4], const u32x4 (&pw)[4]) {
    const int voff[4] = {vb + vsw[0], vb + vsw[1], vb + vsw[2], vb + vsw[3]};
    bf16x8 va[4], vc[4];
    pv_read<0>(va, voff); ATT_WL(0);
    pv_read<1>(vc, voff); pv_mma(o[0], va, pw); ATT_WL(0);
    pv_read<2>(va, voff); pv_mma(o[1], vc, pw); ATT_WL(0);
    pv_read<3>(vc, voff); pv_mma(o[2], va, pw); ATT_WL(0);
    pv_read<4>(va, voff); pv_mma(o[3], vc, pw); ATT_WL(0);
    pv_read<5>(vc, voff); pv_mma(o[4], va, pw); ATT_WL(0);
    pv_read<6>(va, voff); pv_mma(o[5], vc, pw); ATT_WL(0);
    pv_read<7>(vc, voff); pv_mma(o[6], va, pw); ATT_WL(0);
    pv_mma(o[7], vc, pw);
}
template <int OFF> __device__ __forceinline__ bf16x8 k_read1(int kb) {
    bf16x8 r; asm volatile("ds_read_b128 %0, %1 offset:%2" : "=&v"(r) : "v"(kb), "i"(OFF) : "memory"); return r;
}
template <int G> __device__ __forceinline__ void k_read(bf16x8 (&k)[4], int kb) {
    k[0] = k_read1<(2 * G) * 2048>(kb); k[1] = k_read1<(2 * G) * 2048 + 512>(kb); k[2] = k_read1<(2 * G + 1) * 2048>(kb); k[3] = k_read1<(2 * G + 1) * 2048 + 512>(kb);
}
template <int G> __device__ __forceinline__ void qk_mma(f32x16& p0, f32x16& p1, const bf16x8 (&k)[4], const bf16x8 (&qr)[8]) {
    p0 = __builtin_amdgcn_mfma_f32_32x32x16_bf16(k[0], qr[2 * G], p0, 0, 0, 0);
    p1 = __builtin_amdgcn_mfma_f32_32x32x16_bf16(k[1], qr[2 * G], p1, 0, 0, 0);
    p0 = __builtin_amdgcn_mfma_f32_32x32x16_bf16(k[2], qr[2 * G + 1], p0, 0, 0, 0);
    p1 = __builtin_amdgcn_mfma_f32_32x32x16_bf16(k[3], qr[2 * G + 1], p1, 0, 0, 0);
}
template <int D, bool DO_PV, bool DO_SM>
__device__ __forceinline__ void pvsm_block(f32x16& od, const bf16x8 (&v)[4], const u32x4 (&pw)[4], f32x16& p0, f32x16& p1, float m_run, float& ps, u32x4 (&pn)[4]) {
#pragma unroll
    for (int k = 0; k < 4; ++k) {
        if (DO_PV) od = __builtin_amdgcn_mfma_f32_32x32x16_bf16(v[k], __builtin_bit_cast(bf16x8, pw[k]), od, 0, 0, 0);
        if (DO_SM) {
            constexpr int e0 = 4 * D; const int e = e0 + k;
            float ex;
            if (e < 16) { ex = __builtin_amdgcn_exp2f(p0[e] - m_run); p0[e] = ex; } else { ex = __builtin_amdgcn_exp2f(p1[e - 16] - m_run); p1[e - 16] = ex; }
            ps += ex;
            if (k & 1) { const int w = e >> 1;
                const float lo = (e - 1 < 16) ? p0[(e - 1) & 15] : p1[(e - 1) & 15];
                pn[w >> 2][w & 3] = pk2(lo, ex); }
        }
        __builtin_amdgcn_sched_barrier(0);
    }
}
template <bool DO_PV, bool DO_SM>
__device__ __forceinline__ void pv_sm(f32x16 (&o)[8], const int (&voff)[4], const u32x4 (&pw)[4], f32x16& p0, f32x16& p1, float m_run, float& ps, u32x4 (&pn)[4]) {
#if ATT_VSETS == 2
    bf16x8 va[4], vc[4];
    if (DO_PV) { pv_read<0>(va, voff); ATT_WL(0); }
    if (DO_PV) pv_read<1>(vc, voff); pvsm_block<0, DO_PV, DO_SM>(o[0], va, pw, p0, p1, m_run, ps, pn); if (DO_PV) ATT_WL(0);
    if (DO_PV) pv_read<2>(va, voff); pvsm_block<1, DO_PV, DO_SM>(o[1], vc, pw, p0, p1, m_run, ps, pn); if (DO_PV) ATT_WL(0);
    if (DO_PV) pv_read<3>(vc, voff); pvsm_block<2, DO_PV, DO_SM>(o[2], va, pw, p0, p1, m_run, ps, pn); if (DO_PV) ATT_WL(0);
    if (DO_PV) pv_read<4>(va, voff); pvsm_block<3, DO_PV, DO_SM>(o[3], vc, pw, p0, p1, m_run, ps, pn); if (DO_PV) ATT_WL(0);
    if (DO_PV) pv_read<5>(vc, voff); pvsm_block<4, DO_PV, DO_SM>(o[4], va, pw, p0, p1, m_run, ps, pn); if (DO_PV) ATT_WL(0);
    if (DO_PV) pv_read<6>(va, voff); pvsm_block<5, DO_PV, DO_SM>(o[5], vc, pw, p0, p1, m_run, ps, pn); if (DO_PV) ATT_WL(0);
    if (DO_PV) pv_read<7>(vc, voff); pvsm_block<6, DO_PV, DO_SM>(o[6], va, pw, p0, p1, m_run, ps, pn); if (DO_PV) ATT_WL(0);
    pvsm_block<7, DO_PV, DO_SM>(o[7], vc, pw, p0, p1, m_run, ps, pn);
#else
    bf16x8 va[4];
    if (DO_PV) { pv_read<0>(va, voff); ATT_WL(0); } pvsm_block<0, DO_PV, DO_SM>(o[0], va, pw, p0, p1, m_run, ps, pn);
    if (DO_PV) { pv_read<1>(va, voff); ATT_WL(0); } pvsm_block<1, DO_PV, DO_SM>(o[1], va, pw, p0, p1, m_run, ps, pn);
    if (DO_PV) { pv_read<2>(va, voff); ATT_WL(0); } pvsm_block<2, DO_PV, DO_SM>(o[2], va, pw, p0, p1, m_run, ps, pn);
    if (DO_PV) { pv_read<3>(va, voff); ATT_WL(0); } pvsm_block<3, DO_PV, DO_SM>(o[3], va, pw, p0, p1, m_run, ps, pn);
    if (DO_PV) { pv_read<4>(va, voff); ATT_WL(0); } pvsm_block<4, DO_PV, DO_SM>(o[4], va, pw, p0, p1, m_run, ps, pn);
    if (DO_PV) { pv_read<5>(va, voff); ATT_WL(0); } pvsm_block<5, DO_PV, DO_SM>(o[5], va, pw, p0, p1, m_run, ps, pn);
    if (DO_PV) { pv_read<6>(va, voff); ATT_WL(0); } pvsm_block<6, DO_PV, DO_SM>(o[6], va, pw, p0, p1, m_run, ps, pn);
    if (DO_PV) { pv_read<7>(va, voff); ATT_WL(0); } pvsm_block<7, DO_PV, DO_SM>(o[7], va, pw, p0, p1, m_run, ps, pn);
#endif
}
__device__ __forceinline__ float qk_max(f32x16& p0, f32x16& p1, const LAS unsigned char* Kst, const bf16x8 (&qr)[8], bool meta_tile) {
    p0 = (f32x16){0.f, 0.f, 0.f, 0.f, 0.f, 0.f, 0.f, 0.f, 0.f, 0.f, 0.f, 0.f, 0.f, 0.f, 0.f, 0.f}; p1 = p0;
    {   const int kb = (int)(unsigned)(uintptr_t)Kst;
        bf16x8 ka[4], kc[4];
        k_read<0>(ka, kb); ATT_WL(0);
        k_read<1>(kc, kb); qk_mma<0>(p0, p1, ka, qr); ATT_WL(0);
        k_read<2>(ka, kb); qk_mma<1>(p0, p1, kc, qr); ATT_WL(0);
        k_read<3>(kc, kb); qk_mma<2>(p0, p1, ka, qr); ATT_WL(0);
        qk_mma<3>(p0, p1, kc, qr);
    }
    if (meta_tile) {
#pragma unroll
        for (int r = 8; r < 16; ++r) p0[r] = -INFINITY;
#pragma unroll
        for (int r = 0; r < 16; ++r) p1[r] = -INFINITY;
    }
    float rm = fmaxf(fmaxf(p0[0], p0[1]), p0[2]);
#pragma unroll
    for (int r = 3; r < 15; r += 2) rm = fmaxf(fmaxf(rm, p0[r]), p0[r + 1]);
    rm = fmaxf(rm, p0[15]);
#pragma unroll
    for (int r = 0; r < 16; r += 2) rm = fmaxf(fmaxf(rm, p1[r]), p1[r + 1]);
    return fmaxf(rm, xch32(rm));
}
__device__ __forceinline__ void qk_sm(f32x16 (&o)[8], float& m_run, float& l_run, u32x4 (&pw)[4], const LAS unsigned char* Kst, const bf16x8 (&qr)[8], bool meta_tile) {
    f32x16 p0 = (f32x16){0.f, 0.f, 0.f, 0.f, 0.f, 0.f, 0.f, 0.f, 0.f, 0.f, 0.f, 0.f, 0.f, 0.f, 0.f, 0.f}, p1 = p0;
    {
        const int kb = (int)(unsigned)(uintptr_t)Kst;
        bf16x8 ka[4], kc[4];
        k_read<0>(ka, kb); ATT_WL(0);
        k_read<1>(kc, kb); qk_mma<0>(p0, p1, ka, qr); ATT_WL(0);
        k_read<2>(ka, kb); qk_mma<1>(p0, p1, kc, qr); ATT_WL(0);
        k_read<3>(kc, kb); qk_mma<2>(p0, p1, ka, qr); ATT_WL(0);
        qk_mma<3>(p0, p1, kc, qr);
    }
    if (ATT_PROBE == 2) {
        asm volatile("" : "+v"(p0), "+v"(p1));
        p0 = (f32x16){0.f, 0.f, 0.f, 0.f, 0.f, 0.f, 0.f, 0.f, 0.f, 0.f, 0.f, 0.f, 0.f, 0.f, 0.f, 0.f}; p1 = p0;
#pragma unroll
        for (int d0 = 0; d0 < 8; ++d0) {
            const bf16x8 a0 = *(const LAS bf16x8*)(Kst + d0 * 2048), a1 = *(const LAS bf16x8*)(Kst + d0 * 2048 + 512);
            p0 = __builtin_amdgcn_mfma_f32_32x32x16_bf16(a0, qr[d0], p0, 0, 0, 0);
            p1 = __builtin_amdgcn_mfma_f32_32x32x16_bf16(a1, qr[d0], p1, 0, 0, 0);
        }
    }
    if (meta_tile) {
#pragma unroll
        for (int r = 8; r < 16; ++r) p0[r] = -INFINITY;
#pragma unroll
        for (int r = 0; r < 16; ++r) p1[r] = -INFINITY;
    }
    float rm = fmaxf(fmaxf(p0[0], p0[1]), p0[2]);
#pragma unroll
    for (int r = 3; r < 15; r += 2) rm = fmaxf(fmaxf(rm, p0[r]), p0[r + 1]);
    rm = fmaxf(rm, p0[15]);
#pragma unroll
    for (int r = 0; r < 16; r += 2) rm = fmaxf(fmaxf(rm, p1[r]), p1[r + 1]);
    rm = fmaxf(rm, xch32(rm));
    if (__any(rm > m_run + THRL)) {
        const float mn = fmaxf(m_run, rm), alpha = __builtin_amdgcn_exp2f(m_run - mn);
        m_run = mn; l_run *= alpha;
#pragma unroll
        for (int d = 0; d < 8; ++d)
#pragma unroll
            for (int r = 0; r < 16; ++r) o[d][r] *= alpha;
    }
    float ps = 0.f;
#pragma unroll
    for (int r = 0; r < 16; ++r) { float xx = p0[r] - m_run; p0[r] = __builtin_amdgcn_exp2f(xx); if (ATT_PROBE == 3) { asm volatile("" : "+v"(xx)); p0[r] = (p0[r] + __builtin_amdgcn_exp2f(xx)) * 0.5f; } ps += p0[r]; }
#pragma unroll
    for (int r = 0; r < 16; ++r) { float xx = p1[r] - m_run; p1[r] = __builtin_amdgcn_exp2f(xx); if (ATT_PROBE == 3) { asm volatile("" : "+v"(xx)); p1[r] = (p1[r] + __builtin_amdgcn_exp2f(xx)) * 0.5f; } ps += p1[r]; }
    l_run += ps;
    pw[0] = (u32x4){pk2(p0[0], p0[1]), pk2(p0[2], p0[3]), pk2(p0[4], p0[5]), pk2(p0[6], p0[7])};
    pw[1] = (u32x4){pk2(p0[8], p0[9]), pk2(p0[10], p0[11]), pk2(p0[12], p0[13]), pk2(p0[14], p0[15])};
    pw[2] = (u32x4){pk2(p1[0], p1[1]), pk2(p1[2], p1[3]), pk2(p1[4], p1[5]), pk2(p1[6], p1[7])};
    pw[3] = (u32x4){pk2(p1[8], p1[9]), pk2(p1[10], p1[11]), pk2(p1[12], p1[13]), pk2(p1[14], p1[15])};
}
__device__ __forceinline__ void attn_unit(const Frame& F, const bf16_t* Q, const unsigned char* Kimg, const unsigned char* Vimg, const bf16_t* Gt, bf16_t* O,
                                          const float* subln_g, int b, int h, int qb, int desc) {
    LAS unsigned char* lds = F.lds;
    int lane_o = lane_id();
    const int lane = lane_o, r32 = lane & 31, hi = lane >> 5, wid = F.wave, mp = wid >> 2, rg = wid & 3;
    const bool meta = qb < 0;
    const size_t qrow = meta ? (size_t)(MREAL + (r32 & 15)) : (size_t)b * SEQ + qb * 128 + rg * 32 + r32;
    const int NT = meta ? 1 : 2 * qb + 3;
    const int tmax = meta ? 0 : 2 * qb + 1 + (rg >> 1);
    bf16x8 qr[8];
    { const bf16_t* qp = Q + qrow * DM + h * 256 + mp * 128 + hi * 8;
#pragma unroll
      for (int d0 = 0; d0 < 8; ++d0) qr[d0] = *(const bf16x8*)(qp + 16 * d0); }
    const int bsel = meta ? 0 : b;
    const unsigned char* srcK = Kimg + ((size_t)((bsel * NH + h) * 2 + mp) * NTILE) * KTILE_B + rg * 4096;
    const unsigned char* srcV = Vimg + ((size_t)(bsel * NH + h) * NTILE) * VTILE_B + wid * 4096;
    const unsigned laneoff = (unsigned)lane * 16u;
#define ATT_TILE(k) (desc ? NT - 1 - (k) : (k))
#define ATT_DMA_K(k) do { const int _tl = ATT_TILE(k); _Pragma("unroll") for (int _i = 0; _i < (ATT_PROBE == 1 ? 8 : 4); ++_i) \
        __builtin_amdgcn_global_load_lds((const unsigned*)(srcK + (size_t)_tl * KTILE_B + (_i & 3) * 1024 + laneoff), (LAS unsigned*)(lds + ((k) & 1) * 32768 + wid * 4096 + (_i & 3) * 1024), 16, 0, 0); } while (0)
#define ATT_DMA_V(k) do { const int _tl = ATT_TILE(k); _Pragma("unroll") for (int _i = 0; _i < (ATT_PROBE == 1 ? 8 : 4); ++_i) \
        __builtin_amdgcn_global_load_lds((const unsigned*)(srcV + (size_t)_tl * VTILE_B + (_i & 3) * 1024 + laneoff), (LAS unsigned*)(lds + 65536 + ((k) & 1) * 32768 + wid * 4096 + (_i & 3) * 1024), 16, 0, 0); } while (0)
#define ATT_WAITBAR(n) do { if (ATT_PROBE == 1 && n == 4) asm volatile("s_waitcnt vmcnt(8)" ::: "memory"); else asm volatile("s_waitcnt vmcnt(" #n ")" ::: "memory"); __builtin_amdgcn_s_barrier(); asm volatile("" ::: "memory"); } while (0)
    f32x16 o[8];
#pragma unroll
    for (int d = 0; d < 8; ++d) o[d] = (f32x16){0.f, 0.f, 0.f, 0.f, 0.f, 0.f, 0.f, 0.f, 0.f, 0.f, 0.f, 0.f, 0.f, 0.f, 0.f, 0.f};
    float m_run = -1e30f, l_run = 0.f;
    u32x4 pw[4] = {{0u, 0u, 0u, 0u}, {0u, 0u, 0u, 0u}, {0u, 0u, 0u, 0u}, {0u, 0u, 0u, 0u}};
    int vsw[4];
#pragma unroll
    for (int sx = 0; sx < 4; ++sx) vsw[sx] = r32 * 128 + (((2 * sx + hi) ^ ((r32 >> 1) & 7)) * 16);
    const int kbase = mp * KTILE_B + hi * 1024 + r32 * 16;
#if ATT_PIPE
    f32x16 p0, p1; u32x4 pn[4];
    int voff[4];
#pragma unroll
    for (int sx = 0; sx < 4; ++sx) voff[sx] = (int)(unsigned)(uintptr_t)(lds + 65536 + 32768) + vsw[sx];
    ATT_DMA_K(0);
    {
        ATT_WAITBAR(0);
        if (1 < NT) ATT_DMA_K(1);
        ATT_DMA_V(0);
        float ps = 0.f;
        m_run = qk_max(p0, p1, lds + kbase, qr, true);
        pv_sm<false, true>(o, voff, pw, p0, p1, m_run, ps, pn);
        l_run = ps;
#pragma unroll
        for (int i = 0; i < 4; ++i) pw[i] = pn[i];
    }
    for (int t = 1; t < NT; ++t) {
        ATT_WAITBAR(0);
        if (t + 1 < NT) ATT_DMA_K(t + 1);
        ATT_DMA_V(t);
#pragma unroll
        for (int sx = 0; sx < 4; ++sx) voff[sx] ^= 32768;
        if (t <= tmax) {
            float ps = 0.f;
            const float rm = qk_max(p0, p1, lds + (t & 1) * 32768 + kbase, qr, false);
            if (__any(rm > m_run + THRL)) {
                const float mn = fmaxf(m_run, rm), alpha = __builtin_amdgcn_exp2f(m_run - mn);
                m_run = mn; l_run *= alpha;
#pragma unroll
                for (int d = 0; d < 8; ++d)
#pragma unroll
                    for (int r = 0; r < 16; ++r) o[d][r] *= alpha;
#pragma unroll
                for (int i = 0; i < 4; ++i)
#pragma unroll
                    for (int j = 0; j < 4; ++j) pw[i][j] = pk2(bflo(pw[i][j]) * alpha, bfhi(pw[i][j]) * alpha);
            }
            pv_sm<true, true>(o, voff, pw, p0, p1, m_run, ps, pn);
            l_run += ps;
#pragma unroll
            for (int i = 0; i < 4; ++i) pw[i] = pn[i];
        }
    }
    {
        ATT_WAITBAR(0);
        if (tmax == NT - 1) {
#pragma unroll
            for (int sx = 0; sx < 4; ++sx) voff[sx] ^= 32768;
        }
        float ps = 0.f;
        pv_sm<true, false>(o, voff, pw, p0, p1, m_run, ps, pn);
    }
#else
    ATT_DMA_K(0); ATT_DMA_V(0);
#define ATT_VADDR(tt) ((int)(unsigned)(uintptr_t)(lds + 65536 + ((tt) & 1) * 32768))
    if (mp == 0 || !ATT_STAGGER) {
        for (int t = 0; t < NT; ++t) {
            const int tl = ATT_TILE(t);
            ATT_WAITBAR(4);
            if (t + 1 < NT) ATT_DMA_K(t + 1);
            if (tl <= tmax) qk_sm(o, m_run, l_run, pw, lds + (t & 1) * 32768 + kbase, qr, tl == 0);
            if (t + 1 < NT) { ATT_WAITBAR(4); ATT_DMA_V(t + 1); } else ATT_WAITBAR(0);
            if (tl <= tmax) pv_all(o, ATT_VADDR(t), vsw, pw);
        }
        ATT_WAITBAR(0);
    } else {
        for (int t = 0; t < NT; ++t) {
            const int tl = ATT_TILE(t);
            ATT_WAITBAR(4);
            if (t >= 1 && ATT_TILE(t - 1) <= tmax) pv_all(o, ATT_VADDR(t - 1), vsw, pw);
            if (t + 1 < NT) ATT_DMA_K(t + 1);
            if (t + 1 < NT) ATT_WAITBAR(4); else ATT_WAITBAR(0);
            if (tl <= tmax) qk_sm(o, m_run, l_run, pw, lds + (t & 1) * 32768 + kbase, qr, tl == 0);
            if (t + 1 < NT) ATT_DMA_V(t + 1);
        }
        ATT_WAITBAR(0);
        if (ATT_TILE(NT - 1) <= tmax) pv_all(o, ATT_VADDR(NT - 1), vsw, pw);
    }
#undef ATT_VADDR
#endif
    asm volatile("s_waitcnt vmcnt(0) lgkmcnt(0)" ::: "memory"); __builtin_amdgcn_s_barrier(); asm volatile("" ::: "memory");
    const float ltot = l_run + xch32(l_run);
    const float inv = __builtin_amdgcn_rcpf(ltot);
    LAS float* xb = (LAS float*)lds + (size_t)rg * 8192;
    if (mp == 1) {
        const float sc = *(const LAS float*)(lds + MISC_OFF + 64) * inv;
#pragma unroll
        for (int d = 0; d < 8; ++d) {
#pragma unroll
            for (int r = 0; r < 16; ++r) xb[(d * 16 + r) * 64 + lane] = o[d][r] * sc;
            asm volatile("" ::: "memory"); }
    }
    asm volatile("s_waitcnt lgkmcnt(0)" ::: "memory"); __builtin_amdgcn_s_barrier(); asm volatile("" ::: "memory");
    if (mp == 0) {
        float ss = 0.f;
#pragma unroll
        for (int d = 0; d < 8; ++d) {
#pragma unroll
            for (int r = 0; r < 16; ++r) { const float v = o[d][r] * inv - xb[(d * 16 + r) * 64 + lane]; o[d][r] = v; ss = fmaf(v, v, ss); }
            asm volatile("" : "+v"(ss) :: "memory"); }
        ss += xch32(ss);
        const float rstd = __builtin_amdgcn_rsqf(ss * (1.0f / 256.0f) + RMS_EPS) * 0.8f;
        const bool valid = !meta || r32 < 16;
        const size_t qrow2 = meta ? (size_t)(MREAL + (r32 & 15)) : (size_t)b * SEQ + qb * 128 + rg * 32 + r32;
        const bf16_t* gp = Gt + qrow2 * DM + h * 256; bf16_t* op = O + qrow2 * DM + h * 256;
#pragma unroll
        for (int d = 0; d < 8; ++d)
#pragma unroll
            for (int rq = 0; rq < 4; ++rq) {
                const int dd = 32 * d + 8 * rq + 4 * hi;
                const u32x2 g = *(const u32x2*)(gp + dd); const f32x4 sg = *(const f32x4*)(subln_g + dd);
                const float v0 = o[d][4 * rq + 0] * rstd * sg[0] * bflo(g.x), v1 = o[d][4 * rq + 1] * rstd * sg[1] * bfhi(g.x);
                const float v2 = o[d][4 * rq + 2] * rstd * sg[2] * bflo(g.y), v3 = o[d][4 * rq + 3] * rstd * sg[3] * bfhi(g.y);
                u32x2 w; w.x = pk2(v0, v1); w.y = pk2(v2, v3);
                if (valid) *(u32x2*)(op + dd) = w;
                asm volatile("" ::: "memory");
            }
    }
    asm volatile("s_waitcnt vmcnt(0) lgkmcnt(0)" ::: "memory"); __builtin_amdgcn_s_barrier(); asm volatile("" ::: "memory");
#undef ATT_TILE
#undef ATT_DMA_K
#undef ATT_DMA_V
#undef ATT_WAITBAR
}
#undef ATT_WL
}

__global__ void __launch_bounds__(512, 2) trunk_fwd(Args args) {
    extern __shared__ __attribute__((aligned(16))) unsigned char lds_raw[];
    Frame F;
    F.lds = (LAS unsigned char*)lds_raw;
    F.wave = __builtin_amdgcn_readfirstlane((int)threadIdx.x >> 6);
    F.G = gridDim.x; { const int bx = blockIdx.x; F.vcu = (F.G % 8 == 0) ? (bx % 8) * (F.G / 8) + bx / 8 : bx; }
    volatile LAS unsigned* MISC = (volatile LAS unsigned*)(F.lds + MISC_OFF);
    unsigned char* ws = args.ws;
    gu32* ctl = (gu32*)(ws + WS_CTL);
    for (int u = F.wave * 64 + lane_id(); u < (LDS_BYTES - LDSCTL_OFF) / 4; u += 512) ((LAS unsigned*)(F.lds + LDSCTL_OFF))[u] = 0u;
    __syncthreads();
    XcdBarrier bar; bar.bar = (unsigned*)(ctl + CW_BAR); bar.x = 0; bar.st = nullptr; bar.leader = false;
    if (MK_N_LAUNCHES == 1) bar = xcd_barrier_post((unsigned*)(ctl + CW_BAR), MISC + 8, F.wave == 0);
#define GRID_BAR() do { if (MK_N_LAUNCHES == 1) xcd_barrier(bar); } while (0)
    const int lo = args.ph_lo, hi = args.ph_hi;
#define IN(k) (lo <= (k) && (k) < hi)
#define REPS(k) for (int rep_ = 0; rep_ < ((k) == PROBE_PH ? 1 + PROBE_REP : 1); ++rep_)

    const float* x = args.in[0]; const float* meta_tok = args.in[1]; const float* pre_g = args.in[2]; const float* post_g = args.in[3];
    const float* attn_w_in = args.in[4]; const float* attn_w_out = args.in[5];
    const float* lq1 = args.in[6]; const float* lk1 = args.in[7]; const float* lq2 = args.in[8]; const float* lk2 = args.in[9];
    const float* subln_g = args.in[10];
    const float* pool_w_in = args.in[11]; const float* pool_w_group = args.in[12]; const float* pool_scale = args.in[13]; const float* pool_w_out = args.in[14];
    bf16_t* W1 = (bf16_t*)(ws + WS_W1); bf16_t* W2 = (bf16_t*)(ws + WS_W2); bf16_t* W3 = (bf16_t*)(ws + WS_W3); bf16_t* W4 = (bf16_t*)(ws + WS_W4); bf16_t* W5 = (bf16_t*)(ws + WS_W5);
    bf16_t* XN = (bf16_t*)(ws + WS_XN); bf16_t* GB = (bf16_t*)(ws + WS_G); bf16_t* QO = (bf16_t*)(ws + WS_QO);
    unsigned char* Kimg = ws + WS_K; unsigned char* Vimg = ws + WS_V;
    bf16_t* Y0 = (bf16_t*)(ws + WS_Y0); bf16_t* Y1 = (bf16_t*)(ws + WS_Y1);
    bf16_t* UB = (bf16_t*)(ws + WS_U); bf16_t* G1 = (bf16_t*)(ws + WS_G1); bf16_t* MIX = (bf16_t*)(ws + WS_MIX); bf16_t* GATED1 = (bf16_t*)(ws + WS_GATED1);
    float* ropec = (float*)(ws + WS_ROPEC); float* ropes = (float*)(ws + WS_ROPES); float* rstd0 = (float*)(ws + WS_RSTD0);
    const int gw = F.vcu * 8 + F.wave, NGW = F.G * 8;
    const int NGT = F.G * 512;
#define gtid (F.vcu * 512 + F.wave * 64 + lane_id())

    Epi E; E.mode = 0; E.Q = QO; E.Kimg = Kimg; E.Vimg = Vimg; E.G = GB; E.ropec = ropec; E.ropes = ropes; E.Y = Y0; E.U = UB; E.G1 = G1; E.GATED1 = GATED1; E.pool_scale = pool_scale;

    if (IN(0)) REPS(0) {
        LAS float* scr = (LAS float*)(F.lds + F.wave * 16384);
        constexpr int I1 = (DM / 64) * (4 * DM / 32), I2 = (DM / 64) * (DM / 32), I3 = (DM / 64) * (2 * DM / 32), I4 = (512 / 64) * (512 / 32), I5 = I2;
        constexpr int NITEMS = I1 + I2 + I3 + 4 * I4 + I5;
        for (int it = gw; it < NITEMS; it += NGW) {
            int r = it;
            if (r < I1) { p0_transpose_item(attn_w_in, 4 * DM, W1, DM, 0, scr, r, lane_id()); continue; } r -= I1;
            if (r < I2) { p0_transpose_item(attn_w_out, DM, W2, DM, 0, scr, r, lane_id()); continue; } r -= I2;
            if (r < I3) { p0_transpose_item(pool_w_in, 2 * DM, W3, DM, 0, scr, r, lane_id()); continue; } r -= I3;
            if (r < 4 * I4) { const int g = r / I4; p0_transpose_item(pool_w_group + (size_t)g * 512 * 512, 512, W4, 512, g * 512, scr, r % I4, lane_id()); continue; } r -= 4 * I4;
            p0_transpose_item(pool_w_out, DM, W5, DM, 0, scr, r, lane_id());
        }
        for (int i = gtid; i < LTOT * 16; i += NGT) {
            const int pos = i >> 4, k = i & 15; const float ang = (float)pos * args.inv_freq[k];
            double rev = (double)ang * 0.15915494309189535; rev -= floor(rev);
            const float fr = (float)rev; ropec[i] = __builtin_amdgcn_cosf(fr); ropes[i] = __builtin_amdgcn_sinf(fr);
        }
        for (int m = gw; m < MROWS; m += NGW) {
            const float* src = m < MREAL ? x + (size_t)m * DM : meta_tok + (size_t)(m - MREAL) * DM;
            f32x4 v[8]; load_row(src, lane_id(), v);
            const float rstd = __builtin_amdgcn_rsqf(row_ss(v) * (1.0f / DM) + RMS_EPS);
#pragma unroll
            for (int j = 0; j < 8; ++j) v[j] = v[j] * rstd * *(const f32x4*)(pre_g + 4 * (64 * j + lane_id()));
            store_row_bf16(XN + (size_t)m * DM, lane_id(), v);
        }
        const u32x4 z = {0u, 0u, 0u, 0u};
        for (int i = gtid; i < NB * NH * 2 * 1024; i += NGT) *(u32x4*)(Kimg + (size_t)(i >> 10) * NTILE * KTILE_B + (i & 1023) * 16) = z;
        for (int i = gtid; i < NB * NH * 2048; i += NGT) *(u32x4*)(Vimg + (size_t)(i >> 11) * NTILE * VTILE_B + (i & 2047) * 16) = z;
        GRID_BAR();
    }
    if (IN(1)) REPS(1) {
        E.mode = 1;
        rows16_phase(F, XN + (size_t)MREAL * DM, DM, W1, DM, DM, 4 * DM / 32, 0, 1 << 30, E);
        { pg8::Gemm g{XN, W1, MREAL, 3 * DM, DM, DM, DM, 1 << 30, 0}; pg8::StaticOrder S; S.init(MREAL, 3 * DM, F.G, (int)blockIdx.x); S.skip_from = 16; S.skip_n = 8;
          pg8::gemm_phase<true>(F.lds, g, S, E, F.wave); }
        { E.mode = 6;
          pg8::Gemm g{W1 + (size_t)2 * DM * DM, XN, DM, MREAL, DM, DM, DM, 1 << 30, 0}; pg8::StaticOrder S; S.init(DM, MREAL, F.G, (int)blockIdx.x);
          pg8::gemm_phase<true>(F.lds, g, S, E, F.wave); }
        GRID_BAR();
    }
    if (IN(2)) REPS(2) {
        float d1 = 0.f, d2 = 0.f;
#pragma unroll
        for (int j = 0; j < 2; ++j) { d1 += lq1[lane_id() + 64 * j] * lk1[lane_id() + 64 * j]; d2 += lq2[lane_id() + 64 * j] * lk2[lane_id() + 64 * j]; }
        const float lam = expf(wave_sum(d1)) - expf(wave_sum(d2)) + 0.2f;
        if (F.wave == 0 && lane_id() == 0) *(LAS float*)(F.lds + MISC_OFF + 64) = lam;
        __syncthreads();
        if (ATT_STATICPRIO && F.wave >= 4) __builtin_amdgcn_s_setprio(1);
        const bool g256 = false && F.G == 256; const int xg = F.vcu >> 5, li = F.vcu & 31;
        for (int r = 0; g256 ? r < 3 : F.vcu + r * F.G < 520; ++r) {
            int bh, qb, desc;
            if (g256) { if (r == 2 && li != 0) break; bh = r == 2 ? xg : 2 * xg + r; qb = r == 0 ? li : (r == 1 ? 31 - li : -1); desc = r == 1; }
            else { const int u = F.vcu + r * F.G; desc = 0; if (u < 256) { bh = u >> 4; qb = u & 15; } else if (u < 512) { bh = (u - 256) >> 4; qb = 31 - ((u - 256) & 15); } else { bh = u - 512; qb = -1; } }
            att::attn_unit(F, QO, Kimg, Vimg, GB, XN, subln_g, bh >> 3, bh & 7, qb, desc);
        }
        if (ATT_STATICPRIO) __builtin_amdgcn_s_setprio(0);
        GRID_BAR();
    }
    if (IN(3)) REPS(3) {
        E.mode = 2; E.Y = Y0;
        rows16_phase(F, XN + (size_t)MREAL * DM, DM, W2, DM, DM, DM / 32, 0, 1 << 30, E);
        pg8::Gemm g{XN, W2, MREAL, DM, DM, DM, DM, 1 << 30, 0}; pg8::StaticOrder S; S.init(MREAL, DM, F.G, (int)blockIdx.x);
        pg8::gemm_phase<true>(F.lds, g, S, E, F.wave);
        GRID_BAR();
    }
    if (IN(4)) REPS(4) {
        for (int m = gw; m < MROWS; m += 2 * NGW) {
            const int mb = (m + NGW < MROWS) ? m + NGW : m;
            f32x4 ya[8], ha[8], yb[8], hb[8];
            load_row_bf16(Y0 + (size_t)m * DM, lane_id(), ya); load_row_bf16(Y0 + (size_t)mb * DM, lane_id(), yb);
            load_row(m < MREAL ? x + (size_t)m * DM : meta_tok + (size_t)(m - MREAL) * DM, lane_id(), ha);
            load_row(mb < MREAL ? x + (size_t)mb * DM : meta_tok + (size_t)(mb - MREAL) * DM, lane_id(), hb);
            float sa, sb; row_ss2(ya, yb, sa, sb);
            const float ra0 = __builtin_amdgcn_rsqf(sa * (1.0f / DM) + RMS_EPS), rb0 = __builtin_amdgcn_rsqf(sb * (1.0f / DM) + RMS_EPS);
            if (lane_id() == 0) { rstd0[m] = ra0; rstd0[mb] = rb0; }
#pragma unroll
            for (int j = 0; j < 8; ++j) { const f32x4 gp = *(const f32x4*)(post_g + 4 * (64 * j + lane_id())); ha[j] = ha[j] + ya[j] * ra0 * gp; hb[j] = hb[j] + yb[j] * rb0 * gp; }
            row_ss2(ha, hb, sa, sb);
            const float ra1 = __builtin_amdgcn_rsqf(sa * (1.0f / DM) + RMS_EPS), rb1 = __builtin_amdgcn_rsqf(sb * (1.0f / DM) + RMS_EPS);
#pragma unroll
            for (int j = 0; j < 8; ++j) { const f32x4 gq = *(const f32x4*)(pre_g + DM + 4 * (64 * j + lane_id())); ha[j] = ha[j] * ra1 * gq; hb[j] = hb[j] * rb1 * gq; }
            store_row_bf16(XN + (size_t)m * DM, lane_id(), ha);
            if (mb != m) store_row_bf16(XN + (size_t)mb * DM, lane_id(), hb);
        }
        GRID_BAR();
    }
    if (IN(5)) REPS(5) {
        E.mode = 3;
        rows16_phase(F, XN + (size_t)MREAL * DM, DM, W3, DM, DM, DM / 32, 0, 1 << 30, E);
        pg8::Gemm g{XN, W3, MREAL, 2 * DM, DM, DM, DM, 1 << 30, 0}; pg8::StaticOrder S; S.init(MREAL, 2 * DM, F.G, (int)blockIdx.x);
        pg8::gemm_phase<true>(F.lds, g, S, E, F.wave);
        GRID_BAR();
    }
    if (IN(6)) REPS(6) {
        for (int idx = gtid; idx < (MREAL / 16) * 256; idx += NGT) {
            const int strip = idx >> 8, c0 = (idx & 255) * 8, gi = c0 >> 9;
            if (gi == 0) mix_strip<2>(UB, MIX, strip, c0); else if (gi == 1) mix_strip<4>(UB, MIX, strip, c0);
            else if (gi == 2) mix_strip<8>(UB, MIX, strip, c0); else mix_strip<16>(UB, MIX, strip, c0);
        }
        GRID_BAR();
    }
    if (IN(7)) REPS(7) {
        E.mode = 4;
        pg8::Gemm g{MIX, W4, MREAL, DM, 512, DM, 512, 2, 512}; pg8::StaticOrder S; S.init(MREAL, DM, F.G, (int)blockIdx.x);
        pg8::gemm_phase<true>(F.lds, g, S, E, F.wave);
        GRID_BAR();
    }
    if (IN(8)) REPS(8) {
        E.mode = 5; E.Y = Y1;
        pg8::Gemm g{GATED1, W5, MREAL, DM, DM, DM, DM, 1 << 30, 0}; pg8::StaticOrder S; S.init(MREAL, DM, F.G, (int)blockIdx.x);
        pg8::gemm_phase<true>(F.lds, g, S, E, F.wave);
        GRID_BAR();
    }
    if (IN(9)) REPS(9) {
        for (int m = gw; m < MREAL; m += NGW) {
            f32x4 y1[8], acc[8]; load_row_bf16(Y1 + (size_t)m * DM, lane_id(), y1); load_row(x + (size_t)m * DM, lane_id(), acc);
            const float r0 = rstd0[m];
            const float r1 = __builtin_amdgcn_rsqf(row_ss(y1) * (1.0f / DM) + RMS_EPS);
#pragma unroll
            for (int j = 0; j < 8; ++j) {
                const int e = 4 * (64 * j + lane_id());
                const u32x2 y0w = *(const u32x2*)(Y0 + (size_t)m * DM + e); const f32x4 y0 = {bflo(y0w.x), bfhi(y0w.x), bflo(y0w.y), bfhi(y0w.y)};
                acc[j] = acc[j] + y0 * r0 * *(const f32x4*)(post_g + e) + y1[j] * r1 * *(const f32x4*)(post_g + DM + e);
                *(f32x4*)(args.out + (size_t)m * DM + e) = acc[j];
            }
        }
    }
#undef gtid
#undef IN
#undef GRID_BAR
}

extern "C" void kernel_launch(void* const* d_in, const int* in_sizes, int n_in, void* d_out, int out_size, void* d_ws, size_t ws_size, hipStream_t stream) {
    static int grid = 0;
    if (grid == 0) {
        if (n_in != 15 || in_sizes[0] != NB * SEQ * DM || out_size != NB * SEQ * DM || ws_size < WS_END) {
            fprintf(stderr, "kernel_launch: unexpected shapes (n_in %d, in0 %d, out %d, ws %zu)\n", n_in, n_in > 0 ? in_sizes[0] : -1, out_size, ws_size); grid = -1; return; }
        int dev = 0, cus = 0, per_cu = 0;
        if (hipGetDevice(&dev) != hipSuccess || hipDeviceGetAttribute(&cus, hipDeviceAttributeMultiprocessorCount, dev) != hipSuccess) { grid = -1; return; }
        if (hipFuncSetAttribute((const void*)trunk_fwd, hipFuncAttributeMaxDynamicSharedMemorySize, LDS_BYTES) != hipSuccess) { fprintf(stderr, "kernel_launch: hipFuncSetAttribute failed\n"); grid = -1; return; }
        if (hipOccupancyMaxActiveBlocksPerMultiprocessor(&per_cu, (const void*)trunk_fwd, 512, LDS_BYTES) != hipSuccess || per_cu < 1) {
            fprintf(stderr, "kernel_launch: occupancy query reports %d workgroups per CU\n", per_cu); (void)hipGetLastError(); grid = -1; return; }
        grid = cus;
    }
    if (grid < 0) return;
    (void)hipMemsetAsync((char*)d_ws + WS_CTL, 0, CTL_ZERO_BYTES, stream);
    Args a{};
    for (int i = 0; i < 15; ++i) a.in[i] = (const float*)d_in[i];
    a.out = (float*)d_out; a.ws = (unsigned char*)d_ws;
    for (int i = 0; i < 16; ++i) a.inv_freq[i] = (float)pow(500000.0, -(double)i / 16.0);
#if MK_N_LAUNCHES == 1
    a.ph_lo = 0; a.ph_hi = 10; a.li = 0;
    hipLaunchKernelGGL(trunk_fwd, dim3(grid), dim3(512), LDS_BYTES, stream, a);
#else
    for (int p = 0; p < 10; ++p) { a.ph_lo = p; a.ph_hi = p + 1; a.li = p; hipLaunchKernelGGL(trunk_fwd, dim3(grid), dim3(512), LDS_BYTES, stream, a); }
#endif
    const hipError_t le = hipPeekAtLastError();
    if (le != hipSuccess) fprintf(stderr, "kernel_launch: launch failed: %s\n", hipGetErrorName(le));
}
```

```cpp
#include <hip/hip_runtime.h>
#include <cstdio>
#include <cstdint>
#include <cmath>

#ifndef MK_N_LAUNCHES
#define MK_N_LAUNCHES 1
#endif
#ifndef PROBE_PH
#define PROBE_PH (-1)
#endif
#ifndef PROBE_REP
#define PROBE_REP 0
#endif

#define LAS __attribute__((address_space(3)))
#define GAS __attribute__((address_space(1)))
typedef unsigned short bf16_t;
typedef short bf16x8 __attribute__((ext_vector_type(8)));
typedef short s16x4 __attribute__((ext_vector_type(4)));
typedef float f32x4 __attribute__((ext_vector_type(4)));
typedef float f32x16 __attribute__((ext_vector_type(16)));
typedef unsigned u32x4 __attribute__((ext_vector_type(4)));
typedef unsigned u32x2 __attribute__((ext_vector_type(2)));

constexpr int DM = 2048, SEQ = 4096, NB = 2, NMETA = 16, LTOT = SEQ + NMETA;
constexpr int MREAL = NB * SEQ;
constexpr int MROWS = MREAL + NMETA;
constexpr int NH = 8, HD = 128, VD = 256;
constexpr int NTILE = 65;
constexpr int KTILE_B = 64 * 128 * 2, VTILE_B = 64 * 256 * 2;
constexpr float RMS_EPS = 1e-6f;
constexpr float C2 = 0.08838834764831845f * 1.4426950408889634f;
constexpr float LOG2E = 1.4426950408889634f;

constexpr size_t MiB = 1u << 20;
constexpr size_t WS_CTL = 0, CTL_ZERO_BYTES = 65536;
constexpr size_t WS_ROPEC = 1 * MiB, WS_ROPES = 1 * MiB + 512 * 1024;
constexpr size_t WS_RSTD0 = 2 * MiB;
constexpr size_t WS_W1 = 4 * MiB, WS_W2 = 36 * MiB, WS_W3 = 44 * MiB, WS_W4 = 60 * MiB, WS_W5 = 62 * MiB;
constexpr size_t WS_XN = 70 * MiB, WS_G = 104 * MiB, WS_QO = 138 * MiB, WS_K = 172 * MiB;
constexpr size_t KIMG_BYTES = (size_t)NB * NH * 2 * NTILE * KTILE_B, VIMG_BYTES = (size_t)NB * NH * NTILE * VTILE_B;
constexpr size_t WS_V = WS_K + KIMG_BYTES;
constexpr size_t WS_Y0 = WS_K;
constexpr size_t WS_U = WS_QO, WS_G1 = WS_G, WS_MIX = WS_XN, WS_GATED1 = WS_QO, WS_Y1 = WS_XN;
constexpr size_t WS_END = WS_V + VIMG_BYTES;
static_assert(WS_END <= 240 * MiB && WS_Y0 + (size_t)MROWS * DM * 2 <= WS_END && WS_Y1 + (size_t)MROWS * DM * 2 <= WS_G, "ws map");
constexpr int CW_BAR = 4096;

constexpr int RING_BYTES = 131072, LDSCTL_OFF = RING_BYTES, MISC_OFF = LDSCTL_OFF + 320, LDS_BYTES = 147456;

__device__ __forceinline__ int lane_id() { int l = (int)__builtin_amdgcn_mbcnt_hi(~0u, __builtin_amdgcn_mbcnt_lo(~0u, 0u)); asm volatile("" : "+v"(l)); return l; }
__device__ __forceinline__ unsigned pk2(float lo, float hi) {
    typedef float f2_t __attribute__((ext_vector_type(2))); typedef __bf16 b2_t __attribute__((ext_vector_type(2)));
    f2_t v = {lo, hi}; b2_t b = __builtin_convertvector(v, b2_t); return __builtin_bit_cast(unsigned, b);
}
__device__ __forceinline__ float bflo(unsigned u) { return __uint_as_float(u << 16); }
__device__ __forceinline__ float bfhi(unsigned u) { return __uint_as_float(u & 0xffff0000u); }
__device__ __forceinline__ float siluf(float x) { return x * __builtin_amdgcn_rcpf(1.0f + __builtin_amdgcn_exp2f(-x * LOG2E)); }
__device__ __forceinline__ float wave_sum(float v) {
#pragma unroll
    for (int o = 1; o < 64; o <<= 1) v += __shfl_xor(v, o);
    return v;
}
__device__ __forceinline__ u32x4 pack8(f32x4 a, f32x4 b) { u32x4 w; w.x = pk2(a[0], a[1]); w.y = pk2(a[2], a[3]); w.z = pk2(b[0], b[1]); w.w = pk2(b[2], b[3]); return w; }

struct Epi {
    int mode;
    bf16_t* Q; unsigned char* Kimg; unsigned char* Vimg; bf16_t* G; const float* ropec; const float* ropes;
    bf16_t* Y;
    bf16_t* U; bf16_t* G1;
    bf16_t* GATED1; const float* pool_scale;
    template <int MODE> __device__ __forceinline__ void emit(int row, int col, f32x4 a, f32x4 b) const {
        if constexpr (MODE == 1) {
            if (col < 4096) {
                const int c = col & 2047, dim = c & 127;
                if (dim < 32) {
                    f32x4 pa, pb;
#pragma unroll
                    for (int i = 0; i < 4; ++i) { pa[i] = __shfl_xor(a[i], 32); pb[i] = __shfl_xor(b[i], 32); }
                    const int pos = row < MREAL ? NMETA + (row & (SEQ - 1)) : row - MREAL;
                    const float* cs = ropec + pos * 16 + (dim & 15); const float* sn = ropes + pos * 16 + (dim & 15);
                    const f32x4 c0 = *(const f32x4*)cs, c1 = *(const f32x4*)(cs + 4), s0 = *(const f32x4*)sn, s1 = *(const f32x4*)(sn + 4);
                    if (dim < 16) { a = a * c0 - pa * s0; b = b * c1 - pb * s1; } else { a = a * c0 + pa * s0; b = b * c1 + pb * s1; }
                }
                if (col < 2048) { a = a * C2; b = b * C2; *(u32x4*)(Q + (size_t)row * DM + c) = pack8(a, b); }
                else {
                    const int h = c >> 8, mp = (c >> 7) & 1; const u32x4 w = pack8(a, b);
                    const size_t inner = (size_t)(dim >> 3) * 1024;
                    if (row < MREAL) { const int bb = row >> 12, j = row & (SEQ - 1), tile = 1 + (j >> 6), key = j & 63;
                        *(u32x4*)(Kimg + ((size_t)((bb * NH + h) * 2 + mp) * NTILE + tile) * KTILE_B + inner + key * 16) = w; }
                    else { const int key = row - MREAL;
#pragma unroll
                        for (int bb = 0; bb < NB; ++bb) *(u32x4*)(Kimg + ((size_t)((bb * NH + h) * 2 + mp) * NTILE) * KTILE_B + inner + key * 16) = w; }
                }
            } else if (col < 6144) {
                const int c = col - 4096, h = c >> 8, d0 = c & 255, key = row - MREAL;
                const int slot = (key & 3) | (((key >> 3) & 1) << 2) | (((key >> 2) & 1) << 3);
                const float vals[8] = {a[0], a[1], a[2], a[3], b[0], b[1], b[2], b[3]};
                if (row >= MREAL) {
#pragma unroll
                    for (int i = 0; i < 8; ++i) { const int d = d0 + i; const unsigned short bv = (unsigned short)(pk2(vals[i], 0.f) & 0xffffu);
                        const size_t off = (size_t)d * 128 + (((slot >> 3) ^ ((d >> 1) & 7)) * 16) + (slot & 7) * 2;
#pragma unroll
                        for (int bb = 0; bb < NB; ++bb) *(unsigned short*)(Vimg + ((size_t)(bb * NH + h) * NTILE) * VTILE_B + off) = bv; }
                }
            } else {
                const int c = col - 6144;
#pragma unroll
                for (int i = 0; i < 4; ++i) { a[i] = siluf(a[i]); b[i] = siluf(b[i]); }
                *(u32x4*)(G + (size_t)row * DM + c) = pack8(a, b);
            }
        } else if constexpr (MODE == 2 || MODE == 5) {
            *(u32x4*)(Y + (size_t)row * DM + col) = pack8(a, b);
        } else if constexpr (MODE == 3) {
            if (col < 2048) { *(u32x4*)(U + (size_t)row * DM + col) = pack8(a, b); }
            else { const int c = col - 2048;
#pragma unroll
                for (int i = 0; i < 4; ++i) { a[i] = siluf(a[i]); b[i] = siluf(b[i]); }
                *(u32x4*)(G1 + (size_t)row * DM + c) = pack8(a, b); }
        } else if constexpr (MODE == 6) {
            const int h = row >> 8, d = row & 255, bb = col >> 12, j = col & (SEQ - 1), tile = 1 + (j >> 6), k0 = j & 63, sidx = k0 >> 4, aa = (k0 >> 3) & 1;
            unsigned char* base = Vimg + ((size_t)(bb * NH + h) * NTILE + tile) * VTILE_B + (size_t)d * 128 + 8 * aa; const int x = (d >> 1) & 7;
            u32x2 w0, w1; w0.x = pk2(a[0], a[1]); w0.y = pk2(a[2], a[3]); w1.x = pk2(b[0], b[1]); w1.y = pk2(b[2], b[3]);
            *(u32x2*)(base + (((2 * sidx) ^ x) * 16)) = w0; *(u32x2*)(base + (((2 * sidx + 1) ^ x) * 16)) = w1;
        } else {
            const f32x4 s0 = *(const f32x4*)(pool_scale + col), s1 = *(const f32x4*)(pool_scale + col + 4);
            const u32x4 g = *(const u32x4*)(G1 + (size_t)row * DM + col);
            a[0] *= s0[0] * bflo(g.x); a[1] *= s0[1] * bfhi(g.x); a[2] *= s0[2] * bflo(g.y); a[3] *= s0[3] * bfhi(g.y);
            b[0] *= s1[0] * bflo(g.z); b[1] *= s1[1] * bfhi(g.z); b[2] *= s1[2] * bflo(g.w); b[3] *= s1[3] * bfhi(g.w);
            *(u32x4*)(GATED1 + (size_t)row * DM + col) = pack8(a, b);
        }
    }
    __device__ __forceinline__ void emit_rt(int row, int col, f32x4 a, f32x4 b) const {
        if (mode == 1) emit<1>(row, col, a, b); else if (mode == 2 || mode == 5) emit<2>(row, col, a, b); else if (mode == 3) emit<3>(row, col, a, b); else if (mode == 6) emit<6>(row, col, a, b); else emit<4>(row, col, a, b);
    }
};

namespace pg8 {
constexpr int BM = 256, BK = 64, HALF = 128, HTB = HALF * BK * 2, STAGE_BYTES = 8 * HTB, NXCD = 8, WGM = 8;
__host__ __device__ __forceinline__ int lds_byte(int r, int c) { const int st = (r >> 4) * 2 + (c >> 5), rr = r & 15, cc = c & 31, ob = rr * 64 + cc * 2; return st * 1024 + (ob ^ (((ob >> 9) & 1) << 5)); }
__host__ __device__ __forceinline__ void stage_rc(int b, int& R, int& C) { const int st = b / 1024, sb = b % 1024, swz = sb ^ (((sb >> 9) & 1) << 5); R = (st >> 1) * 16 + swz / 64; C = (st & 1) * 32 + (swz % 64) / 2; }
__host__ __device__ __forceinline__ int perm32(int rho) { const int n = rho >> 4, i = rho & 15; return 8 * (i >> 2) + 4 * n + (i & 3); }
struct Unit { int pm, pn; };
struct Gemm { const bf16_t* A; const bf16_t* Bt; int M, N, K, lda, ldb, pn_per_grp, a_grp_cols; };
struct StaticOrder {
    int nM, nN, nwg, G, c, skip_from, skip_n;
    __device__ void init(int M, int N, int G_, int c_) { nM = M / BM; nN = N / BM; nwg = nM * nN; G = G_; c = c_; skip_from = 1 << 30; skip_n = 0; }
    __device__ bool next(int i, Unit& u) const {
        const long L = (long)i * G + c; if (L >= nwg) return false;
        int wgid = (int)L; { const int q = nwg / NXCD, r = nwg % NXCD, xcd = wgid % NXCD, off = wgid / NXCD; wgid = (xcd < r ? xcd * (q + 1) : r * (q + 1) + (xcd - r) * q) + off; }
        const int nig = WGM * nN, gid = wgid / nig, fm = gid * WGM, gsz = (nM - fm) < WGM ? (nM - fm) : WGM;
        u.pm = fm + ((wgid % nig) % gsz); u.pn = (wgid % nig) / gsz; if (u.pn >= skip_from) u.pn += skip_n; return true;
    }
};
template <int MODE>
__device__ __forceinline__ void run_epi_m(const Epi& E, const f32x4 (&acc)[2][2][4][2], const Unit& u, int wr, int wc) {
    int lane = lane_id();
    const int fr = lane & 15, fq = lane >> 4;
#pragma unroll
    for (int ai = 0; ai < 2; ++ai)
#pragma unroll
        for (int m = 0; m < 4; ++m) { const int row = u.pm * BM + ai * HALF + wr * 64 + m * 16 + fr;
#pragma unroll
            for (int bj = 0; bj < 2; ++bj) { const int col = u.pn * BM + bj * HALF + wc * 32 + 8 * fq; E.emit<MODE>(row, col, acc[ai][bj][m][0], acc[ai][bj][m][1]); asm volatile("" ::: "memory"); } }
}
__device__ __forceinline__ void run_epi(const Epi& E, const f32x4 (&acc)[2][2][4][2], const Unit& u, int wr, int wc, int fr, int fq) {
    if (E.mode == 1) run_epi_m<1>(E, acc, u, wr, wc); else if (E.mode == 2 || E.mode == 5) run_epi_m<2>(E, acc, u, wr, wc);
    else if (E.mode == 3) run_epi_m<3>(E, acc, u, wr, wc); else if (E.mode == 6) run_epi_m<6>(E, acc, u, wr, wc); else run_epi_m<4>(E, acc, u, wr, wc);
}
template <bool ALIGN_EPI>
__device__ __forceinline__ void gemm_phase(LAS unsigned char* lds, const Gemm g, const StaticOrder& S, const Epi& E, int wave_idx) {
    const int wid = wave_idx, lane = lane_id(), tid = wid * 64 + lane, wr = wid >> 2, wc = wid & 3, fr = lane & 15, fq = lane >> 4;
    const int K = g.K, nt = K / BK;
    unsigned voffA[2], voffB[2];
#pragma unroll
    for (int i = 0; i < 2; ++i) { int R, C; stage_rc(tid * 16 + i * 8192, R, C); const int Rb = (R & ~31) + perm32(R & 31);
        voffA[i] = (unsigned)(R * g.lda + C) * 2u; voffB[i] = (unsigned)(Rb * g.ldb + C) * 2u; }
    const size_t kstep = (size_t)(BK * 2);
    const size_t hstepA = (size_t)HALF * g.lda * 2, hstepB = (size_t)HALF * g.ldb * 2;
    const size_t tstepA = 2 * hstepA, tstepB = 2 * hstepB;
    const unsigned ldsw = (unsigned)wid * 1024u;
    const int aoff = lds_byte(wr * 64 + fr, fq * 8), boff = lds_byte(wc * 32 + fr, fq * 8);
#define PG8_SA(b, h) (((b) * 2 + (h)) * HTB)
#define PG8_SB(b, h) ((4 + (b) * 2 + (h)) * HTB)
#define PG8_STAGE(bufoff, gbase, voff) do { _Pragma("unroll") for (int _i = 0; _i < 2; ++_i) \
        __builtin_amdgcn_global_load_lds((const unsigned*)((const char*)(gbase) + (voff)[_i]), (LAS unsigned*)(lds + (bufoff) + ldsw + _i * 8192), 16, 0, 0); } while (0)
#define PG8_LDA(dst, b, h) do { _Pragma("unroll") for (int m = 0; m < 4; ++m) _Pragma("unroll") for (int k = 0; k < 2; ++k) dst[m][k] = *(const LAS bf16x8*)(lds + PG8_SA(b, h) + aoff + m * 2048 + k * 1024); } while (0)
#define PG8_LDB(dst, b, h) do { _Pragma("unroll") for (int n = 0; n < 2; ++n) _Pragma("unroll") for (int k = 0; k < 2; ++k) dst[n][k] = *(const LAS bf16x8*)(lds + PG8_SB(b, h) + boff + n * 2048 + k * 1024); } while (0)
#define PG8_MMA(ai, bj, At, Bt) do { __builtin_amdgcn_s_setprio(1); _Pragma("unroll") for (int m = 0; m < 4; ++m) _Pragma("unroll") for (int n = 0; n < 2; ++n) _Pragma("unroll") for (int k = 0; k < 2; ++k) \
        acc[ai][bj][m][n] = __builtin_amdgcn_mfma_f32_16x16x32_bf16(Bt[n][k], At[m][k], acc[ai][bj][m][n], 0, 0, 0); __builtin_amdgcn_s_setprio(0); } while (0)
#define PG8_WAIT_V(n) asm volatile("s_waitcnt vmcnt(" #n ")" ::: "memory")
#define PG8_WAIT_L(n) asm volatile("s_waitcnt lgkmcnt(" #n ")" ::: "memory")
#define PG8_BAR __builtin_amdgcn_s_barrier()
#define PG8_SCHED __builtin_amdgcn_sched_barrier(0)
#define PG8_ABASE(u) ((const char*)g.A + (size_t)(u).pm * tstepA + (size_t)((u).pn / g.pn_per_grp) * g.a_grp_cols * 2)
    Unit cur, nxt; int ui = 0;
    if (!S.next(0, cur)) return;
    f32x4 acc[2][2][4][2];
#pragma unroll
    for (int a = 0; a < 2; ++a)
#pragma unroll
        for (int b = 0; b < 2; ++b)
#pragma unroll
            for (int m = 0; m < 4; ++m)
#pragma unroll
                for (int n = 0; n < 2; ++n) acc[a][b][m][n] = (f32x4){0.f, 0.f, 0.f, 0.f};
    bf16x8 At[4][2], B0[2][2], B1[2][2];
    const char* cA = PG8_ABASE(cur); const char* cB = (const char*)g.Bt + (size_t)cur.pn * tstepB;
    PG8_STAGE(PG8_SB(0, 0), cB, voffB); PG8_STAGE(PG8_SB(0, 1), cB + hstepB, voffB); PG8_STAGE(PG8_SA(0, 0), cA, voffA); PG8_STAGE(PG8_SA(0, 1), cA + hstepA, voffA);
    if (wr == 1) PG8_BAR;
    PG8_WAIT_V(2); PG8_BAR;
    PG8_STAGE(PG8_SB(1, 0), cB + kstep, voffB); PG8_STAGE(PG8_SA(1, 0), cA + kstep, voffA); PG8_STAGE(PG8_SB(1, 1), cB + hstepB + kstep, voffB);
    PG8_WAIT_V(6); PG8_BAR;
    for (;;) {
        const bool has_next = S.next(ui + 1, nxt);
        const char* nA = has_next ? PG8_ABASE(nxt) : cA; const char* nB = has_next ? (const char*)g.Bt + (size_t)nxt.pn * tstepB : cB;
        for (int t = 0; t < nt; t += 2) {
            const bool last = (t == nt - 2);
            const char* a1 = cA + (size_t)(t + 1) * kstep;
            const char* a2 = last ? nA : cA + (size_t)(t + 2) * kstep; const char* b2 = last ? nB : cB + (size_t)(t + 2) * kstep;
            const char* a3 = a2 + kstep; const char* b3 = b2 + kstep;
            PG8_LDB(B0, 0, 0); PG8_LDB(B1, 0, 1); PG8_SCHED; PG8_LDA(At, 0, 0); PG8_STAGE(PG8_SA(1, 1), a1 + hstepA, voffA);
            PG8_WAIT_V(8); PG8_WAIT_L(0); PG8_BAR; PG8_MMA(0, 0, At, B0); PG8_MMA(0, 1, At, B1); PG8_BAR; PG8_SCHED;
            PG8_LDA(At, 0, 1); PG8_STAGE(PG8_SB(0, 0), b2, voffB); PG8_STAGE(PG8_SB(0, 1), b2 + hstepB, voffB); PG8_STAGE(PG8_SA(0, 0), a2, voffA);
            PG8_WAIT_V(8); PG8_WAIT_L(0); PG8_BAR; PG8_MMA(1, 0, At, B0); PG8_MMA(1, 1, At, B1); PG8_BAR; PG8_SCHED;
            PG8_LDB(B0, 1, 0); PG8_LDB(B1, 1, 1); PG8_SCHED; PG8_LDA(At, 1, 0); PG8_STAGE(PG8_SA(0, 1), a2 + hstepA, voffA);
            PG8_WAIT_V(8); PG8_WAIT_L(0); PG8_BAR; PG8_MMA(0, 0, At, B0); PG8_MMA(0, 1, At, B1); PG8_BAR; PG8_SCHED;
            PG8_LDA(At, 1, 1); PG8_STAGE(PG8_SB(1, 0), b3, voffB); PG8_STAGE(PG8_SB(1, 1), b3 + hstepB, voffB); PG8_STAGE(PG8_SA(1, 0), a3, voffA);
            PG8_WAIT_V(8); PG8_WAIT_L(0); PG8_BAR; PG8_MMA(1, 0, At, B0); PG8_MMA(1, 1, At, B1); PG8_BAR; PG8_SCHED;
        }
        if constexpr (ALIGN_EPI) { if (wr == 0) PG8_BAR; }
        run_epi(E, acc, cur, wr, wc, fr, fq);
        if (!has_next) break;
#pragma unroll
        for (int a = 0; a < 2; ++a)
#pragma unroll
            for (int b = 0; b < 2; ++b)
#pragma unroll
                for (int m = 0; m < 4; ++m)
#pragma unroll
                    for (int n = 0; n < 2; ++n) acc[a][b][m][n] = (f32x4){0.f, 0.f, 0.f, 0.f};
        cur = nxt; cA = nA; cB = nB; ++ui;
        if constexpr (ALIGN_EPI) { if (wr == 1) PG8_BAR; }
    }
    PG8_WAIT_V(0);
    if constexpr (!ALIGN_EPI) { if (wr == 0) PG8_BAR; }
    PG8_BAR;
#undef PG8_SA
#undef PG8_SB
#undef PG8_STAGE
#undef PG8_LDA
#undef PG8_LDB
#undef PG8_MMA
#undef PG8_WAIT_V
#undef PG8_WAIT_L
#undef PG8_BAR
#undef PG8_SCHED
#undef PG8_ABASE
}
}

typedef GAS unsigned gu32;
#define RLX_AGENT __ATOMIC_RELAXED, __HIP_MEMORY_SCOPE_AGENT
#define XB_TMO      128
#define XB_XCNT(j)  (256  + 64 * (j))
#define XB_XSUB(j)  (1280 + 64 * (j))
#define XB_XGEN(j)  (2304 + 64 * (j))
#define XB_TOP      3328
#define XB_TOPGEN   3392
#define XCD_BAR_WORDS 3456
#define XB_SPIN_CAP (1u << 18)
__device__ __forceinline__ unsigned xb_ld(unsigned* p)              { return __hip_atomic_load(p, __ATOMIC_RELAXED, __HIP_MEMORY_SCOPE_AGENT); }
__device__ __forceinline__ unsigned xb_add(unsigned* p, unsigned v) { return __hip_atomic_fetch_add(p, v, __ATOMIC_RELAXED, __HIP_MEMORY_SCOPE_AGENT); }
__device__ __forceinline__ unsigned xb_xcc_id() { return (unsigned)__builtin_amdgcn_s_getreg((3 << 11) | 20) & 0xFu; }
#define XB_SPIN(cond, bar) do { unsigned _sp = 0; while (cond) { __builtin_amdgcn_s_sleep(1); \
    if ((++_sp & 255u) == 0u) { if (xb_ld(&(bar)[XB_TMO])) break; if (_sp > XB_SPIN_CAP) { atomicAdd(&(bar)[XB_TMO], 1u); break; } } } } while (0)
struct XcdBarrier { unsigned* bar; unsigned x; volatile LAS unsigned* st; bool leader; };
__device__ __forceinline__ XcdBarrier xcd_barrier_post(unsigned* bar, volatile LAS unsigned* st, bool wave0) {
    XcdBarrier b; b.bar = bar; b.x = xb_xcc_id(); b.st = st; b.leader = wave0;
    if (wave0 && lane_id() == 0) (void)xb_add(&bar[XB_XCNT(b.x)], 1u);
    return b;
}
__device__ __forceinline__ void xcd_barrier_complete(unsigned* bar, unsigned x, unsigned& nloc, unsigned& nx) {
    const unsigned G = gridDim.x * gridDim.y * gridDim.z;
    unsigned sum, cnt, mine, sp = 0u;
    for (;;) {
        sum = 0u; cnt = 0u; mine = 0u;
#pragma unroll
        for (unsigned j = 0; j < 16; ++j) { const unsigned c = xb_ld(&bar[XB_XCNT(j)]); sum += c; cnt += (c > 0u) ? 1u : 0u; mine = (j == x) ? c : mine; }
        if (sum == G) break;
        __builtin_amdgcn_s_sleep(1);
        if ((++sp & 255u) == 0u) { if (xb_ld(&bar[XB_TMO])) break; if (sp > XB_SPIN_CAP) { atomicAdd(&bar[XB_TMO], 1u); break; } }
    }
    nloc = mine > 0u ? mine : 1u; nx = cnt > 0u ? cnt : 1u;
}
__device__ __forceinline__ void xcd_barrier(const XcdBarrier& b) {
    asm volatile("s_waitcnt vmcnt(0)" ::: "memory");
    __syncthreads();
    if (b.leader && lane_id() == 0) {
        unsigned* bar = b.bar;
        __builtin_amdgcn_s_waitcnt(0);
        unsigned nloc = b.st[0], nx = b.st[1];
        if (nloc == 0u) { xcd_barrier_complete(bar, b.x, nloc, nx); b.st[0] = nloc; b.st[1] = nx; }
        const unsigned old = xb_add(&bar[XB_XSUB(b.x)], 1u);
        const unsigned gen = old / nloc;
        if (old + 1u == (gen + 1u) * nloc) {
            __builtin_amdgcn_fence(__ATOMIC_RELEASE, "agent");
            asm volatile("s_waitcnt vmcnt(0)" ::: "memory");
            const unsigned og = xb_add(&bar[XB_TOP], 1u);
            const unsigned tg = og / nx;
            if (og + 1u == (tg + 1u) * nx) xb_add(&bar[XB_TOPGEN], 1u);
            else XB_SPIN(xb_ld(&bar[XB_TOPGEN]) == tg, bar);
            __builtin_amdgcn_fence(__ATOMIC_ACQUIRE, "agent");
            xb_add(&bar[XB_XGEN(b.x)], 1u);
            asm volatile("s_waitcnt vmcnt(0)" ::: "memory");
        } else {
            XB_SPIN(xb_ld(&bar[XB_XGEN(b.x)]) == gen, bar);
            __builtin_amdgcn_fence(__ATOMIC_ACQUIRE, "agent");
            asm volatile("s_waitcnt vmcnt(0)" ::: "memory");
        }
    }
    __syncthreads();
}

struct Args {
    const float* in[15]; float* out; unsigned char* ws;
    float inv_freq[16];
    int ph_lo, ph_hi, li, pad;
};
struct Frame {
    LAS unsigned char* lds; int wave, vcu, G;
};

struct P0Item { const float* src; bf16_t* dst; int N, ldt; };
__device__ __forceinline__ void p0_item_load(const P0Item& it, int lane, f32x4 (&v)[8]) {
    const float* p = it.src + (size_t)(lane >> 3) * it.N + 4 * (lane & 7);
#pragma unroll
    for (int i = 0; i < 8; ++i) v[i] = __builtin_nontemporal_load((const f32x4*)(p + (size_t)(8 * i) * it.N));
}
__device__ __forceinline__ void p0_item_store(const P0Item& it, int lane, const f32x4 (&v)[8], LAS float* scr) {
    LAS float* w = scr + (lane >> 3) * 33 + 4 * (lane & 7);
#pragma unroll
    for (int i = 0; i < 8; ++i) { w[(8 * i) * 33 + 0] = v[i][0]; w[(8 * i) * 33 + 1] = v[i][1]; w[(8 * i) * 33 + 2] = v[i][2]; w[(8 * i) * 33 + 3] = v[i][3]; }
    asm volatile("s_waitcnt lgkmcnt(0)" ::: "memory");
    const int c = lane & 7;
#pragma unroll
    for (int j = 0; j < 4; ++j) { const int n = (lane >> 3) + 8 * j; const LAS float* s = scr + (8 * c) * 33 + n;
        u32x4 o; o.x = pk2(s[0 * 33], s[1 * 33]); o.y = pk2(s[2 * 33], s[3 * 33]); o.z = pk2(s[4 * 33], s[5 * 33]); o.w = pk2(s[6 * 33], s[7 * 33]);
        *(u32x4*)(it.dst + (size_t)n * it.ldt + 8 * c) = o; }
    asm volatile("s_waitcnt lgkmcnt(0)" ::: "memory");
}
__device__ __forceinline__ void load_row(const float* p, int lane, f32x4 (&v)[8]) {
#pragma unroll
    for (int j = 0; j < 8; ++j) v[j] = *(const f32x4*)(p + 4 * (64 * j + lane));
}
__device__ __forceinline__ void load_row_bf16(const bf16_t* p, int lane, f32x4 (&v)[8]) {
#pragma unroll
    for (int j = 0; j < 8; ++j) { const u32x2 w = *(const u32x2*)(p + 4 * (64 * j + lane)); v[j] = (f32x4){bflo(w.x), bfhi(w.x), bflo(w.y), bfhi(w.y)}; }
}
__device__ __forceinline__ float row_ss(const f32x4 (&v)[8]) {
    float s = 0.f;
#pragma unroll
    for (int j = 0; j < 8; ++j) s += (v[j][0] * v[j][0] + v[j][1] * v[j][1]) + (v[j][2] * v[j][2] + v[j][3] * v[j][3]);
    return wave_sum(s);
}
__device__ __forceinline__ void row_ss2(const f32x4 (&a)[8], const f32x4 (&b)[8], float& sa, float& sb) {
    float s = 0.f, t = 0.f;
#pragma unroll
    for (int j = 0; j < 8; ++j) { s += (a[j][0] * a[j][0] + a[j][1] * a[j][1]) + (a[j][2] * a[j][2] + a[j][3] * a[j][3]); t += (b[j][0] * b[j][0] + b[j][1] * b[j][1]) + (b[j][2] * b[j][2] + b[j][3] * b[j][3]); }
#pragma unroll
    for (int o = 1; o < 64; o <<= 1) { s += __shfl_xor(s, o); t += __shfl_xor(t, o); }
    sa = s; sb = t;
}
__device__ __forceinline__ void store_row_bf16(bf16_t* p, int lane, const f32x4 (&v)[8]) {
#pragma unroll
    for (int j = 0; j < 8; ++j) { u32x2 w; w.x = pk2(v[j][0], v[j][1]); w.y = pk2(v[j][2], v[j][3]); *(u32x2*)(p + 4 * (64 * j + lane)) = w; }
}

__device__ __forceinline__ void rows16_phase(const Frame& F, const bf16_t* A16, int lda, const bf16_t* Bt, int ldb, int K, int ntasks, int a_grp_cols, int tasks_per_grp, const Epi& E) {
    int lane_o = lane_id();
    const int lane = lane_o, m = lane & 15, fq = lane >> 4;
    LAS float* red = (LAS float*)F.lds;
    const int stride = F.G / ntasks > 0 ? F.G / ntasks : 1;
    for (int task0 = F.vcu; task0 < ntasks * stride; task0 += F.G) {
        if (task0 % stride) continue;
        const int task = task0 / stride;
        const int n0 = task * 32, kslice = K / 8, kb = F.wave * kslice;
        const bf16_t* ap = A16 + (size_t)m * lda + (task / tasks_per_grp) * a_grp_cols + kb + 8 * fq;
        const bf16_t* bp0 = Bt + (size_t)(n0 + 8 * (m >> 2) + (m & 3)) * ldb + kb + 8 * fq;
        const bf16_t* bp1 = bp0 + (size_t)4 * ldb;
        f32x4 acc0 = {0.f, 0.f, 0.f, 0.f}, acc1 = {0.f, 0.f, 0.f, 0.f};
        for (int ks = 0; ks < kslice; ks += 32) {
            const bf16x8 a = *(const bf16x8*)(ap + ks), b0 = *(const bf16x8*)(bp0 + ks), b1 = *(const bf16x8*)(bp1 + ks);
            acc0 = __builtin_amdgcn_mfma_f32_16x16x32_bf16(b0, a, acc0, 0, 0, 0);
            acc1 = __builtin_amdgcn_mfma_f32_16x16x32_bf16(b1, a, acc1, 0, 0, 0);
        }
        *(LAS f32x4*)(red + (F.wave * 2 + 0) * 256 + lane * 4) = acc0;
        *(LAS f32x4*)(red + (F.wave * 2 + 1) * 256 + lane * 4) = acc1;
        __syncthreads();
        if (F.wave == 0) {
            f32x4 s0 = {0.f, 0.f, 0.f, 0.f}, s1 = {0.f, 0.f, 0.f, 0.f};
#pragma unroll
            for (int w = 0; w < 8; ++w) { s0 += *(const LAS f32x4*)(red + (w * 2 + 0) * 256 + lane * 4); s1 += *(const LAS f32x4*)(red + (w * 2 + 1) * 256 + lane * 4); }
            E.emit_rt(MREAL + m, n0 + 8 * fq, s0, s1);
        }
        __syncthreads();
    }
}

template <int W> __device__ __forceinline__ void mix_strip(const bf16_t* U, bf16_t* MIXo, int strip, int c0) {
    const int row0 = strip * 16, bb = row0 >> 12, p0 = NMETA + (row0 & (SEQ - 1));
    u32x4 buf[W - 1 + 16];
#pragma unroll
    for (int i = 0; i < W - 1 + 16; ++i) { const int pp = p0 - (W - 1) + i; const int r = pp >= NMETA ? bb * SEQ + pp - NMETA : MREAL + pp;
        buf[i] = *(const u32x4*)(U + (size_t)r * DM + c0); }
    float s[8] = {0.f, 0.f, 0.f, 0.f, 0.f, 0.f, 0.f, 0.f};
#define MIX_UNPK(v, f) const float f[8] = {bflo(v.x), bfhi(v.x), bflo(v.y), bfhi(v.y), bflo(v.z), bfhi(v.z), bflo(v.w), bfhi(v.w)}
#pragma unroll
    for (int i = 0; i < W - 1; ++i) { MIX_UNPK(buf[i], f);
#pragma unroll
        for (int k = 0; k < 8; ++k) s[k] += f[k]; }
    constexpr float iw = 1.0f / (float)W;
#pragma unroll
    for (int t = 0; t < 16; ++t) {
        MIX_UNPK(buf[W - 1 + t], f);
#pragma unroll
        for (int k = 0; k < 8; ++k) s[k] += f[k];
        u32x4 o; o.x = pk2(s[0] * iw - f[0], s[1] * iw - f[1]); o.y = pk2(s[2] * iw - f[2], s[3] * iw - f[3]);
        o.z = pk2(s[4] * iw - f[4], s[5] * iw - f[5]); o.w = pk2(s[6] * iw - f[6], s[7] * iw - f[7]);
        *(u32x4*)(MIXo + (size_t)(row0 + t) * DM + c0) = o;
        MIX_UNPK(buf[t], g);
#pragma unroll
        for (int k = 0; k < 8; ++k) s[k] -= g[k];
    }
#undef MIX_UNPK
}

namespace att {
__device__ __forceinline__ int crow(int r, int hi) { return (r & 3) + 8 * (r >> 2) + 4 * hi; }
__device__ __forceinline__ float xch32(float v) { return __shfl_xor(v, 32); }
#ifndef ATT_VPREFETCH
#define ATT_VPREFETCH 1
#endif
#ifndef ATT_PROBE
#define ATT_PROBE 0
#endif
#ifndef ATT_STATICPRIO
#define ATT_STATICPRIO 1
#endif
#ifndef ATT_VSETS
#define ATT_VSETS 1
#endif
#ifndef ATT_PIPE
#define ATT_PIPE 0
#endif
#ifndef ATT_STAGGER
#define ATT_STAGGER 1
#endif
#ifndef ATT_SETPRIO
#define ATT_SETPRIO 0
#endif
constexpr float THRL = 6.0f;
template <int OFF> __device__ __forceinline__ bf16x8 v_read1(int va) {
    bf16x8 r; asm volatile("ds_read_b128 %0, %1 offset:%2" : "=&v"(r) : "v"(va), "i"(OFF) : "memory"); return r;
}
template <int D0> __device__ __forceinline__ void pv_read(bf16x8 (&v)[4], const int (&voff)[4]) {
    v[0] = v_read1<D0 * 4096>(voff[0]); v[1] = v_read1<D0 * 4096>(voff[1]); v[2] = v_read1<D0 * 4096>(voff[2]); v[3] = v_read1<D0 * 4096>(voff[3]);
}
__device__ __forceinline__ void pv_mma(f32x16& od, const bf16x8 (&v)[4], const u32x4 (&pw)[4]) {
    if (ATT_SETPRIO) __builtin_amdgcn_s_setprio(1);
    od = __builtin_amdgcn_mfma_f32_32x32x16_bf16(v[0], __builtin_bit_cast(bf16x8, pw[0]), od, 0, 0, 0);
    od = __builtin_amdgcn_mfma_f32_32x32x16_bf16(v[1], __builtin_bit_cast(bf16x8, pw[1]), od, 0, 0, 0);
    od = __builtin_amdgcn_mfma_f32_32x32x16_bf16(v[2], __builtin_bit_cast(bf16x8, pw[2]), od, 0, 0, 0);
    od = __builtin_amdgcn_mfma_f32_32x32x16_bf16(v[3], __builtin_bit_cast(bf16x8, pw[3]), od, 0, 0, 0);
    if (ATT_SETPRIO) __builtin_amdgcn_s_setprio(0);
}
#define ATT_WL(n) do { __builtin_amdgcn_sched_barrier(0); asm volatile("s_waitcnt lgkmcnt(" #n ")" ::: "memory"); __builtin_amdgcn_sched_barrier(0); } while (0)
__device__ __forceinline__ void pv_all(f32x16 (&o)[8], int vb, const int (&vsw)[4], const u32x4 (&pw)[4]) {
    const int voff[4] = {vb + vsw[0], vb + vsw[1], vb + vsw[2], vb + vsw[3]};
    bf16x8 va[4], vc[4];
    pv_read<0>(va, voff); ATT_WL(0);
    pv_read<1>(vc, voff); pv_mma(o[0], va, pw); ATT_WL(0);
    pv_read<2>(va, voff); pv_mma(o[1], vc, pw); ATT_WL(0);
    pv_read<3>(vc, voff); pv_mma(o[2], va, pw); ATT_WL(0);
    pv_read<4>(va, voff); pv_mma(o[3], vc, pw); ATT_WL(0);
    pv_read<5>(vc, voff); pv_mma(o[4], va, pw); ATT_WL(0);
    pv_read<6>(va, voff); pv_mma(o[5], vc, pw); ATT_WL(0);
    pv_read<7>(vc, voff); pv_mma(o[6], va, pw); ATT_WL(0);
    pv_mma(o[7], vc, pw);
}
template <int OFF> __device__ __forceinline__ bf16x8 k_read1(int kb) {
    bf16x8 r; asm volatile("ds_read_b128 %0, %1 offset:%2" : "=&v"(r) : "v"(kb), "i"(OFF) : "memory"); return r;
}
template <int G> __device__ __forceinline__ void k_read(bf16x8 (&k)[4], int kb) {
    k[0] = k_read1<(2 * G) * 2048>(kb); k[1] = k_read1<(2 * G) * 2048 + 512>(kb); k[2] = k_read1<(2 * G + 1) * 2048>(kb); k[3] = k_read1<(2 * G + 1) * 2048 + 512>(kb);
}
template <int G> __device__ __forceinline__ void qk_mma(f32x16& p0, f32x16& p1, const bf16x8 (&k)[4], const bf16x8 (&qr)[8]) {
    p0 = __builtin_amdgcn_mfma_f32_32x32x16_bf16(k[0], qr[2 * G], p0, 0, 0, 0);
    p1 = __builtin_amdgcn_mfma_f32_32x32x16_bf16(k[1], qr[2 * G], p1, 0, 0, 0);
    p0 = __builtin_amdgcn_mfma_f32_32x32x16_bf16(k[2], qr[2 * G + 1], p0, 0, 0, 0);
    p1 = __builtin_amdgcn_mfma_f32_32x32x16_bf16(k[3], qr[2 * G + 1], p1, 0, 0, 0);
}
template <int D, bool DO_PV, bool DO_SM>
__device__ __forceinline__ void pvsm_block(f32x16& od, const bf16x8 (&v)[4], const u32x4 (&pw)[4], f32x16& p0, f32x16& p1, float m_run, float& ps, u32x4 (&pn)[4]) {
#pragma unroll
    for (int k = 0; k < 4; ++k) {
        if (DO_PV) od = __builtin_amdgcn_mfma_f32_32x32x16_bf16(v[k], __builtin_bit_cast(bf16x8, pw[k]), od, 0, 0, 0);
        if (DO_SM) {
            constexpr int e0 = 4 * D; const int e = e0 + k;
            float ex;
            if (e < 16) { ex = __builtin_amdgcn_exp2f(p0[e] - m_run); p0[e] = ex; } else { ex = __builtin_amdgcn_exp2f(p1[e - 16] - m_run); p1[e - 16] = ex; }
            ps += ex;
            if (k & 1) { const int w = e >> 1;
                const float lo = (e - 1 < 16) ? p0[(e - 1) & 15] : p1[(e - 1) & 15];
                pn[w >> 2][w & 3] = pk2(lo, ex); }
        }
        __builtin_amdgcn_sched_barrier(0);
    }
}
template <bool DO_PV, bool DO_SM>
__device__ __forceinline__ void pv_sm(f32x16 (&o)[8], const int (&voff)[4], const u32x4 (&pw)[4], f32x16& p0, f32x16& p1, float m_run, float& ps, u32x4 (&pn)[4]) {
#if ATT_VSETS == 2
    bf16x8 va[4], vc[4];
    if (DO_PV) { pv_read<0>(va, voff); ATT_WL(0); }
    if (DO_PV) pv_read<1>(vc, voff); pvsm_block<0, DO_PV, DO_SM>(o[0], va, pw, p0, p1, m_run, ps, pn); if (DO_PV) ATT_WL(0);
    if (DO_PV) pv_read<2>(va, voff); pvsm_block<1, DO_PV, DO_SM>(o[1], vc, pw, p0, p1, m_run, ps, pn); if (DO_PV) ATT_WL(0);
    if (DO_PV) pv_read<3>(vc, voff); pvsm_block<2, DO_PV, DO_SM>(o[2], va, pw, p0, p1, m_run, ps, pn); if (DO_PV) ATT_WL(0);
    if (DO_PV) pv_read<4>(va, voff); pvsm_block<3, DO_PV, DO_SM>(o[3], vc, pw, p0, p1, m_run, ps, pn); if (DO_PV) ATT_WL(0);
    if (DO_PV) pv_read<5>(vc, voff); pvsm_block<4, DO_PV, DO_SM>(o[4], va, pw, p0, p1, m_run, ps, pn); if (DO_PV) ATT_WL(0);
    if (DO_PV) pv_read<6>(va, voff); pvsm_block<5, DO_PV, DO_SM>(o[5], vc, pw, p0, p1, m_run, ps, pn); if (DO_PV) ATT_WL(0);
    if (DO_PV) pv_read<7>(vc, voff); pvsm_block<6, DO_PV, DO_SM>(o[6], va, pw, p0, p1, m_run, ps, pn); if (DO_PV) ATT_WL(0);
    pvsm_block<7, DO_PV, DO_SM>(o[7], vc, pw, p0, p1, m_run, ps, pn);
#else
    bf16x8 va[4];
    if (DO_PV) { pv_read<0>(va, voff); ATT_WL(0); } pvsm_block<0, DO_PV, DO_SM>(o[0], va, pw, p0, p1, m_run, ps, pn);
    if (DO_PV) { pv_read<1>(va, voff); ATT_WL(0); } pvsm_block<1, DO_PV, DO_SM>(o[1], va, pw, p0, p1, m_run, ps, pn);
    if (DO_PV) { pv_read<2>(va, voff); ATT_WL(0); } pvsm_block<2, DO_PV, DO_SM>(o[2], va, pw, p0, p1, m_run, ps, pn);
    if (DO_PV) { pv_read<3>(va, voff); ATT_WL(0); } pvsm_block<3, DO_PV, DO_SM>(o[3], va, pw, p0, p1, m_run, ps, pn);
    if (DO_PV) { pv_read<4>(va, voff); ATT_WL(0); } pvsm_block<4, DO_PV, DO_SM>(o[4], va, pw, p0, p1, m_run, ps, pn);
    if (DO_PV) { pv_read<5>(va, voff); ATT_WL(0); } pvsm_block<5, DO_PV, DO_SM>(o[5], va, pw, p0, p1, m_run, ps, pn);
    if (DO_PV) { pv_read<6>(va, voff); ATT_WL(0); } pvsm_block<6, DO_PV, DO_SM>(o[6], va, pw, p0, p1, m_run, ps, pn);
    if (DO_PV) { pv_read<7>(va, voff); ATT_WL(0); } pvsm_block<7, DO_PV, DO_SM>(o[7], va, pw, p0, p1, m_run, ps, pn);
#endif
}
__device__ __forceinline__ float qk_max(f32x16& p0, f32x16& p1, const LAS unsigned char* Kst, const bf16x8 (&qr)[8], bool meta_tile) {
    p0 = (f32x16){0.f, 0.f, 0.f, 0.f, 0.f, 0.f, 0.f, 0.f, 0.f, 0.f, 0.f, 0.f, 0.f, 0.f, 0.f, 0.f}; p1 = p0;
    {   const int kb = (int)(unsigned)(uintptr_t)Kst;
        bf16x8 ka[4], kc[4];
        k_read<0>(ka, kb); ATT_WL(0);
        k_read<1>(kc, kb); qk_mma<0>(p0, p1, ka, qr); ATT_WL(0);
        k_read<2>(ka, kb); qk_mma<1>(p0, p1, kc, qr); ATT_WL(0);
        k_read<3>(kc, kb); qk_mma<2>(p0, p1, ka, qr); ATT_WL(0);
        qk_mma<3>(p0, p1, kc, qr);
    }
    if (meta_tile) {
#pragma unroll
        for (int r = 8; r < 16; ++r) p0[r] = -INFINITY;
#pragma unroll
        for (int r = 0; r < 16; ++r) p1[r] = -INFINITY;
    }
    float rm = fmaxf(fmaxf(p0[0], p0[1]), p0[2]);
#pragma unroll
    for (int r = 3; r < 15; r += 2) rm = fmaxf(fmaxf(rm, p0[r]), p0[r + 1]);
    rm = fmaxf(rm, p0[15]);
#pragma unroll
    for (int r = 0; r < 16; r += 2) rm = fmaxf(fmaxf(rm, p1[r]), p1[r + 1]);
    return fmaxf(rm, xch32(rm));
}
__device__ __forceinline__ void qk_sm(f32x16 (&o)[8], float& m_run, float& l_run, u32x4 (&pw)[4], const LAS unsigned char* Kst, const bf16x8 (&qr)[8], bool meta_tile) {
    f32x16 p0 = (f32x16){0.f, 0.f, 0.f, 0.f, 0.f, 0.f, 0.f, 0.f, 0.f, 0.f, 0.f, 0.f, 0.f, 0.f, 0.f, 0.f}, p1 = p0;
    {
        const int kb = (int)(unsigned)(uintptr_t)Kst;
        bf16x8 ka[4], kc[4];
        k_read<0>(ka, kb); ATT_WL(0);
        k_read<1>(kc, kb); qk_mma<0>(p0, p1, ka, qr); ATT_WL(0);
        k_read<2>(ka, kb); qk_mma<1>(p0, p1, kc, qr); ATT_WL(0);
        k_read<3>(kc, kb); qk_mma<2>(p0, p1, ka, qr); ATT_WL(0);
        qk_mma<3>(p0, p1, kc, qr);
    }
    if (ATT_PROBE == 2) {
        asm volatile("" : "+v"(p0), "+v"(p1));
        p0 = (f32x16){0.f, 0.f, 0.f, 0.f, 0.f, 0.f, 0.f, 0.f, 0.f, 0.f, 0.f, 0.f, 0.f, 0.f, 0.f, 0.f}; p1 = p0;
#pragma unroll
        for (int d0 = 0; d0 < 8; ++d0) {
            const bf16x8 a0 = *(const LAS bf16x8*)(Kst + d0 * 2048), a1 = *(const LAS bf16x8*)(Kst + d0 * 2048 + 512);
            p0 = __builtin_amdgcn_mfma_f32_32x32x16_bf16(a0, qr[d0], p0, 0, 0, 0);
            p1 = __builtin_amdgcn_mfma_f32_32x32x16_bf16(a1, qr[d0], p1, 0, 0, 0);
        }
    }
    if (meta_tile) {
#pragma unroll
        for (int r = 8; r < 16; ++r) p0[r] = -INFINITY;
#pragma unroll
        for (int r = 0; r < 16; ++r) p1[r] = -INFINITY;
    }
    float rm = fmaxf(fmaxf(p0[0], p0[1]), p0[2]);
#pragma unroll
    for (int r = 3; r < 15; r += 2) rm = fmaxf(fmaxf(rm, p0[r]), p0[r + 1]);
    rm = fmaxf(rm, p0[15]);
#pragma unroll
    for (int r = 0; r < 16; r += 2) rm = fmaxf(fmaxf(rm, p1[r]), p1[r + 1]);
    rm = fmaxf(rm, xch32(rm));
    if (__any(rm > m_run + THRL)) {
        const float mn = fmaxf(m_run, rm), alpha = __builtin_amdgcn_exp2f(m_run - mn);
        m_run = mn; l_run *= alpha;
#pragma unroll
        for (int d = 0; d < 8; ++d)
#pragma unroll
            for (int r = 0; r < 16; ++r) o[d][r] *= alpha;
    }
    float ps = 0.f;
#pragma unroll
    for (int r = 0; r < 16; ++r) { float xx = p0[r] - m_run; p0[r] = __builtin_amdgcn_exp2f(xx); if (ATT_PROBE == 3) { asm volatile("" : "+v"(xx)); p0[r] = (p0[r] + __builtin_amdgcn_exp2f(xx)) * 0.5f; } ps += p0[r]; }
#pragma unroll
    for (int r = 0; r < 16; ++r) { float xx = p1[r] - m_run; p1[r] = __builtin_amdgcn_exp2f(xx); if (ATT_PROBE == 3) { asm volatile("" : "+v"(xx)); p1[r] = (p1[r] + __builtin_amdgcn_exp2f(xx)) * 0.5f; } ps += p1[r]; }
    l_run += ps;
    pw[0] = (u32x4){pk2(p0[0], p0[1]), pk2(p0[2], p0[3]), pk2(p0[4], p0[5]), pk2(p0[6], p0[7])};
    pw[1] = (u32x4){pk2(p0[8], p0[9]), pk2(p0[10], p0[11]), pk2(p0[12], p0[13]), pk2(p0[14], p0[15])};
    pw[2] = (u32x4){pk2(p1[0], p1[1]), pk2(p1[2], p1[3]), pk2(p1[4], p1[5]), pk2(p1[6], p1[7])};
    pw[3] = (u32x4){pk2(p1[8], p1[9]), pk2(p1[10], p1[11]), pk2(p1[12], p1[13]), pk2(p1[14], p1[15])};
}
__device__ __forceinline__ void attn_unit(const Frame& F, const bf16_t* Q, const unsigned char* Kimg, const unsigned char* Vimg, const bf16_t* Gt, bf16_t* O,
                                          const float* subln_g, int b, int h, int qb, int desc) {
    LAS unsigned char* lds = F.lds;
    int lane_o = lane_id();
    const int lane = lane_o, r32 = lane & 31, hi = lane >> 5, wid = F.wave, mp = wid >> 2, rg = wid & 3;
    const bool meta = qb < 0;
    const size_t qrow = meta ? (size_t)(MREAL + (r32 & 15)) : (size_t)b * SEQ + qb * 128 + rg * 32 + r32;
    const int NT = meta ? 1 : 2 * qb + 3;
    const int tmax = meta ? 0 : 2 * qb + 1 + (rg >> 1);
    bf16x8 qr[8];
    { const bf16_t* qp = Q + qrow * DM + h * 256 + mp * 128 + hi * 8;
#pragma unroll
      for (int d0 = 0; d0 < 8; ++d0) qr[d0] = *(const bf16x8*)(qp + 16 * d0); }
    const int bsel = meta ? 0 : b;
    const unsigned char* srcK = Kimg + ((size_t)((bsel * NH + h) * 2 + mp) * NTILE) * KTILE_B + rg * 4096;
    const unsigned char* srcV = Vimg + ((size_t)(bsel * NH + h) * NTILE) * VTILE_B + wid * 4096;
    const unsigned laneoff = (unsigned)lane * 16u;
#define ATT_TILE(k) (desc ? NT - 1 - (k) : (k))
#define ATT_DMA_K(k) do { const int _tl = ATT_TILE(k); _Pragma("unroll") for (int _i = 0; _i < (ATT_PROBE == 1 ? 8 : 4); ++_i) \
        __builtin_amdgcn_global_load_lds((const unsigned*)(srcK + (size_t)_tl * KTILE_B + (_i & 3) * 1024 + laneoff), (LAS unsigned*)(lds + ((k) & 1) * 32768 + wid * 4096 + (_i & 3) * 1024), 16, 0, 0); } while (0)
#define ATT_DMA_V(k) do { const int _tl = ATT_TILE(k); _Pragma("unroll") for (int _i = 0; _i < (ATT_PROBE == 1 ? 8 : 4); ++_i) \
        __builtin_amdgcn_global_load_lds((const unsigned*)(srcV + (size_t)_tl * VTILE_B + (_i & 3) * 1024 + laneoff), (LAS unsigned*)(lds + 65536 + ((k) & 1) * 32768 + wid * 4096 + (_i & 3) * 1024), 16, 0, 0); } while (0)
#define ATT_WAITBAR(n) do { if (ATT_PROBE == 1 && n == 4) asm volatile("s_waitcnt vmcnt(8)" ::: "memory"); else asm volatile("s_waitcnt vmcnt(" #n ")" ::: "memory"); __builtin_amdgcn_s_barrier(); asm volatile("" ::: "memory"); } while (0)
    f32x16 o[8];
#pragma unroll
    for (int d = 0; d < 8; ++d) o[d] = (f32x16){0.f, 0.f, 0.f, 0.f, 0.f, 0.f, 0.f, 0.f, 0.f, 0.f, 0.f, 0.f, 0.f, 0.f, 0.f, 0.f};
    float m_run = -1e30f, l_run = 0.f;
    u32x4 pw[4] = {{0u, 0u, 0u, 0u}, {0u, 0u, 0u, 0u}, {0u, 0u, 0u, 0u}, {0u, 0u, 0u, 0u}};
    int vsw[4];
#pragma unroll
    for (int sx = 0; sx < 4; ++sx) vsw[sx] = r32 * 128 + (((2 * sx + hi) ^ ((r32 >> 1) & 7)) * 16);
    const int kbase = mp * KTILE_B + hi * 1024 + r32 * 16;
#if ATT_PIPE
    f32x16 p0, p1; u32x4 pn[4];
    int voff[4];
#pragma unroll
    for (int sx = 0; sx < 4; ++sx) voff[sx] = (int)(unsigned)(uintptr_t)(lds + 65536 + 32768) + vsw[sx];
    ATT_DMA_K(0);
    {
        ATT_WAITBAR(0);
        if (1 < NT) ATT_DMA_K(1);
        ATT_DMA_V(0);
        float ps = 0.f;
        m_run = qk_max(p0, p1, lds + kbase, qr, true);
        pv_sm<false, true>(o, voff, pw, p0, p1, m_run, ps, pn);
        l_run = ps;
#pragma unroll
        for (int i = 0; i < 4; ++i) pw[i] = pn[i];
    }
    for (int t = 1; t < NT; ++t) {
        ATT_WAITBAR(0);
        if (t + 1 < NT) ATT_DMA_K(t + 1);
        ATT_DMA_V(t);
#pragma unroll
        for (int sx = 0; sx < 4; ++sx) voff[sx] ^= 32768;
        if (t <= tmax) {
            float ps = 0.f;
            const float rm = qk_max(p0, p1, lds + (t & 1) * 32768 + kbase, qr, false);
            if (__any(rm > m_run + THRL)) {
                const float mn = fmaxf(m_run, rm), alpha = __builtin_amdgcn_exp2f(m_run - mn);
                m_run = mn; l_run *= alpha;
#pragma unroll
                for (int d = 0; d < 8; ++d)
#pragma unroll
                    for (int r = 0; r < 16; ++r) o[d][r] *= alpha;
#pragma unroll
                for (int i = 0; i < 4; ++i)
#pragma unroll
                    for (int j = 0; j < 4; ++j) pw[i][j] = pk2(bflo(pw[i][j]) * alpha, bfhi(pw[i][j]) * alpha);
            }
            pv_sm<true, true>(o, voff, pw, p0, p1, m_run, ps, pn);
            l_run += ps;
#pragma unroll
            for (int i = 0; i < 4; ++i) pw[i] = pn[i];
        }
    }
    {
        ATT_WAITBAR(0);
        if (tmax == NT - 1) {
#pragma unroll
            for (int sx = 0; sx < 4; ++sx) voff[sx] ^= 32768;
        }
        float ps = 0.f;
        pv_sm<true, false>(o, voff, pw, p0, p1, m_run, ps, pn);
    }
#else
    ATT_DMA_K(0); ATT_DMA_V(0);
#define ATT_VADDR(tt) ((int)(unsigned)(uintptr_t)(lds + 65536 + ((tt) & 1) * 32768))
    if (mp == 0 || !ATT_STAGGER) {
        for (int t = 0; t < NT; ++t) {
            const int tl = ATT_TILE(t);
            ATT_WAITBAR(4);
            if (t + 1 < NT) ATT_DMA_K(t + 1);
            if (tl <= tmax) qk_sm(o, m_run, l_run, pw, lds + (t & 1) * 32768 + kbase, qr, tl == 0);
            if (t + 1 < NT) { ATT_WAITBAR(4); ATT_DMA_V(t + 1); } else ATT_WAITBAR(0);
            if (tl <= tmax) pv_all(o, ATT_VADDR(t), vsw, pw);
        }
        ATT_WAITBAR(0);
    } else {
        for (int t = 0; t < NT; ++t) {
            const int tl = ATT_TILE(t);
            ATT_WAITBAR(4);
            if (t >= 1 && ATT_TILE(t - 1) <= tmax) pv_all(o, ATT_VADDR(t - 1), vsw, pw);
            if (t + 1 < NT) ATT_DMA_K(t + 1);
            if (t + 1 < NT) ATT_WAITBAR(4); else ATT_WAITBAR(0);
            if (tl <= tmax) qk_sm(o, m_run, l_run, pw, lds + (t & 1) * 32768 + kbase, qr, tl == 0);
            if (t + 1 < NT) ATT_DMA_V(t + 1);
        }
        ATT_WAITBAR(0);
        if (ATT_TILE(NT - 1) <= tmax) pv_all(o, ATT_VADDR(NT - 1), vsw, pw);
    }
#undef ATT_VADDR
#endif
    asm volatile("s_waitcnt vmcnt(0) lgkmcnt(0)" ::: "memory"); __builtin_amdgcn_s_barrier(); asm volatile("" ::: "memory");
    const float ltot = l_run + xch32(l_run);
    const float inv = __builtin_amdgcn_rcpf(ltot);
    LAS float* xb = (LAS float*)lds + (size_t)rg * 8192;
    if (mp == 1) {
        const float sc = *(const LAS float*)(lds + MISC_OFF + 64) * inv;
#pragma unroll
        for (int d = 0; d < 8; ++d) {
#pragma unroll
            for (int r = 0; r < 16; ++r) xb[(d * 16 + r) * 64 + lane] = o[d][r] * sc;
            asm volatile("" ::: "memory"); }
    }
    asm volatile("s_waitcnt lgkmcnt(0)" ::: "memory"); __builtin_amdgcn_s_barrier(); asm volatile("" ::: "memory");
    if (mp == 0) {
        float ss = 0.f;
#pragma unroll
        for (int d = 0; d < 8; ++d) {
#pragma unroll
            for (int r = 0; r < 16; ++r) { const float v = o[d][r] * inv - xb[(d * 16 + r) * 64 + lane]; o[d][r] = v; ss = fmaf(v, v, ss); }
            asm volatile("" : "+v"(ss) :: "memory"); }
        ss += xch32(ss);
        const float rstd = __builtin_amdgcn_rsqf(ss * (1.0f / 256.0f) + RMS_EPS) * 0.8f;
        const bool valid = !meta || r32 < 16;
        const size_t qrow2 = meta ? (size_t)(MREAL + (r32 & 15)) : (size_t)b * SEQ + qb * 128 + rg * 32 + r32;
        const bf16_t* gp = Gt + qrow2 * DM + h * 256; bf16_t* op = O + qrow2 * DM + h * 256;
#pragma unroll
        for (int d = 0; d < 8; ++d)
#pragma unroll
            for (int rq = 0; rq < 4; ++rq) {
                const int dd = 32 * d + 8 * rq + 4 * hi;
                const u32x2 g = *(const u32x2*)(gp + dd); const f32x4 sg = *(const f32x4*)(subln_g + dd);
                const float v0 = o[d][4 * rq + 0] * rstd * sg[0] * bflo(g.x), v1 = o[d][4 * rq + 1] * rstd * sg[1] * bfhi(g.x);
                const float v2 = o[d][4 * rq + 2] * rstd * sg[2] * bflo(g.y), v3 = o[d][4 * rq + 3] * rstd * sg[3] * bfhi(g.y);
                u32x2 w; w.x = pk2(v0, v1); w.y = pk2(v2, v3);
                if (valid) *(u32x2*)(op + dd) = w;
                asm volatile("" ::: "memory");
            }
    }
    asm volatile("s_waitcnt vmcnt(0) lgkmcnt(0)" ::: "memory"); __builtin_amdgcn_s_barrier(); asm volatile("" ::: "memory");
#undef ATT_TILE
#undef ATT_DMA_K
#undef ATT_DMA_V
#undef ATT_WAITBAR
}
#undef ATT_WL
}

__global__ void __launch_bounds__(512, 2) trunk_fwd(Args args) {
    extern __shared__ __attribute__((aligned(16))) unsigned char lds_raw[];
    Frame F;
    F.lds = (LAS unsigned char*)lds_raw;
    F.wave = __builtin_amdgcn_readfirstlane((int)threadIdx.x >> 6);
    F.G = gridDim.x; { const int bx = blockIdx.x; F.vcu = (F.G % 8 == 0) ? (bx % 8) * (F.G / 8) + bx / 8 : bx; }
    volatile LAS unsigned* MISC = (volatile LAS unsigned*)(F.lds + MISC_OFF);
    unsigned char* ws = args.ws;
    gu32* ctl = (gu32*)(ws + WS_CTL);
    for (int u = F.wave * 64 + lane_id(); u < (LDS_BYTES - LDSCTL_OFF) / 4; u += 512) ((LAS unsigned*)(F.lds + LDSCTL_OFF))[u] = 0u;
    __syncthreads();
    XcdBarrier bar; bar.bar = (unsigned*)(ctl + CW_BAR); bar.x = 0; bar.st = nullptr; bar.leader = false;
    if (MK_N_LAUNCHES == 1) bar = xcd_barrier_post((unsigned*)(ctl + CW_BAR), MISC + 8, F.wave == 0);
#define GRID_BAR() do { if (MK_N_LAUNCHES == 1) xcd_barrier(bar); } while (0)
    const int lo = args.ph_lo, hi = args.ph_hi;
#define IN(k) (lo <= (k) && (k) < hi)
#define REPS(k) for (int rep_ = 0; rep_ < ((k) == PROBE_PH ? 1 + PROBE_REP : 1); ++rep_)

    const float* x = args.in[0]; const float* meta_tok = args.in[1]; const float* pre_g = args.in[2]; const float* post_g = args.in[3];
    const float* attn_w_in = args.in[4]; const float* attn_w_out = args.in[5];
    const float* lq1 = args.in[6]; const float* lk1 = args.in[7]; const float* lq2 = args.in[8]; const float* lk2 = args.in[9];
    const float* subln_g = args.in[10];
    const float* pool_w_in = args.in[11]; const float* pool_w_group = args.in[12]; const float* pool_scale = args.in[13]; const float* pool_w_out = args.in[14];
    bf16_t* W1 = (bf16_t*)(ws + WS_W1); bf16_t* W2 = (bf16_t*)(ws + WS_W2); bf16_t* W3 = (bf16_t*)(ws + WS_W3); bf16_t* W4 = (bf16_t*)(ws + WS_W4); bf16_t* W5 = (bf16_t*)(ws + WS_W5);
    bf16_t* XN = (bf16_t*)(ws + WS_XN); bf16_t* GB = (bf16_t*)(ws + WS_G); bf16_t* QO = (bf16_t*)(ws + WS_QO);
    unsigned char* Kimg = ws + WS_K; unsigned char* Vimg = ws + WS_V;
    bf16_t* Y0 = (bf16_t*)(ws + WS_Y0); bf16_t* Y1 = (bf16_t*)(ws + WS_Y1);
    bf16_t* UB = (bf16_t*)(ws + WS_U); bf16_t* G1 = (bf16_t*)(ws + WS_G1); bf16_t* MIX = (bf16_t*)(ws + WS_MIX); bf16_t* GATED1 = (bf16_t*)(ws + WS_GATED1);
    float* ropec = (float*)(ws + WS_ROPEC); float* ropes = (float*)(ws + WS_ROPES); float* rstd0 = (float*)(ws + WS_RSTD0);
    const int gw = F.vcu * 8 + F.wave, NGW = F.G * 8;
    const int NGT = F.G * 512;
#define gtid (F.vcu * 512 + F.wave * 64 + lane_id())

    Epi E; E.mode = 0; E.Q = QO; E.Kimg = Kimg; E.Vimg = Vimg; E.G = GB; E.ropec = ropec; E.ropes = ropes; E.Y = Y0; E.U = UB; E.G1 = G1; E.GATED1 = GATED1; E.pool_scale = pool_scale;

    if (IN(0)) REPS(0) {
        LAS float* scr = (LAS float*)(F.lds + F.wave * 16384);
        constexpr int I1 = (DM / 64) * (4 * DM / 32), I2 = (DM / 64) * (DM / 32), I3 = (DM / 64) * (2 * DM / 32), I4 = (512 / 64) * (512 / 32), I5 = I2;
        constexpr int NITEMS = I1 + I2 + I3 + 4 * I4 + I5;
        auto decode = [&](int it) -> P0Item {
            const float* W; bf16_t* WT; int N, ldt, row_off = 0, r = it;
            if (r < I1) { W = attn_w_in; N = 4 * DM; WT = W1; ldt = DM; }
            else if ((r -= I1) < I2) { W = attn_w_out; N = DM; WT = W2; ldt = DM; }
            else if ((r -= I2) < I3) { W = pool_w_in; N = 2 * DM; WT = W3; ldt = DM; }
            else if ((r -= I3) < 4 * I4) { const int g = r / I4; r -= g * I4; W = pool_w_group + (size_t)g * 512 * 512; N = 512; WT = W4; ldt = 512; row_off = g * 512; }
            else { r -= 4 * I4; W = pool_w_out; N = DM; WT = W5; ldt = DM; }
            const int nblk = N / 32, k0 = 64 * (r / nblk), n0 = 32 * (r % nblk);
            return P0Item{W + (size_t)k0 * N + n0, WT + (size_t)(row_off + n0) * ldt + k0, N, ldt};
        };
        {
            const int ln = lane_id();
            int it = gw; f32x4 cur[8], nxt[8]; P0Item ci{}, ni{};
            if (it < NITEMS) { ci = decode(it); p0_item_load(ci, ln, cur); }
            for (; it < NITEMS; it += NGW) {
                const bool more = it + NGW < NITEMS;
                if (more) { ni = decode(it + NGW); p0_item_load(ni, ln, nxt); }
                p0_item_store(ci, ln, cur, scr);
                if (more) { ci = ni;
#pragma unroll
                    for (int i = 0; i < 8; ++i) cur[i] = nxt[i]; }
            }
        }
        for (int i = gtid; i < LTOT * 16; i += NGT) {
            const int pos = i >> 4, k = i & 15; const float ang = (float)pos * args.inv_freq[k];
            double rev = (double)ang * 0.15915494309189535; rev -= floor(rev);
            const float fr = (float)rev; ropec[i] = __builtin_amdgcn_cosf(fr); ropes[i] = __builtin_amdgcn_sinf(fr);
        }
        for (int m = gw; m < MROWS; m += NGW) {
            const float* src = m < MREAL ? x + (size_t)m * DM : meta_tok + (size_t)(m - MREAL) * DM;
            f32x4 v[8]; load_row(src, lane_id(), v);
            const float rstd = __builtin_amdgcn_rsqf(row_ss(v) * (1.0f / DM) + RMS_EPS);
#pragma unroll
            for (int j = 0; j < 8; ++j) v[j] = v[j] * rstd * *(const f32x4*)(pre_g + 4 * (64 * j + lane_id()));
            store_row_bf16(XN + (size_t)m * DM, lane_id(), v);
        }
        const u32x4 z = {0u, 0u, 0u, 0u};
        for (int i = gtid; i < NB * NH * 2 * 1024; i += NGT) *(u32x4*)(Kimg + (size_t)(i >> 10) * NTILE * KTILE_B + (i & 1023) * 16) = z;
        for (int i = gtid; i < NB * NH * 2048; i += NGT) *(u32x4*)(Vimg + (size_t)(i >> 11) * NTILE * VTILE_B + (i & 2047) * 16) = z;
        GRID_BAR();
    }
    if (IN(1)) REPS(1) {
        E.mode = 1;
        rows16_phase(F, XN + (size_t)MREAL * DM, DM, W1, DM, DM, 4 * DM / 32, 0, 1 << 30, E);
        { pg8::Gemm g{XN, W1, MREAL, 3 * DM, DM, DM, DM, 1 << 30, 0}; pg8::StaticOrder S; S.init(MREAL, 3 * DM, F.G, (int)blockIdx.x); S.skip_from = 16; S.skip_n = 8;
          pg8::gemm_phase<true>(F.lds, g, S, E, F.wave); }
        { E.mode = 6;
          pg8::Gemm g{W1 + (size_t)2 * DM * DM, XN, DM, MREAL, DM, DM, DM, 1 << 30, 0}; pg8::StaticOrder S; S.init(DM, MREAL, F.G, (int)blockIdx.x);
          pg8::gemm_phase<true>(F.lds, g, S, E, F.wave); }
        GRID_BAR();
    }
    if (IN(2)) REPS(2) {
        float d1 = 0.f, d2 = 0.f;
#pragma unroll
        for (int j = 0; j < 2; ++j) { d1 += lq1[lane_id() + 64 * j] * lk1[lane_id() + 64 * j]; d2 += lq2[lane_id() + 64 * j] * lk2[lane_id() + 64 * j]; }
        const float lam = expf(wave_sum(d1)) - expf(wave_sum(d2)) + 0.2f;
        if (F.wave == 0 && lane_id() == 0) *(LAS float*)(F.lds + MISC_OFF + 64) = lam;
        __syncthreads();
        if (ATT_STATICPRIO && F.wave >= 4) __builtin_amdgcn_s_setprio(1);
        const bool g256 = false && F.G == 256; const int xg = F.vcu >> 5, li = F.vcu & 31;
        for (int r = 0; g256 ? r < 3 : F.vcu + r * F.G < 520; ++r) {
            int bh, qb, desc;
            if (g256) { if (r == 2 && li != 0) break; bh = r == 2 ? xg : 2 * xg + r; qb = r == 0 ? li : (r == 1 ? 31 - li : -1); desc = r == 1; }
            else { const int u = F.vcu + r * F.G; desc = 0; if (u < 256) { bh = u >> 4; qb = u & 15; } else if (u < 512) { bh = (u - 256) >> 4; qb = 31 - ((u - 256) & 15); } else { bh = u - 512; qb = -1; } }
            att::attn_unit(F, QO, Kimg, Vimg, GB, XN, subln_g, bh >> 3, bh & 7, qb, desc);
        }
        if (ATT_STATICPRIO) __builtin_amdgcn_s_setprio(0);
        GRID_BAR();
    }
    if (IN(3)) REPS(3) {
        E.mode = 2; E.Y = Y0;
        rows16_phase(F, XN + (size_t)MREAL * DM, DM, W2, DM, DM, DM / 32, 0, 1 << 30, E);
        pg8::Gemm g{XN, W2, MREAL, DM, DM, DM, DM, 1 << 30, 0}; pg8::StaticOrder S; S.init(MREAL, DM, F.G, (int)blockIdx.x);
        pg8::gemm_phase<true>(F.lds, g, S, E, F.wave);
        GRID_BAR();
    }
    if (IN(4)) REPS(4) {
        for (int m = gw; m < MROWS; m += 2 * NGW) {
            const int mb = (m + NGW < MROWS) ? m + NGW : m;
            f32x4 ya[8], ha[8], yb[8], hb[8];
            load_row_bf16(Y0 + (size_t)m * DM, lane_id(), ya); load_row_bf16(Y0 + (size_t)mb * DM, lane_id(), yb);
            load_row(m < MREAL ? x + (size_t)m * DM : meta_tok + (size_t)(m - MREAL) * DM, lane_id(), ha);
            load_row(mb < MREAL ? x + (size_t)mb * DM : meta_tok + (size_t)(mb - MREAL) * DM, lane_id(), hb);
            float sa, sb; row_ss2(ya, yb, sa, sb);
            const float ra0 = __builtin_amdgcn_rsqf(sa * (1.0f / DM) + RMS_EPS), rb0 = __builtin_amdgcn_rsqf(sb * (1.0f / DM) + RMS_EPS);
            if (lane_id() == 0) { rstd0[m] = ra0; rstd0[mb] = rb0; }
#pragma unroll
            for (int j = 0; j < 8; ++j) { const f32x4 gp = *(const f32x4*)(post_g + 4 * (64 * j + lane_id())); ha[j] = ha[j] + ya[j] * ra0 * gp; hb[j] = hb[j] + yb[j] * rb0 * gp; }
            row_ss2(ha, hb, sa, sb);
            const float ra1 = __builtin_amdgcn_rsqf(sa * (1.0f / DM) + RMS_EPS), rb1 = __builtin_amdgcn_rsqf(sb * (1.0f / DM) + RMS_EPS);
#pragma unroll
            for (int j = 0; j < 8; ++j) { const f32x4 gq = *(const f32x4*)(pre_g + DM + 4 * (64 * j + lane_id())); ha[j] = ha[j] * ra1 * gq; hb[j] = hb[j] * rb1 * gq; }
            store_row_bf16(XN + (size_t)m * DM, lane_id(), ha);
            if (mb != m) store_row_bf16(XN + (size_t)mb * DM, lane_id(), hb);
        }
        GRID_BAR();
    }
    if (IN(5)) REPS(5) {
        E.mode = 3;
        rows16_phase(F, XN + (size_t)MREAL * DM, DM, W3, DM, DM, DM / 32, 0, 1 << 30, E);
        pg8::Gemm g{XN, W3, MREAL, 2 * DM, DM, DM, DM, 1 << 30, 0}; pg8::StaticOrder S; S.init(MREAL, 2 * DM, F.G, (int)blockIdx.x);
        pg8::gemm_phase<true>(F.lds, g, S, E, F.wave);
        GRID_BAR();
    }
    if (IN(6)) REPS(6) {
        for (int idx = gtid; idx < (MREAL / 16) * 256; idx += NGT) {
            const int strip = idx >> 8, c0 = (idx & 255) * 8, gi = c0 >> 9;
            if (gi == 0) mix_strip<2>(UB, MIX, strip, c0); else if (gi == 1) mix_strip<4>(UB, MIX, strip, c0);
            else if (gi == 2) mix_strip<8>(UB, MIX, strip, c0); else mix_strip<16>(UB, MIX, strip, c0);
        }
        GRID_BAR();
    }
    if (IN(7)) REPS(7) {
        E.mode = 4;
        pg8::Gemm g{MIX, W4, MREAL, DM, 512, DM, 512, 2, 512}; pg8::StaticOrder S; S.init(MREAL, DM, F.G, (int)blockIdx.x);
        pg8::gemm_phase<true>(F.lds, g, S, E, F.wave);
        GRID_BAR();
    }
    if (IN(8)) REPS(8) {
        E.mode = 5; E.Y = Y1;
        pg8::Gemm g{GATED1, W5, MREAL, DM, DM, DM, DM, 1 << 30, 0}; pg8::StaticOrder S; S.init(MREAL, DM, F.G, (int)blockIdx.x);
        pg8::gemm_phase<true>(F.lds, g, S, E, F.wave);
        GRID_BAR();
    }
    if (IN(9)) REPS(9) {
        for (int m = gw; m < MREAL; m += NGW) {
            f32x4 y1[8], acc[8]; load_row_bf16(Y1 + (size_t)m * DM, lane_id(), y1); load_row(x + (size_t)m * DM, lane_id(), acc);
            const float r0 = rstd0[m];
            const float r1 = __builtin_amdgcn_rsqf(row_ss(y1) * (1.0f / DM) + RMS_EPS);
#pragma unroll
            for (int j = 0; j < 8; ++j) {
                const int e = 4 * (64 * j + lane_id());
                const u32x2 y0w = *(const u32x2*)(Y0 + (size_t)m * DM + e); const f32x4 y0 = {bflo(y0w.x), bfhi(y0w.x), bflo(y0w.y), bfhi(y0w.y)};
                acc[j] = acc[j] + y0 * r0 * *(const f32x4*)(post_g + e) + y1[j] * r1 * *(const f32x4*)(post_g + DM + e);
                *(f32x4*)(args.out + (size_t)m * DM + e) = acc[j];
            }
        }
    }
#undef gtid
#undef IN
#undef GRID_BAR
}

extern "C" void kernel_launch(void* const* d_in, const int* in_sizes, int n_in, void* d_out, int out_size, void* d_ws, size_t ws_size, hipStream_t stream) {
    static int grid = 0;
    if (grid == 0) {
        if (n_in != 15 || in_sizes[0] != NB * SEQ * DM || out_size != NB * SEQ * DM || ws_size < WS_END) {
            fprintf(stderr, "kernel_launch: unexpected shapes (n_in %d, in0 %d, out %d, ws %zu)\n", n_in, n_in > 0 ? in_sizes[0] : -1, out_size, ws_size); grid = -1; return; }
        int dev = 0, cus = 0, per_cu = 0;
        if (hipGetDevice(&dev) != hipSuccess || hipDeviceGetAttribute(&cus, hipDeviceAttributeMultiprocessorCount, dev) != hipSuccess) { grid = -1; return; }
        if (hipFuncSetAttribute((const void*)trunk_fwd, hipFuncAttributeMaxDynamicSharedMemorySize, LDS_BYTES) != hipSuccess) { fprintf(stderr, "kernel_launch: hipFuncSetAttribute failed\n"); grid = -1; return; }
        if (hipOccupancyMaxActiveBlocksPerMultiprocessor(&per_cu, (const void*)trunk_fwd, 512, LDS_BYTES) != hipSuccess || per_cu < 1) {
            fprintf(stderr, "kernel_launch: occupancy query reports %d workgroups per CU\n", per_cu); (void)hipGetLastError(); grid = -1; return; }
        grid = cus;
    }
    if (grid < 0) return;
    (void)hipMemsetAsync((char*)d_ws + WS_CTL, 0, CTL_ZERO_BYTES, stream);
    Args a{};
    for (int i = 0; i < 15; ++i) a.in[i] = (const float*)d_in[i];
    a.out = (float*)d_out; a.ws = (unsigned char*)d_ws;
    for (int i = 0; i < 16; ++i) a.inv_freq[i] = (float)pow(500000.0, -(double)i / 16.0);
#if MK_N_LAUNCHES == 1
    a.ph_lo = 0; a.ph_hi = 10; a.li = 0;
    hipLaunchKernelGGL(trunk_fwd, dim3(grid), dim3(512), LDS_BYTES, stream, a);
#else
    for (int p = 0; p < 10; ++p) { a.ph_lo = p; a.ph_hi = p + 1; a.li = p; hipLaunchKernelGGL(trunk_fwd, dim3(grid), dim3(512), LDS_BYTES, stream, a); }
#endif
    const hipError_t le = hipPeekAtLastError();
    if (le != hipSuccess) fprintf(stderr, "kernel_launch: launch failed: %s\n", hipGetErrorName(le));
}
```

```cpp
#include <hip/hip_runtime.h>
#include <cstdio>
#include <cstdint>
#include <cmath>

#ifndef MK_N_LAUNCHES
#define MK_N_LAUNCHES 1
#endif
#ifndef PROBE_PH
#define PROBE_PH (-1)
#endif
#ifndef PROBE_REP
#define PROBE_REP 0
#endif

#define LAS __attribute__((address_space(3)))
#define GAS __attribute__((address_space(1)))
typedef unsigned short bf16_t;
typedef short bf16x8 __attribute__((ext_vector_type(8)));
typedef short s16x4 __attribute__((ext_vector_type(4)));
typedef float f32x4 __attribute__((ext_vector_type(4)));
typedef float f32x16 __attribute__((ext_vector_type(16)));
typedef unsigned u32x4 __attribute__((ext_vector_type(4)));
typedef unsigned u32x2 __attribute__((ext_vector_type(2)));

constexpr int DM = 2048, SEQ = 4096, NB = 2, NMETA = 16, LTOT = SEQ + NMETA;
constexpr int MREAL = NB * SEQ;
constexpr int MROWS = MREAL + NMETA;
constexpr int NH = 8, HD = 128, VD = 256;
constexpr int NTILE = 65;
constexpr int KTILE_B = 64 * 128 * 2, VTILE_B = 64 * 256 * 2;
constexpr float RMS_EPS = 1e-6f;
constexpr float C2 = 0.08838834764831845f * 1.4426950408889634f;
constexpr float LOG2E = 1.4426950408889634f;

constexpr size_t MiB = 1u << 20;
constexpr size_t WS_CTL = 0, CTL_ZERO_BYTES = 65536;
constexpr size_t WS_ROPEC = 1 * MiB, WS_ROPES = 1 * MiB + 512 * 1024;
constexpr size_t WS_RSTD0 = 2 * MiB;
constexpr size_t WS_W1 = 4 * MiB, WS_W2 = 36 * MiB, WS_W3 = 44 * MiB, WS_W4 = 60 * MiB, WS_W5 = 62 * MiB;
constexpr size_t WS_XN = 70 * MiB, WS_G = 104 * MiB, WS_QO = 138 * MiB, WS_K = 172 * MiB;
constexpr size_t KIMG_BYTES = (size_t)NB * NH * 2 * NTILE * KTILE_B, VIMG_BYTES = (size_t)NB * NH * NTILE * VTILE_B;
constexpr size_t WS_V = WS_K + KIMG_BYTES;
constexpr size_t WS_Y0 = WS_K;
constexpr size_t WS_U = WS_QO, WS_G1 = WS_G, WS_MIX = WS_XN, WS_GATED1 = WS_QO, WS_Y1 = WS_XN;
constexpr size_t WS_END = WS_V + VIMG_BYTES;
static_assert(WS_END <= 240 * MiB && WS_Y0 + (size_t)MROWS * DM * 2 <= WS_END && WS_Y1 + (size_t)MROWS * DM * 2 <= WS_G, "ws map");
constexpr int CW_BAR = 4096;

constexpr int RING_BYTES = 131072, LDSCTL_OFF = RING_BYTES, MISC_OFF = LDSCTL_OFF + 320, LDS_BYTES = 147456;

__device__ __forceinline__ int lane_id() { int l = (int)__builtin_amdgcn_mbcnt_hi(~0u, __builtin_amdgcn_mbcnt_lo(~0u, 0u)); asm volatile("" : "+v"(l)); return l; }
__device__ __forceinline__ unsigned pk2(float lo, float hi) {
    typedef float f2_t __attribute__((ext_vector_type(2))); typedef __bf16 b2_t __attribute__((ext_vector_type(2)));
    f2_t v = {lo, hi}; b2_t b = __builtin_convertvector(v, b2_t); return __builtin_bit_cast(unsigned, b);
}
__device__ __forceinline__ float bflo(unsigned u) { return __uint_as_float(u << 16); }
__device__ __forceinline__ float bfhi(unsigned u) { return __uint_as_float(u & 0xffff0000u); }
__device__ __forceinline__ float siluf(float x) { return x * __builtin_amdgcn_rcpf(1.0f + __builtin_amdgcn_exp2f(-x * LOG2E)); }
__device__ __forceinline__ float wave_sum(float v) {
#pragma unroll
    for (int o = 1; o < 64; o <<= 1) v += __shfl_xor(v, o);
    return v;
}
__device__ __forceinline__ u32x4 pack8(f32x4 a, f32x4 b) { u32x4 w; w.x = pk2(a[0], a[1]); w.y = pk2(a[2], a[3]); w.z = pk2(b[0], b[1]); w.w = pk2(b[2], b[3]); return w; }

struct Epi {
    int mode;
    bf16_t* Q; unsigned char* Kimg; unsigned char* Vimg; bf16_t* G; const float* ropec; const float* ropes;
    bf16_t* Y;
    bf16_t* U; bf16_t* G1;
    bf16_t* GATED1; const float* pool_scale;
    template <int MODE> __device__ __forceinline__ void emit(int row, int col, f32x4 a, f32x4 b) const {
        if constexpr (MODE == 1) {
            if (col < 4096) {
                const int c = col & 2047, dim = c & 127;
                if (dim < 32) {
                    f32x4 pa, pb;
#pragma unroll
                    for (int i = 0; i < 4; ++i) { pa[i] = __shfl_xor(a[i], 32); pb[i] = __shfl_xor(b[i], 32); }
                    const int pos = row < MREAL ? NMETA + (row & (SEQ - 1)) : row - MREAL;
                    const float* cs = ropec + pos * 16 + (dim & 15); const float* sn = ropes + pos * 16 + (dim & 15);
                    const f32x4 c0 = *(const f32x4*)cs, c1 = *(const f32x4*)(cs + 4), s0 = *(const f32x4*)sn, s1 = *(const f32x4*)(sn + 4);
                    if (dim < 16) { a = a * c0 - pa * s0; b = b * c1 - pb * s1; } else { a = a * c0 + pa * s0; b = b * c1 + pb * s1; }
                }
                if (col < 2048) { a = a * C2; b = b * C2; *(u32x4*)(Q + (size_t)row * DM + c) = pack8(a, b); }
                else {
                    const int h = c >> 8, mp = (c >> 7) & 1; const u32x4 w = pack8(a, b);
                    const size_t inner = (size_t)(dim >> 3) * 1024;
                    if (row < MREAL) { const int bb = row >> 12, j = row & (SEQ - 1), tile = 1 + (j >> 6), key = j & 63;
                        *(u32x4*)(Kimg + ((size_t)((bb * NH + h) * 2 + mp) * NTILE + tile) * KTILE_B + inner + key * 16) = w; }
                    else { const int key = row - MREAL;
#pragma unroll
                        for (int bb = 0; bb < NB; ++bb) *(u32x4*)(Kimg + ((size_t)((bb * NH + h) * 2 + mp) * NTILE) * KTILE_B + inner + key * 16) = w; }
                }
            } else if (col < 6144) {
                const int c = col - 4096, h = c >> 8, d0 = c & 255, key = row - MREAL;
                const int slot = (key & 3) | (((key >> 3) & 1) << 2) | (((key >> 2) & 1) << 3);
                const float vals[8] = {a[0], a[1], a[2], a[3], b[0], b[1], b[2], b[3]};
                if (row >= MREAL) {
#pragma unroll
                    for (int i = 0; i < 8; ++i) { const int d = d0 + i; const unsigned short bv = (unsigned short)(pk2(vals[i], 0.f) & 0xffffu);
                        const size_t off = (size_t)d * 128 + (((slot >> 3) ^ ((d >> 1) & 7)) * 16) + (slot & 7) * 2;
#pragma unroll
                        for (int bb = 0; bb < NB; ++bb) *(unsigned short*)(Vimg + ((size_t)(bb * NH + h) * NTILE) * VTILE_B + off) = bv; }
                }
            } else {
                const int c = col - 6144;
#pragma unroll
                for (int i = 0; i < 4; ++i) { a[i] = siluf(a[i]); b[i] = siluf(b[i]); }
                *(u32x4*)(G + (size_t)row * DM + c) = pack8(a, b);
            }
        } else if constexpr (MODE == 2 || MODE == 5) {
            *(u32x4*)(Y + (size_t)row * DM + col) = pack8(a, b);
        } else if constexpr (MODE == 3) {
            if (col < 2048) { *(u32x4*)(U + (size_t)row * DM + col) = pack8(a, b); }
            else { const int c = col - 2048;
#pragma unroll
                for (int i = 0; i < 4; ++i) { a[i] = siluf(a[i]); b[i] = siluf(b[i]); }
                *(u32x4*)(G1 + (size_t)row * DM + c) = pack8(a, b); }
        } else if constexpr (MODE == 6) {
            const int h = row >> 8, d = row & 255, bb = col >> 12, j = col & (SEQ - 1), tile = 1 + (j >> 6), k0 = j & 63, sidx = k0 >> 4, aa = (k0 >> 3) & 1;
            unsigned char* base = Vimg + ((size_t)(bb * NH + h) * NTILE + tile) * VTILE_B + (size_t)d * 128 + 8 * aa; const int x = (d >> 1) & 7;
            u32x2 w0, w1; w0.x = pk2(a[0], a[1]); w0.y = pk2(a[2], a[3]); w1.x = pk2(b[0], b[1]); w1.y = pk2(b[2], b[3]);
            *(u32x2*)(base + (((2 * sidx) ^ x) * 16)) = w0; *(u32x2*)(base + (((2 * sidx + 1) ^ x) * 16)) = w1;
        } else {
            const f32x4 s0 = *(const f32x4*)(pool_scale + col), s1 = *(const f32x4*)(pool_scale + col + 4);
            const u32x4 g = *(const u32x4*)(G1 + (size_t)row * DM + col);
            a[0] *= s0[0] * bflo(g.x); a[1] *= s0[1] * bfhi(g.x); a[2] *= s0[2] * bflo(g.y); a[3] *= s0[3] * bfhi(g.y);
            b[0] *= s1[0] * bflo(g.z); b[1] *= s1[1] * bfhi(g.z); b[2] *= s1[2] * bflo(g.w); b[3] *= s1[3] * bfhi(g.w);
            *(u32x4*)(GATED1 + (size_t)row * DM + col) = pack8(a, b);
        }
    }
    __device__ __forceinline__ void emit_rt(int row, int col, f32x4 a, f32x4 b) const {
        if (mode == 1) emit<1>(row, col, a, b); else if (mode == 2 || mode == 5) emit<2>(row, col, a, b); else if (mode == 3) emit<3>(row, col, a, b); else if (mode == 6) emit<6>(row, col, a, b); else emit<4>(row, col, a, b);
    }
};

namespace pg8 {
constexpr int BM = 256, BK = 64, HALF = 128, HTB = HALF * BK * 2, STAGE_BYTES = 8 * HTB, NXCD = 8, WGM = 8;
__host__ __device__ __forceinline__ int lds_byte(int r, int c) { const int st = (r >> 4) * 2 + (c >> 5), rr = r & 15, cc = c & 31, ob = rr * 64 + cc * 2; return st * 1024 + (ob ^ (((ob >> 9) & 1) << 5)); }
__host__ __device__ __forceinline__ void stage_rc(int b, int& R, int& C) { const int st = b / 1024, sb = b % 1024, swz = sb ^ (((sb >> 9) & 1) << 5); R = (st >> 1) * 16 + swz / 64; C = (st & 1) * 32 + (swz % 64) / 2; }
__host__ __device__ __forceinline__ int perm32(int rho) { const int n = rho >> 4, i = rho & 15; return 8 * (i >> 2) + 4 * n + (i & 3); }
struct Unit { int pm, pn; };
struct Gemm { const bf16_t* A; const bf16_t* Bt; int M, N, K, lda, ldb, pn_per_grp, a_grp_cols; };
struct StaticOrder {
    int nM, nN, nwg, G, c, skip_from, skip_n;
    __device__ void init(int M, int N, int G_, int c_) { nM = M / BM; nN = N / BM; nwg = nM * nN; G = G_; c = c_; skip_from = 1 << 30; skip_n = 0; }
    __device__ bool next(int i, Unit& u) const {
        const long L = (long)i * G + c; if (L >= nwg) return false;
        int wgid = (int)L; { const int q = nwg / NXCD, r = nwg % NXCD, xcd = wgid % NXCD, off = wgid / NXCD; wgid = (xcd < r ? xcd * (q + 1) : r * (q + 1) + (xcd - r) * q) + off; }
        const int nig = WGM * nN, gid = wgid / nig, fm = gid * WGM, gsz = (nM - fm) < WGM ? (nM - fm) : WGM;
        u.pm = fm + ((wgid % nig) % gsz); u.pn = (wgid % nig) / gsz; if (u.pn >= skip_from) u.pn += skip_n; return true;
    }
};
template <int MODE>
__device__ __forceinline__ void run_epi_m(const Epi& E, const f32x4 (&acc)[2][2][4][2], const Unit& u, int wr, int wc) {
    int lane = lane_id();
    const int fr = lane & 15, fq = lane >> 4;
#pragma unroll
    for (int ai = 0; ai < 2; ++ai)
#pragma unroll
        for (int m = 0; m < 4; ++m) { const int row = u.pm * BM + ai * HALF + wr * 64 + m * 16 + fr;
#pragma unroll
            for (int bj = 0; bj < 2; ++bj) { const int col = u.pn * BM + bj * HALF + wc * 32 + 8 * fq; E.emit<MODE>(row, col, acc[ai][bj][m][0], acc[ai][bj][m][1]); asm volatile("" ::: "memory"); } }
}
__device__ __forceinline__ void run_epi(const Epi& E, const f32x4 (&acc)[2][2][4][2], const Unit& u, int wr, int wc, int fr, int fq) {
    if (E.mode == 1) run_epi_m<1>(E, acc, u, wr, wc); else if (E.mode == 2 || E.mode == 5) run_epi_m<2>(E, acc, u, wr, wc);
    else if (E.mode == 3) run_epi_m<3>(E, acc, u, wr, wc); else if (E.mode == 6) run_epi_m<6>(E, acc, u, wr, wc); else run_epi_m<4>(E, acc, u, wr, wc);
}
template <bool ALIGN_EPI>
__device__ __forceinline__ void gemm_phase(LAS unsigned char* lds, const Gemm g, const StaticOrder& S, const Epi& E, int wave_idx) {
    const int wid = wave_idx, lane = lane_id(), tid = wid * 64 + lane, wr = wid >> 2, wc = wid & 3, fr = lane & 15, fq = lane >> 4;
    const int K = g.K, nt = K / BK;
    unsigned voffA[2], voffB[2];
#pragma unroll
    for (int i = 0; i < 2; ++i) { int R, C; stage_rc(tid * 16 + i * 8192, R, C); const int Rb = (R & ~31) + perm32(R & 31);
        voffA[i] = (unsigned)(R * g.lda + C) * 2u; voffB[i] = (unsigned)(Rb * g.ldb + C) * 2u; }
    const size_t kstep = (size_t)(BK * 2);
    const size_t hstepA = (size_t)HALF * g.lda * 2, hstepB = (size_t)HALF * g.ldb * 2;
    const size_t tstepA = 2 * hstepA, tstepB = 2 * hstepB;
    const unsigned ldsw = (unsigned)wid * 1024u;
    const int aoff = lds_byte(wr * 64 + fr, fq * 8), boff = lds_byte(wc * 32 + fr, fq * 8);
#define PG8_SA(b, h) (((b) * 2 + (h)) * HTB)
#define PG8_SB(b, h) ((4 + (b) * 2 + (h)) * HTB)
#define PG8_STAGE(bufoff, gbase, voff) do { _Pragma("unroll") for (int _i = 0; _i < 2; ++_i) \
        __builtin_amdgcn_global_load_lds((const unsigned*)((const char*)(gbase) + (voff)[_i]), (LAS unsigned*)(lds + (bufoff) + ldsw + _i * 8192), 16, 0, 0); } while (0)
#define PG8_LDA(dst, b, h) do { _Pragma("unroll") for (int m = 0; m < 4; ++m) _Pragma("unroll") for (int k = 0; k < 2; ++k) dst[m][k] = *(const LAS bf16x8*)(lds + PG8_SA(b, h) + aoff + m * 2048 + k * 1024); } while (0)
#define PG8_LDB(dst, b, h) do { _Pragma("unroll") for (int n = 0; n < 2; ++n) _Pragma("unroll") for (int k = 0; k < 2; ++k) dst[n][k] = *(const LAS bf16x8*)(lds + PG8_SB(b, h) + boff + n * 2048 + k * 1024); } while (0)
#define PG8_MMA(ai, bj, At, Bt) do { __builtin_amdgcn_s_setprio(1); _Pragma("unroll") for (int m = 0; m < 4; ++m) _Pragma("unroll") for (int n = 0; n < 2; ++n) _Pragma("unroll") for (int k = 0; k < 2; ++k) \
        acc[ai][bj][m][n] = __builtin_amdgcn_mfma_f32_16x16x32_bf16(Bt[n][k], At[m][k], acc[ai][bj][m][n], 0, 0, 0); __builtin_amdgcn_s_setprio(0); } while (0)
#define PG8_WAIT_V(n) asm volatile("s_waitcnt vmcnt(" #n ")" ::: "memory")
#define PG8_WAIT_L(n) asm volatile("s_waitcnt lgkmcnt(" #n ")" ::: "memory")
#define PG8_BAR __builtin_amdgcn_s_barrier()
#define PG8_SCHED __builtin_amdgcn_sched_barrier(0)
#define PG8_ABASE(u) ((const char*)g.A + (size_t)(u).pm * tstepA + (size_t)((u).pn / g.pn_per_grp) * g.a_grp_cols * 2)
    Unit cur, nxt; int ui = 0;
    if (!S.next(0, cur)) return;
    f32x4 acc[2][2][4][2];
#pragma unroll
    for (int a = 0; a < 2; ++a)
#pragma unroll
        for (int b = 0; b < 2; ++b)
#pragma unroll
            for (int m = 0; m < 4; ++m)
#pragma unroll
                for (int n = 0; n < 2; ++n) acc[a][b][m][n] = (f32x4){0.f, 0.f, 0.f, 0.f};
    bf16x8 At[4][2], B0[2][2], B1[2][2];
    const char* cA = PG8_ABASE(cur); const char* cB = (const char*)g.Bt + (size_t)cur.pn * tstepB;
    PG8_STAGE(PG8_SB(0, 0), cB, voffB); PG8_STAGE(PG8_SB(0, 1), cB + hstepB, voffB); PG8_STAGE(PG8_SA(0, 0), cA, voffA); PG8_STAGE(PG8_SA(0, 1), cA + hstepA, voffA);
    if (wr == 1) PG8_BAR;
    PG8_WAIT_V(2); PG8_BAR;
    PG8_STAGE(PG8_SB(1, 0), cB + kstep, voffB); PG8_STAGE(PG8_SA(1, 0), cA + kstep, voffA); PG8_STAGE(PG8_SB(1, 1), cB + hstepB + kstep, voffB);
    PG8_WAIT_V(6); PG8_BAR;
    for (;;) {
        const bool has_next = S.next(ui + 1, nxt);
        const char* nA = has_next ? PG8_ABASE(nxt) : cA; const char* nB = has_next ? (const char*)g.Bt + (size_t)nxt.pn * tstepB : cB;
        for (int t = 0; t < nt; t += 2) {
            const bool last = (t == nt - 2);
            const char* a1 = cA + (size_t)(t + 1) * kstep;
            const char* a2 = last ? nA : cA + (size_t)(t + 2) * kstep; const char* b2 = last ? nB : cB + (size_t)(t + 2) * kstep;
            const char* a3 = a2 + kstep; const char* b3 = b2 + kstep;
            PG8_LDB(B0, 0, 0); PG8_LDB(B1, 0, 1); PG8_SCHED; PG8_LDA(At, 0, 0); PG8_STAGE(PG8_SA(1, 1), a1 + hstepA, voffA);
            PG8_WAIT_V(8); PG8_WAIT_L(0); PG8_BAR; PG8_MMA(0, 0, At, B0); PG8_MMA(0, 1, At, B1); PG8_BAR; PG8_SCHED;
            PG8_LDA(At, 0, 1); PG8_STAGE(PG8_SB(0, 0), b2, voffB); PG8_STAGE(PG8_SB(0, 1), b2 + hstepB, voffB); PG8_STAGE(PG8_SA(0, 0), a2, voffA);
            PG8_WAIT_V(8); PG8_WAIT_L(0); PG8_BAR; PG8_MMA(1, 0, At, B0); PG8_MMA(1, 1, At, B1); PG8_BAR; PG8_SCHED;
            PG8_LDB(B0, 1, 0); PG8_LDB(B1, 1, 1); PG8_SCHED; PG8_LDA(At, 1, 0); PG8_STAGE(PG8_SA(0, 1), a2 + hstepA, voffA);
            PG8_WAIT_V(8); PG8_WAIT_L(0); PG8_BAR; PG8_MMA(0, 0, At, B0); PG8_MMA(0, 1, At, B1); PG8_BAR; PG8_SCHED;
            PG8_LDA(At, 1, 1); PG8_STAGE(PG8_SB(1, 0), b3, voffB); PG8_STAGE(PG8_SB(1, 1), b3 + hstepB, voffB); PG8_STAGE(PG8_SA(1, 0), a3, voffA);
            PG8_WAIT_V(8); PG8_WAIT_L(0); PG8_BAR; PG8_MMA(1, 0, At, B0); PG8_MMA(1, 1, At, B1); PG8_BAR; PG8_SCHED;
        }
        if constexpr (ALIGN_EPI) { if (wr == 0) PG8_BAR; }
        run_epi(E, acc, cur, wr, wc, fr, fq);
        if (!has_next) break;
#pragma unroll
        for (int a = 0; a < 2; ++a)
#pragma unroll
            for (int b = 0; b < 2; ++b)
#pragma unroll
                for (int m = 0; m < 4; ++m)
#pragma unroll
                    for (int n = 0; n < 2; ++n) acc[a][b][m][n] = (f32x4){0.f, 0.f, 0.f, 0.f};
        cur = nxt; cA = nA; cB = nB; ++ui;
        if constexpr (ALIGN_EPI) { if (wr == 1) PG8_BAR; }
    }
    PG8_WAIT_V(0);
    if constexpr (!ALIGN_EPI) { if (wr == 0) PG8_BAR; }
    PG8_BAR;
#undef PG8_SA
#undef PG8_SB
#undef PG8_STAGE
#undef PG8_LDA
#undef PG8_LDB
#undef PG8_MMA
#undef PG8_WAIT_V
#undef PG8_WAIT_L
#undef PG8_BAR
#undef PG8_SCHED
#undef PG8_ABASE
}
}

typedef GAS unsigned gu32;
#define RLX_AGENT __ATOMIC_RELAXED, __HIP_MEMORY_SCOPE_AGENT
#define XB_TMO      128
#define XB_XCNT(j)  (256  + 64 * (j))
#define XB_XSUB(j)  (1280 + 64 * (j))
#define XB_XGEN(j)  (2304 + 64 * (j))
#define XB_TOP      3328
#define XB_TOPGEN   3392
#define XCD_BAR_WORDS 3456
#define XB_SPIN_CAP (1u << 18)
__device__ __forceinline__ unsigned xb_ld(unsigned* p)              { return __hip_atomic_load(p, __ATOMIC_RELAXED, __HIP_MEMORY_SCOPE_AGENT); }
__device__ __forceinline__ unsigned xb_add(unsigned* p, unsigned v) { return __hip_atomic_fetch_add(p, v, __ATOMIC_RELAXED, __HIP_MEMORY_SCOPE_AGENT); }
__device__ __forceinline__ unsigned xb_xcc_id() { return (unsigned)__builtin_amdgcn_s_getreg((3 << 11) | 20) & 0xFu; }
#define XB_SPIN(cond, bar) do { unsigned _sp = 0; while (cond) { __builtin_amdgcn_s_sleep(1); \
    if ((++_sp & 255u) == 0u) { if (xb_ld(&(bar)[XB_TMO])) break; if (_sp > XB_SPIN_CAP) { atomicAdd(&(bar)[XB_TMO], 1u); break; } } } } while (0)
struct XcdBarrier { unsigned* bar; unsigned x; volatile LAS unsigned* st; bool leader; };
__device__ __forceinline__ XcdBarrier xcd_barrier_post(unsigned* bar, volatile LAS unsigned* st, bool wave0) {
    XcdBarrier b; b.bar = bar; b.x = xb_xcc_id(); b.st = st; b.leader = wave0;
    if (wave0 && lane_id() == 0) (void)xb_add(&bar[XB_XCNT(b.x)], 1u);
    return b;
}
__device__ __forceinline__ void xcd_barrier_complete(unsigned* bar, unsigned x, unsigned& nloc, unsigned& nx) {
    const unsigned G = gridDim.x * gridDim.y * gridDim.z;
    unsigned sum, cnt, mine, sp = 0u;
    for (;;) {
        sum = 0u; cnt = 0u; mine = 0u;
#pragma unroll
        for (unsigned j = 0; j < 16; ++j) { const unsigned c = xb_ld(&bar[XB_XCNT(j)]); sum += c; cnt += (c > 0u) ? 1u : 0u; mine = (j == x) ? c : mine; }
        if (sum == G) break;
        __builtin_amdgcn_s_sleep(1);
        if ((++sp & 255u) == 0u) { if (xb_ld(&bar[XB_TMO])) break; if (sp > XB_SPIN_CAP) { atomicAdd(&bar[XB_TMO], 1u); break; } }
    }
    nloc = mine > 0u ? mine : 1u; nx = cnt > 0u ? cnt : 1u;
}
__device__ __forceinline__ void xcd_barrier(const XcdBarrier& b) {
    asm volatile("s_waitcnt vmcnt(0)" ::: "memory");
    __syncthreads();
    if (b.leader && lane_id() == 0) {
        unsigned* bar = b.bar;
        __builtin_amdgcn_s_waitcnt(0);
        unsigned nloc = b.st[0], nx = b.st[1];
        if (nloc == 0u) { xcd_barrier_complete(bar, b.x, nloc, nx); b.st[0] = nloc; b.st[1] = nx; }
        const unsigned old = xb_add(&bar[XB_XSUB(b.x)], 1u);
        const unsigned gen = old / nloc;
        if (old + 1u == (gen + 1u) * nloc) {
            __builtin_amdgcn_fence(__ATOMIC_RELEASE, "agent");
            asm volatile("s_waitcnt vmcnt(0)" ::: "memory");
            const unsigned og = xb_add(&bar[XB_TOP], 1u);
            const unsigned tg = og / nx;
            if (og + 1u == (tg + 1u) * nx) xb_add(&bar[XB_TOPGEN], 1u);
            else XB_SPIN(xb_ld(&bar[XB_TOPGEN]) == tg, bar);
            __builtin_amdgcn_fence(__ATOMIC_ACQUIRE, "agent");
            xb_add(&bar[XB_XGEN(b.x)], 1u);
            asm volatile("s_waitcnt vmcnt(0)" ::: "memory");
        } else {
            XB_SPIN(xb_ld(&bar[XB_XGEN(b.x)]) == gen, bar);
            __builtin_amdgcn_fence(__ATOMIC_ACQUIRE, "agent");
            asm volatile("s_waitcnt vmcnt(0)" ::: "memory");
        }
    }
    __syncthreads();
}

struct Args {
    const float* in[15]; float* out; unsigned char* ws;
    float inv_freq[16];
    int ph_lo, ph_hi, li, pad;
};
struct Frame {
    LAS unsigned char* lds; int wave, vcu, G;
};

struct P0Item { const float* src; bf16_t* dst; int N, ldt; };
__device__ __forceinline__ void p0_item_load(const P0Item& it, int lane, f32x4 (&v)[8]) {
    const float* p = it.src + (size_t)(lane >> 3) * it.N + 4 * (lane & 7);
#pragma unroll
    for (int i = 0; i < 8; ++i) v[i] = __builtin_nontemporal_load((const f32x4*)(p + (size_t)(8 * i) * it.N));
}
__device__ __forceinline__ void p0_item_store(const P0Item& it, int lane, const f32x4 (&v)[8], LAS float* scr) {
    LAS float* w = scr + (lane >> 3) * 33 + 4 * (lane & 7);
#pragma unroll
    for (int i = 0; i < 8; ++i) { w[(8 * i) * 33 + 0] = v[i][0]; w[(8 * i) * 33 + 1] = v[i][1]; w[(8 * i) * 33 + 2] = v[i][2]; w[(8 * i) * 33 + 3] = v[i][3]; }
    asm volatile("s_waitcnt lgkmcnt(0)" ::: "memory");
    const int c = lane & 7;
#pragma unroll
    for (int j = 0; j < 4; ++j) { const int n = (lane >> 3) + 8 * j; const LAS float* s = scr + (8 * c) * 33 + n;
        u32x4 o; o.x = pk2(s[0 * 33], s[1 * 33]); o.y = pk2(s[2 * 33], s[3 * 33]); o.z = pk2(s[4 * 33], s[5 * 33]); o.w = pk2(s[6 * 33], s[7 * 33]);
        *(u32x4*)(it.dst + (size_t)n * it.ldt + 8 * c) = o; }
    asm volatile("s_waitcnt lgkmcnt(0)" ::: "memory");
}
__device__ __forceinline__ void load_row(const float* p, int lane, f32x4 (&v)[8]) {
#pragma unroll
    for (int j = 0; j < 8; ++j) v[j] = *(const f32x4*)(p + 4 * (64 * j + lane));
}
__device__ __forceinline__ void load_row_bf16(const bf16_t* p, int lane, f32x4 (&v)[8]) {
#pragma unroll
    for (int j = 0; j < 8; ++j) { const u32x2 w = *(const u32x2*)(p + 4 * (64 * j + lane)); v[j] = (f32x4){bflo(w.x), bfhi(w.x), bflo(w.y), bfhi(w.y)}; }
}
__device__ __forceinline__ float row_ss(const f32x4 (&v)[8]) {
    float s = 0.f;
#pragma unroll
    for (int j = 0; j < 8; ++j) s += (v[j][0] * v[j][0] + v[j][1] * v[j][1]) + (v[j][2] * v[j][2] + v[j][3] * v[j][3]);
    return wave_sum(s);
}
__device__ __forceinline__ void row_ss2(const f32x4 (&a)[8], const f32x4 (&b)[8], float& sa, float& sb) {
    float s = 0.f, t = 0.f;
#pragma unroll
    for (int j = 0; j < 8; ++j) { s += (a[j][0] * a[j][0] + a[j][1] * a[j][1]) + (a[j][2] * a[j][2] + a[j][3] * a[j][3]); t += (b[j][0] * b[j][0] + b[j][1] * b[j][1]) + (b[j][2] * b[j][2] + b[j][3] * b[j][3]); }
#pragma unroll
    for (int o = 1; o < 64; o <<= 1) { s += __shfl_xor(s, o); t += __shfl_xor(t, o); }
    sa = s; sb = t;
}
__device__ __forceinline__ void store_row_bf16(bf16_t* p, int lane, const f32x4 (&v)[8]) {
#pragma unroll
    for (int j = 0; j < 8; ++j) { u32x2 w; w.x = pk2(v[j][0], v[j][1]); w.y = pk2(v[j][2], v[j][3]); *(u32x2*)(p + 4 * (64 * j + lane)) = w; }
}

__device__ __forceinline__ void rows16_phase(const Frame& F, const bf16_t* A16, int lda, const bf16_t* Bt, int ldb, int K, int ntasks, int a_grp_cols, int tasks_per_grp, const Epi& E) {
    int lane_o = lane_id();
    const int lane = lane_o, m = lane & 15, fq = lane >> 4;
    LAS float* red = (LAS float*)F.lds;
    const int stride = F.G / ntasks > 0 ? F.G / ntasks : 1;
    for (int task0 = F.vcu; task0 < ntasks * stride; task0 += F.G) {
        if (task0 % stride) continue;
        const int task = task0 / stride;
        const int n0 = task * 32, kslice = K / 8, kb = F.wave * kslice;
        const bf16_t* ap = A16 + (size_t)m * lda + (task / tasks_per_grp) * a_grp_cols + kb + 8 * fq;
        const bf16_t* bp0 = Bt + (size_t)(n0 + 8 * (m >> 2) + (m & 3)) * ldb + kb + 8 * fq;
        const bf16_t* bp1 = bp0 + (size_t)4 * ldb;
        f32x4 acc0 = {0.f, 0.f, 0.f, 0.f}, acc1 = {0.f, 0.f, 0.f, 0.f};
        for (int ks = 0; ks < kslice; ks += 32) {
            const bf16x8 a = *(const bf16x8*)(ap + ks), b0 = *(const bf16x8*)(bp0 + ks), b1 = *(const bf16x8*)(bp1 + ks);
            acc0 = __builtin_amdgcn_mfma_f32_16x16x32_bf16(b0, a, acc0, 0, 0, 0);
            acc1 = __builtin_amdgcn_mfma_f32_16x16x32_bf16(b1, a, acc1, 0, 0, 0);
        }
        *(LAS f32x4*)(red + (F.wave * 2 + 0) * 256 + lane * 4) = acc0;
        *(LAS f32x4*)(red + (F.wave * 2 + 1) * 256 + lane * 4) = acc1;
        __syncthreads();
        if (F.wave == 0) {
            f32x4 s0 = {0.f, 0.f, 0.f, 0.f}, s1 = {0.f, 0.f, 0.f, 0.f};
#pragma unroll
            for (int w = 0; w < 8; ++w) { s0 += *(const LAS f32x4*)(red + (w * 2 + 0) * 256 + lane * 4); s1 += *(const LAS f32x4*)(red + (w * 2 + 1) * 256 + lane * 4); }
            E.emit_rt(MREAL + m, n0 + 8 * fq, s0, s1);
        }
        __syncthreads();
    }
}

template <int W> __device__ __forceinline__ void mix_strip(const bf16_t* U, bf16_t* MIXo, int strip, int c0) {
    const int row0 = strip * 16, bb = row0 >> 12, p0 = NMETA + (row0 & (SEQ - 1));
    u32x4 buf[W - 1 + 16];
#pragma unroll
    for (int i = 0; i < W - 1 + 16; ++i) { const int pp = p0 - (W - 1) + i; const int r = pp >= NMETA ? bb * SEQ + pp - NMETA : MREAL + pp;
        buf[i] = *(const u32x4*)(U + (size_t)r * DM + c0); }
    float s[8] = {0.f, 0.f, 0.f, 0.f, 0.f, 0.f, 0.f, 0.f};
#define MIX_UNPK(v, f) const float f[8] = {bflo(v.x), bfhi(v.x), bflo(v.y), bfhi(v.y), bflo(v.z), bfhi(v.z), bflo(v.w), bfhi(v.w)}
#pragma unroll
    for (int i = 0; i < W - 1; ++i) { MIX_UNPK(buf[i], f);
#pragma unroll
        for (int k = 0; k < 8; ++k) s[k] += f[k]; }
    constexpr float iw = 1.0f / (float)W;
#pragma unroll
    for (int t = 0; t < 16; ++t) {
        MIX_UNPK(buf[W - 1 + t], f);
#pragma unroll
        for (int k = 0; k < 8; ++k) s[k] += f[k];
        u32x4 o; o.x = pk2(s[0] * iw - f[0], s[1] * iw - f[1]); o.y = pk2(s[2] * iw - f[2], s[3] * iw - f[3]);
        o.z = pk2(s[4] * iw - f[4], s[5] * iw - f[5]); o.w = pk2(s[6] * iw - f[6], s[7] * iw - f[7]);
        *(u32x4*)(MIXo + (size_t)(row0 + t) * DM + c0) = o;
        MIX_UNPK(buf[t], g);
#pragma unroll
        for (int k = 0; k < 8; ++k) s[k] -= g[k];
    }
#undef MIX_UNPK
}

namespace att {
__device__ __forceinline__ int crow(int r, int hi) { return (r & 3) + 8 * (r >> 2) + 4 * hi; }
__device__ __forceinline__ float xch32(float v) { return __shfl_xor(v, 32); }
#ifndef ATT_VPREFETCH
#define ATT_VPREFETCH 1
#endif
#ifndef ATT_PROBE
#define ATT_PROBE 0
#endif
#ifndef ATT_STATICPRIO
#define ATT_STATICPRIO 1
#endif
#ifndef ATT_VSETS
#define ATT_VSETS 1
#endif
#ifndef ATT_PIPE
#define ATT_PIPE 0
#endif
#ifndef ATT_STAGGER
#define ATT_STAGGER 1
#endif
#ifndef ATT_SETPRIO
#define ATT_SETPRIO 0
#endif
constexpr float THRL = 6.0f;
template <int OFF> __device__ __forceinline__ bf16x8 v_read1(int va) {
    bf16x8 r; asm volatile("ds_read_b128 %0, %1 offset:%2" : "=&v"(r) : "v"(va), "i"(OFF) : "memory"); return r;
}
template <int D0> __device__ __forceinline__ void pv_read(bf16x8 (&v)[4], const int (&voff)[4]) {
    v[0] = v_read1<D0 * 4096>(voff[0]); v[1] = v_read1<D0 * 4096>(voff[1]); v[2] = v_read1<D0 * 4096>(voff[2]); v[3] = v_read1<D0 * 4096>(voff[3]);
}
__device__ __forceinline__ void pv_mma(f32x16& od, const bf16x8 (&v)[4], const u32x4 (&pw)[4]) {
    if (ATT_SETPRIO) __builtin_amdgcn_s_setprio(1);
    od = __builtin_amdgcn_mfma_f32_32x32x16_bf16(v[0], __builtin_bit_cast(bf16x8, pw[0]), od, 0, 0, 0);
    od = __builtin_amdgcn_mfma_f32_32x32x16_bf16(v[1], __builtin_bit_cast(bf16x8, pw[1]), od, 0, 0, 0);
    od = __builtin_amdgcn_mfma_f32_32x32x16_bf16(v[2], __builtin_bit_cast(bf16x8, pw[2]), od, 0, 0, 0);
    od = __builtin_amdgcn_mfma_f32_32x32x16_bf16(v[3], __builtin_bit_cast(bf16x8, pw[3]), od, 0, 0, 0);
    if (ATT_SETPRIO) __builtin_amdgcn_s_setprio(0);
}
#define ATT_WL(n) do { __builtin_amdgcn_sched_barrier(0); asm volatile("s_waitcnt lgkmcnt(" #n ")" ::: "memory"); __builtin_amdgcn_sched_barrier(0); } while (0)
#define ATT_KEEP4(a) asm volatile("" :: "v"((a)[0]), "v"((a)[1]), "v"((a)[2]), "v"((a)[3]))
__device__ __forceinline__ void pv_all(f32x16 (&o)[8], int vb, const int (&vsw)[4], const u32x4 (&pw)[4]) {
    const int voff[4] = {vb + vsw[0], vb + vsw[1], vb + vsw[2], vb + vsw[3]};
    bf16x8 va[4], vc[4];
    pv_read<0>(va, voff); ATT_WL(0); ATT_KEEP4(va);
    pv_read<1>(vc, voff); pv_mma(o[0], va, pw); ATT_WL(0); ATT_KEEP4(vc);
    pv_read<2>(va, voff); pv_mma(o[1], vc, pw); ATT_WL(0); ATT_KEEP4(va);
    pv_read<3>(vc, voff); pv_mma(o[2], va, pw); ATT_WL(0); ATT_KEEP4(vc);
    pv_read<4>(va, voff); pv_mma(o[3], vc, pw); ATT_WL(0); ATT_KEEP4(va);
    pv_read<5>(vc, voff); pv_mma(o[4], va, pw); ATT_WL(0); ATT_KEEP4(vc);
    pv_read<6>(va, voff); pv_mma(o[5], vc, pw); ATT_WL(0); ATT_KEEP4(va);
    pv_read<7>(vc, voff); pv_mma(o[6], va, pw); ATT_WL(0); ATT_KEEP4(vc);
    pv_mma(o[7], vc, pw);
}
template <int OFF> __device__ __forceinline__ bf16x8 k_read1(int kb) {
    bf16x8 r; asm volatile("ds_read_b128 %0, %1 offset:%2" : "=&v"(r) : "v"(kb), "i"(OFF) : "memory"); return r;
}
template <int G> __device__ __forceinline__ void k_read(bf16x8 (&k)[4], int kb) {
    k[0] = k_read1<(2 * G) * 2048>(kb); k[1] = k_read1<(2 * G) * 2048 + 512>(kb); k[2] = k_read1<(2 * G + 1) * 2048>(kb); k[3] = k_read1<(2 * G + 1) * 2048 + 512>(kb);
}
template <int G> __device__ __forceinline__ void qk_mma(f32x16& p0, f32x16& p1, const bf16x8 (&k)[4], const bf16x8 (&qr)[8]) {
    p0 = __builtin_amdgcn_mfma_f32_32x32x16_bf16(k[0], qr[2 * G], p0, 0, 0, 0);
    p1 = __builtin_amdgcn_mfma_f32_32x32x16_bf16(k[1], qr[2 * G], p1, 0, 0, 0);
    p0 = __builtin_amdgcn_mfma_f32_32x32x16_bf16(k[2], qr[2 * G + 1], p0, 0, 0, 0);
    p1 = __builtin_amdgcn_mfma_f32_32x32x16_bf16(k[3], qr[2 * G + 1], p1, 0, 0, 0);
}
template <int D, bool DO_PV, bool DO_SM>
__device__ __forceinline__ void pvsm_block(f32x16& od, const bf16x8 (&v)[4], const u32x4 (&pw)[4], f32x16& p0, f32x16& p1, float m_run, float& ps, u32x4 (&pn)[4]) {
#pragma unroll
    for (int k = 0; k < 4; ++k) {
        if (DO_PV) od = __builtin_amdgcn_mfma_f32_32x32x16_bf16(v[k], __builtin_bit_cast(bf16x8, pw[k]), od, 0, 0, 0);
        if (DO_SM) {
            constexpr int e0 = 4 * D; const int e = e0 + k;
            float ex;
            if (e < 16) { ex = __builtin_amdgcn_exp2f(p0[e] - m_run); p0[e] = ex; } else { ex = __builtin_amdgcn_exp2f(p1[e - 16] - m_run); p1[e - 16] = ex; }
            ps += ex;
            if (k & 1) { const int w = e >> 1;
                const float lo = (e - 1 < 16) ? p0[(e - 1) & 15] : p1[(e - 1) & 15];
                pn[w >> 2][w & 3] = pk2(lo, ex); }
        }
        __builtin_amdgcn_sched_barrier(0);
    }
}
template <bool DO_PV, bool DO_SM>
__device__ __forceinline__ void pv_sm(f32x16 (&o)[8], const int (&voff)[4], const u32x4 (&pw)[4], f32x16& p0, f32x16& p1, float m_run, float& ps, u32x4 (&pn)[4]) {
#if ATT_VSETS == 2
    bf16x8 va[4], vc[4];
    if (DO_PV) { pv_read<0>(va, voff); ATT_WL(0); }
    if (DO_PV) pv_read<1>(vc, voff); pvsm_block<0, DO_PV, DO_SM>(o[0], va, pw, p0, p1, m_run, ps, pn); if (DO_PV) ATT_WL(0);
    if (DO_PV) pv_read<2>(va, voff); pvsm_block<1, DO_PV, DO_SM>(o[1], vc, pw, p0, p1, m_run, ps, pn); if (DO_PV) ATT_WL(0);
    if (DO_PV) pv_read<3>(vc, voff); pvsm_block<2, DO_PV, DO_SM>(o[2], va, pw, p0, p1, m_run, ps, pn); if (DO_PV) ATT_WL(0);
    if (DO_PV) pv_read<4>(va, voff); pvsm_block<3, DO_PV, DO_SM>(o[3], vc, pw, p0, p1, m_run, ps, pn); if (DO_PV) ATT_WL(0);
    if (DO_PV) pv_read<5>(vc, voff); pvsm_block<4, DO_PV, DO_SM>(o[4], va, pw, p0, p1, m_run, ps, pn); if (DO_PV) ATT_WL(0);
    if (DO_PV) pv_read<6>(va, voff); pvsm_block<5, DO_PV, DO_SM>(o[5], vc, pw, p0, p1, m_run, ps, pn); if (DO_PV) ATT_WL(0);
    if (DO_PV) pv_read<7>(vc, voff); pvsm_block<6, DO_PV, DO_SM>(o[6], va, pw, p0, p1, m_run, ps, pn); if (DO_PV) ATT_WL(0);
    pvsm_block<7, DO_PV, DO_SM>(o[7], vc, pw, p0, p1, m_run, ps, pn);
#else
    bf16x8 va[4];
    if (DO_PV) { pv_read<0>(va, voff); ATT_WL(0); } pvsm_block<0, DO_PV, DO_SM>(o[0], va, pw, p0, p1, m_run, ps, pn);
    if (DO_PV) { pv_read<1>(va, voff); ATT_WL(0); } pvsm_block<1, DO_PV, DO_SM>(o[1], va, pw, p0, p1, m_run, ps, pn);
    if (DO_PV) { pv_read<2>(va, voff); ATT_WL(0); } pvsm_block<2, DO_PV, DO_SM>(o[2], va, pw, p0, p1, m_run, ps, pn);
    if (DO_PV) { pv_read<3>(va, voff); ATT_WL(0); } pvsm_block<3, DO_PV, DO_SM>(o[3], va, pw, p0, p1, m_run, ps, pn);
    if (DO_PV) { pv_read<4>(va, voff); ATT_WL(0); } pvsm_block<4, DO_PV, DO_SM>(o[4], va, pw, p0, p1, m_run, ps, pn);
    if (DO_PV) { pv_read<5>(va, voff); ATT_WL(0); } pvsm_block<5, DO_PV, DO_SM>(o[5], va, pw, p0, p1, m_run, ps, pn);
    if (DO_PV) { pv_read<6>(va, voff); ATT_WL(0); } pvsm_block<6, DO_PV, DO_SM>(o[6], va, pw, p0, p1, m_run, ps, pn);
    if (DO_PV) { pv_read<7>(va, voff); ATT_WL(0); } pvsm_block<7, DO_PV, DO_SM>(o[7], va, pw, p0, p1, m_run, ps, pn);
#endif
}
__device__ __forceinline__ float qk_max(f32x16& p0, f32x16& p1, const LAS unsigned char* Kst, const bf16x8 (&qr)[8], bool meta_tile) {
    p0 = (f32x16){0.f, 0.f, 0.f, 0.f, 0.f, 0.f, 0.f, 0.f, 0.f, 0.f, 0.f, 0.f, 0.f, 0.f, 0.f, 0.f}; p1 = p0;
    {   const int kb = (int)(unsigned)(uintptr_t)Kst;
        bf16x8 ka[4], kc[4];
        k_read<0>(ka, kb); ATT_WL(0); ATT_KEEP4(ka);
        k_read<1>(kc, kb); qk_mma<0>(p0, p1, ka, qr); ATT_WL(0); ATT_KEEP4(kc);
        k_read<2>(ka, kb); qk_mma<1>(p0, p1, kc, qr); ATT_WL(0); ATT_KEEP4(ka);
        k_read<3>(kc, kb); qk_mma<2>(p0, p1, ka, qr); ATT_WL(0); ATT_KEEP4(kc);
        qk_mma<3>(p0, p1, kc, qr);
    }
    if (meta_tile) {
#pragma unroll
        for (int r = 8; r < 16; ++r) p0[r] = -INFINITY;
#pragma unroll
        for (int r = 0; r < 16; ++r) p1[r] = -INFINITY;
    }
    float rm = fmaxf(fmaxf(p0[0], p0[1]), p0[2]);
#pragma unroll
    for (int r = 3; r < 15; r += 2) rm = fmaxf(fmaxf(rm, p0[r]), p0[r + 1]);
    rm = fmaxf(rm, p0[15]);
#pragma unroll
    for (int r = 0; r < 16; r += 2) rm = fmaxf(fmaxf(rm, p1[r]), p1[r + 1]);
    return fmaxf(rm, xch32(rm));
}
__device__ __forceinline__ void qk_sm(f32x16 (&o)[8], float& m_run, float& l_run, u32x4 (&pw)[4], const LAS unsigned char* Kst, const bf16x8 (&qr)[8], bool meta_tile) {
    f32x16 p0 = (f32x16){0.f, 0.f, 0.f, 0.f, 0.f, 0.f, 0.f, 0.f, 0.f, 0.f, 0.f, 0.f, 0.f, 0.f, 0.f, 0.f}, p1 = p0;
    {
        const int kb = (int)(unsigned)(uintptr_t)Kst;
        bf16x8 ka[4], kc[4];
        k_read<0>(ka, kb); ATT_WL(0); ATT_KEEP4(ka);
        k_read<1>(kc, kb); qk_mma<0>(p0, p1, ka, qr); ATT_WL(0); ATT_KEEP4(kc);
        k_read<2>(ka, kb); qk_mma<1>(p0, p1, kc, qr); ATT_WL(0); ATT_KEEP4(ka);
        k_read<3>(kc, kb); qk_mma<2>(p0, p1, ka, qr); ATT_WL(0); ATT_KEEP4(kc);
        qk_mma<3>(p0, p1, kc, qr);
    }
    if (ATT_PROBE == 2) {
        asm volatile("" : "+v"(p0), "+v"(p1));
        p0 = (f32x16){0.f, 0.f, 0.f, 0.f, 0.f, 0.f, 0.f, 0.f, 0.f, 0.f, 0.f, 0.f, 0.f, 0.f, 0.f, 0.f}; p1 = p0;
#pragma unroll
        for (int d0 = 0; d0 < 8; ++d0) {
            const bf16x8 a0 = *(const LAS bf16x8*)(Kst + d0 * 2048), a1 = *(const LAS bf16x8*)(Kst + d0 * 2048 + 512);
            p0 = __builtin_amdgcn_mfma_f32_32x32x16_bf16(a0, qr[d0], p0, 0, 0, 0);
            p1 = __builtin_amdgcn_mfma_f32_32x32x16_bf16(a1, qr[d0], p1, 0, 0, 0);
        }
    }
    if (meta_tile) {
#pragma unroll
        for (int r = 8; r < 16; ++r) p0[r] = -INFINITY;
#pragma unroll
        for (int r = 0; r < 16; ++r) p1[r] = -INFINITY;
    }
    float rm = fmaxf(fmaxf(p0[0], p0[1]), p0[2]);
#pragma unroll
    for (int r = 3; r < 15; r += 2) rm = fmaxf(fmaxf(rm, p0[r]), p0[r + 1]);
    rm = fmaxf(rm, p0[15]);
#pragma unroll
    for (int r = 0; r < 16; r += 2) rm = fmaxf(fmaxf(rm, p1[r]), p1[r + 1]);
    rm = fmaxf(rm, xch32(rm));
    if (__any(rm > m_run + THRL)) {
        const float mn = fmaxf(m_run, rm), alpha = __builtin_amdgcn_exp2f(m_run - mn);
        m_run = mn; l_run *= alpha;
#pragma unroll
        for (int d = 0; d < 8; ++d)
#pragma unroll
            for (int r = 0; r < 16; ++r) o[d][r] *= alpha;
    }
    float ps = 0.f;
#pragma unroll
    for (int r = 0; r < 16; ++r) { float xx = p0[r] - m_run; p0[r] = __builtin_amdgcn_exp2f(xx); if (ATT_PROBE == 3) { asm volatile("" : "+v"(xx)); p0[r] = (p0[r] + __builtin_amdgcn_exp2f(xx)) * 0.5f; } ps += p0[r]; }
#pragma unroll
    for (int r = 0; r < 16; ++r) { float xx = p1[r] - m_run; p1[r] = __builtin_amdgcn_exp2f(xx); if (ATT_PROBE == 3) { asm volatile("" : "+v"(xx)); p1[r] = (p1[r] + __builtin_amdgcn_exp2f(xx)) * 0.5f; } ps += p1[r]; }
    l_run += ps;
    pw[0] = (u32x4){pk2(p0[0], p0[1]), pk2(p0[2], p0[3]), pk2(p0[4], p0[5]), pk2(p0[6], p0[7])};
    pw[1] = (u32x4){pk2(p0[8], p0[9]), pk2(p0[10], p0[11]), pk2(p0[12], p0[13]), pk2(p0[14], p0[15])};
    pw[2] = (u32x4){pk2(p1[0], p1[1]), pk2(p1[2], p1[3]), pk2(p1[4], p1[5]), pk2(p1[6], p1[7])};
    pw[3] = (u32x4){pk2(p1[8], p1[9]), pk2(p1[10], p1[11]), pk2(p1[12], p1[13]), pk2(p1[14], p1[15])};
}
__device__ __forceinline__ void attn_unit(const Frame& F, const bf16_t* Q, const unsigned char* Kimg, const unsigned char* Vimg, const bf16_t* Gt, bf16_t* O,
                                          const float* subln_g, int b, int h, int qb, int desc) {
    LAS unsigned char* lds = F.lds;
    int lane_o = lane_id();
    const int lane = lane_o, r32 = lane & 31, hi = lane >> 5, wid = F.wave, mp = wid >> 2, rg = wid & 3;
    const bool meta = qb < 0;
    const size_t qrow = meta ? (size_t)(MREAL + (r32 & 15)) : (size_t)b * SEQ + qb * 128 + rg * 32 + r32;
    const int NT = meta ? 1 : 2 * qb + 3;
    const int tmax = meta ? 0 : 2 * qb + 1 + (rg >> 1);
    bf16x8 qr[8];
    { const bf16_t* qp = Q + qrow * DM + h * 256 + mp * 128 + hi * 8;
#pragma unroll
      for (int d0 = 0; d0 < 8; ++d0) qr[d0] = *(const bf16x8*)(qp + 16 * d0); }
    const int bsel = meta ? 0 : b;
    const unsigned char* srcK = Kimg + ((size_t)((bsel * NH + h) * 2 + mp) * NTILE) * KTILE_B + rg * 4096;
    const unsigned char* srcV = Vimg + ((size_t)(bsel * NH + h) * NTILE) * VTILE_B + wid * 4096;
    const unsigned laneoff = (unsigned)lane * 16u;
#define ATT_TILE(k) (desc ? NT - 1 - (k) : (k))
#define ATT_DMA_K(k) do { const int _tl = ATT_TILE(k); _Pragma("unroll") for (int _i = 0; _i < (ATT_PROBE == 1 ? 8 : 4); ++_i) \
        __builtin_amdgcn_global_load_lds((const unsigned*)(srcK + (size_t)_tl * KTILE_B + (_i & 3) * 1024 + laneoff), (LAS unsigned*)(lds + ((k) & 1) * 32768 + wid * 4096 + (_i & 3) * 1024), 16, 0, 0); } while (0)
#define ATT_DMA_V(k) do { const int _tl = ATT_TILE(k); _Pragma("unroll") for (int _i = 0; _i < (ATT_PROBE == 1 ? 8 : 4); ++_i) \
        __builtin_amdgcn_global_load_lds((const unsigned*)(srcV + (size_t)_tl * VTILE_B + (_i & 3) * 1024 + laneoff), (LAS unsigned*)(lds + 65536 + ((k) & 1) * 32768 + wid * 4096 + (_i & 3) * 1024), 16, 0, 0); } while (0)
#define ATT_WAITBAR(n) do { if (ATT_PROBE == 1 && n == 4) asm volatile("s_waitcnt vmcnt(8)" ::: "memory"); else asm volatile("s_waitcnt vmcnt(" #n ")" ::: "memory"); __builtin_amdgcn_s_barrier(); asm volatile("" ::: "memory"); } while (0)
    f32x16 o[8];
#pragma unroll
    for (int d = 0; d < 8; ++d) o[d] = (f32x16){0.f, 0.f, 0.f, 0.f, 0.f, 0.f, 0.f, 0.f, 0.f, 0.f, 0.f, 0.f, 0.f, 0.f, 0.f, 0.f};
    float m_run = -1e30f, l_run = 0.f;
    u32x4 pw[4] = {{0u, 0u, 0u, 0u}, {0u, 0u, 0u, 0u}, {0u, 0u, 0u, 0u}, {0u, 0u, 0u, 0u}};
    int vsw[4];
#pragma unroll
    for (int sx = 0; sx < 4; ++sx) vsw[sx] = r32 * 128 + (((2 * sx + hi) ^ ((r32 >> 1) & 7)) * 16);
    const int kbase = mp * KTILE_B + hi * 1024 + r32 * 16;
#if ATT_PIPE
    f32x16 p0, p1; u32x4 pn[4];
    int voff[4];
#pragma unroll
    for (int sx = 0; sx < 4; ++sx) voff[sx] = (int)(unsigned)(uintptr_t)(lds + 65536 + 32768) + vsw[sx];
    ATT_DMA_K(0);
    {
        ATT_WAITBAR(0);
        if (1 < NT) ATT_DMA_K(1);
        ATT_DMA_V(0);
        float ps = 0.f;
        m_run = qk_max(p0, p1, lds + kbase, qr, true);
        pv_sm<false, true>(o, voff, pw, p0, p1, m_run, ps, pn);
        l_run = ps;
#pragma unroll
        for (int i = 0; i < 4; ++i) pw[i] = pn[i];
    }
    for (int t = 1; t < NT; ++t) {
        ATT_WAITBAR(0);
        if (t + 1 < NT) ATT_DMA_K(t + 1);
        ATT_DMA_V(t);
#pragma unroll
        for (int sx = 0; sx < 4; ++sx) voff[sx] ^= 32768;
        if (t <= tmax) {
            float ps = 0.f;
            const float rm = qk_max(p0, p1, lds + (t & 1) * 32768 + kbase, qr, false);
            if (__any(rm > m_run + THRL)) {
                const float mn = fmaxf(m_run, rm), alpha = __builtin_amdgcn_exp2f(m_run - mn);
                m_run = mn; l_run *= alpha;
#pragma unroll
                for (int d = 0; d < 8; ++d)
#pragma unroll
                    for (int r = 0; r < 16; ++r) o[d][r] *= alpha;
#pragma unroll
                for (int i = 0; i < 4; ++i)
#pragma unroll
                    for (int j = 0; j < 4; ++j) pw[i][j] = pk2(bflo(pw[i][j]) * alpha, bfhi(pw[i][j]) * alpha);
            }
            pv_sm<true, true>(o, voff, pw, p0, p1, m_run, ps, pn);
            l_run += ps;
#pragma unroll
            for (int i = 0; i < 4; ++i) pw[i] = pn[i];
        }
    }
    {
        ATT_WAITBAR(0);
        if (tmax == NT - 1) {
#pragma unroll
            for (int sx = 0; sx < 4; ++sx) voff[sx] ^= 32768;
        }
        float ps = 0.f;
        pv_sm<true, false>(o, voff, pw, p0, p1, m_run, ps, pn);
    }
#else
    ATT_DMA_K(0); ATT_DMA_V(0);
#define ATT_VADDR(tt) ((int)(unsigned)(uintptr_t)(lds + 65536 + ((tt) & 1) * 32768))
    if (mp == 0 || !ATT_STAGGER) {
        for (int t = 0; t < NT; ++t) {
            const int tl = ATT_TILE(t);
            ATT_WAITBAR(4);
            if (t + 1 < NT) ATT_DMA_K(t + 1);
            if (tl <= tmax) qk_sm(o, m_run, l_run, pw, lds + (t & 1) * 32768 + kbase, qr, tl == 0);
            if (t + 1 < NT) { ATT_WAITBAR(4); ATT_DMA_V(t + 1); } else ATT_WAITBAR(0);
            if (tl <= tmax) pv_all(o, ATT_VADDR(t), vsw, pw);
        }
        ATT_WAITBAR(0);
    } else {
        for (int t = 0; t < NT; ++t) {
            const int tl = ATT_TILE(t);
            ATT_WAITBAR(4);
            if (t >= 1 && ATT_TILE(t - 1) <= tmax) pv_all(o, ATT_VADDR(t - 1), vsw, pw);
            if (t + 1 < NT) ATT_DMA_K(t + 1);
            if (t + 1 < NT) ATT_WAITBAR(4); else ATT_WAITBAR(0);
            if (tl <= tmax) qk_sm(o, m_run, l_run, pw, lds + (t & 1) * 32768 + kbase, qr, tl == 0);
            if (t + 1 < NT) ATT_DMA_V(t + 1);
        }
        ATT_WAITBAR(0);
        if (ATT_TILE(NT - 1) <= tmax) pv_all(o, ATT_VADDR(NT - 1), vsw, pw);
    }
#undef ATT_VADDR
#endif
    asm volatile("s_waitcnt vmcnt(0) lgkmcnt(0)" ::: "memory"); __builtin_amdgcn_s_barrier(); asm volatile("" ::: "memory");
    const float ltot = l_run + xch32(l_run);
    const float inv = __builtin_amdgcn_rcpf(ltot);
    LAS float* xb = (LAS float*)lds + (size_t)rg * 8192;
    if (mp == 1) {
        const float sc = *(const LAS float*)(lds + MISC_OFF + 64) * inv;
#pragma unroll
        for (int d = 0; d < 8; ++d) {
#pragma unroll
            for (int r = 0; r < 16; ++r) xb[(d * 16 + r) * 64 + lane] = o[d][r] * sc;
            asm volatile("" ::: "memory"); }
    }
    asm volatile("s_waitcnt lgkmcnt(0)" ::: "memory"); __builtin_amdgcn_s_barrier(); asm volatile("" ::: "memory");
    if (mp == 0) {
        float ss = 0.f;
#pragma unroll
        for (int d = 0; d < 8; ++d) {
#pragma unroll
            for (int r = 0; r < 16; ++r) { const float v = o[d][r] * inv - xb[(d * 16 + r) * 64 + lane]; o[d][r] = v; ss = fmaf(v, v, ss); }
            asm volatile("" : "+v"(ss) :: "memory"); }
        ss += xch32(ss);
        const float rstd = __builtin_amdgcn_rsqf(ss * (1.0f / 256.0f) + RMS_EPS) * 0.8f;
        const bool valid = !meta || r32 < 16;
        const size_t qrow2 = meta ? (size_t)(MREAL + (r32 & 15)) : (size_t)b * SEQ + qb * 128 + rg * 32 + r32;
        const bf16_t* gp = Gt + qrow2 * DM + h * 256; bf16_t* op = O + qrow2 * DM + h * 256;
#pragma unroll
        for (int d = 0; d < 8; ++d)
#pragma unroll
            for (int rq = 0; rq < 4; ++rq) {
                const int dd = 32 * d + 8 * rq + 4 * hi;
                const u32x2 g = *(const u32x2*)(gp + dd); const f32x4 sg = *(const f32x4*)(subln_g + dd);
                const float v0 = o[d][4 * rq + 0] * rstd * sg[0] * bflo(g.x), v1 = o[d][4 * rq + 1] * rstd * sg[1] * bfhi(g.x);
                const float v2 = o[d][4 * rq + 2] * rstd * sg[2] * bflo(g.y), v3 = o[d][4 * rq + 3] * rstd * sg[3] * bfhi(g.y);
                u32x2 w; w.x = pk2(v0, v1); w.y = pk2(v2, v3);
                if (valid) *(u32x2*)(op + dd) = w;
                asm volatile("" ::: "memory");
            }
    }
    asm volatile("s_waitcnt vmcnt(0) lgkmcnt(0)" ::: "memory"); __builtin_amdgcn_s_barrier(); asm volatile("" ::: "memory");
#undef ATT_TILE
#undef ATT_DMA_K
#undef ATT_DMA_V
#undef ATT_WAITBAR
}
#undef ATT_WL
}

__global__ void __launch_bounds__(512, 2) trunk_fwd(Args args) {
    extern __shared__ __attribute__((aligned(16))) unsigned char lds_raw[];
    Frame F;
    F.lds = (LAS unsigned char*)lds_raw;
    F.wave = __builtin_amdgcn_readfirstlane((int)threadIdx.x >> 6);
    F.G = gridDim.x; { const int bx = blockIdx.x; F.vcu = (F.G % 8 == 0) ? (bx % 8) * (F.G / 8) + bx / 8 : bx; }
    volatile LAS unsigned* MISC = (volatile LAS unsigned*)(F.lds + MISC_OFF);
    unsigned char* ws = args.ws;
    gu32* ctl = (gu32*)(ws + WS_CTL);
    for (int u = F.wave * 64 + lane_id(); u < (LDS_BYTES - LDSCTL_OFF) / 4; u += 512) ((LAS unsigned*)(F.lds + LDSCTL_OFF))[u] = 0u;
    __syncthreads();
    XcdBarrier bar; bar.bar = (unsigned*)(ctl + CW_BAR); bar.x = 0; bar.st = nullptr; bar.leader = false;
    if (MK_N_LAUNCHES == 1) bar = xcd_barrier_post((unsigned*)(ctl + CW_BAR), MISC + 8, F.wave == 0);
#define GRID_BAR() do { if (MK_N_LAUNCHES == 1) xcd_barrier(bar); } while (0)
    const int lo = args.ph_lo, hi = args.ph_hi;
#define IN(k) (lo <= (k) && (k) < hi)
#define REPS(k) for (int rep_ = 0; rep_ < ((k) == PROBE_PH ? 1 + PROBE_REP : 1); ++rep_)

    const float* x = args.in[0]; const float* meta_tok = args.in[1]; const float* pre_g = args.in[2]; const float* post_g = args.in[3];
    const float* attn_w_in = args.in[4]; const float* attn_w_out = args.in[5];
    const float* lq1 = args.in[6]; const float* lk1 = args.in[7]; const float* lq2 = args.in[8]; const float* lk2 = args.in[9];
    const float* subln_g = args.in[10];
    const float* pool_w_in = args.in[11]; const float* pool_w_group = args.in[12]; const float* pool_scale = args.in[13]; const float* pool_w_out = args.in[14];
    bf16_t* W1 = (bf16_t*)(ws + WS_W1); bf16_t* W2 = (bf16_t*)(ws + WS_W2); bf16_t* W3 = (bf16_t*)(ws + WS_W3); bf16_t* W4 = (bf16_t*)(ws + WS_W4); bf16_t* W5 = (bf16_t*)(ws + WS_W5);
    bf16_t* XN = (bf16_t*)(ws + WS_XN); bf16_t* GB = (bf16_t*)(ws + WS_G); bf16_t* QO = (bf16_t*)(ws + WS_QO);
    unsigned char* Kimg = ws + WS_K; unsigned char* Vimg = ws + WS_V;
    bf16_t* Y0 = (bf16_t*)(ws + WS_Y0); bf16_t* Y1 = (bf16_t*)(ws + WS_Y1);
    bf16_t* UB = (bf16_t*)(ws + WS_U); bf16_t* G1 = (bf16_t*)(ws + WS_G1); bf16_t* MIX = (bf16_t*)(ws + WS_MIX); bf16_t* GATED1 = (bf16_t*)(ws + WS_GATED1);
    float* ropec = (float*)(ws + WS_ROPEC); float* ropes = (float*)(ws + WS_ROPES); float* rstd0 = (float*)(ws + WS_RSTD0);
    const int gw = F.vcu * 8 + F.wave, NGW = F.G * 8;
    const int NGT = F.G * 512;
#define gtid (F.vcu * 512 + F.wave * 64 + lane_id())

    Epi E; E.mode = 0; E.Q = QO; E.Kimg = Kimg; E.Vimg = Vimg; E.G = GB; E.ropec = ropec; E.ropes = ropes; E.Y = Y0; E.U = UB; E.G1 = G1; E.GATED1 = GATED1; E.pool_scale = pool_scale;

    if (IN(0)) REPS(0) {
        LAS float* scr = (LAS float*)(F.lds + F.wave * 16384);
        constexpr int I1 = (DM / 64) * (4 * DM / 32), I2 = (DM / 64) * (DM / 32), I3 = (DM / 64) * (2 * DM / 32), I4 = (512 / 64) * (512 / 32), I5 = I2;
        constexpr int NITEMS = I1 + I2 + I3 + 4 * I4 + I5;
        auto decode = [&](int it) -> P0Item {
            const float* W; bf16_t* WT; int N, ldt, row_off = 0, r = it;
            if (r < I1) { W = attn_w_in; N = 4 * DM; WT = W1; ldt = DM; }
            else if ((r -= I1) < I2) { W = attn_w_out; N = DM; WT = W2; ldt = DM; }
            else if ((r -= I2) < I3) { W = pool_w_in; N = 2 * DM; WT = W3; ldt = DM; }
            else if ((r -= I3) < 4 * I4) { const int g = r / I4; r -= g * I4; W = pool_w_group + (size_t)g * 512 * 512; N = 512; WT = W4; ldt = 512; row_off = g * 512; }
            else { r -= 4 * I4; W = pool_w_out; N = DM; WT = W5; ldt = DM; }
            const int nblk = N / 32, k0 = 64 * (r / nblk), n0 = 32 * (r % nblk);
            return P0Item{W + (size_t)k0 * N + n0, WT + (size_t)(row_off + n0) * ldt + k0, N, ldt};
        };
        {
            const int ln = lane_id();
            int it = gw; f32x4 cur[8], nxt[8]; P0Item ci{}, ni{};
            if (it < NITEMS) { ci = decode(it); p0_item_load(ci, ln, cur); }
            for (; it < NITEMS; it += NGW) {
                const bool more = it + NGW < NITEMS;
                if (more) { ni = decode(it + NGW); p0_item_load(ni, ln, nxt); }
                p0_item_store(ci, ln, cur, scr);
                if (more) { ci = ni;
#pragma unroll
                    for (int i = 0; i < 8; ++i) cur[i] = nxt[i]; }
            }
        }
        for (int i = gtid; i < LTOT * 16; i += NGT) {
            const int pos = i >> 4, k = i & 15; const float ang = (float)pos * args.inv_freq[k];
            double rev = (double)ang * 0.15915494309189535; rev -= floor(rev);
            const float fr = (float)rev; ropec[i] = __builtin_amdgcn_cosf(fr); ropes[i] = __builtin_amdgcn_sinf(fr);
        }
        for (int m = gw; m < MROWS; m += 2 * NGW) {
            const int mb = (m + NGW < MROWS) ? m + NGW : m; const int ln = lane_id();
            f32x4 va[8], vb[8];
            load_row(m < MREAL ? x + (size_t)m * DM : meta_tok + (size_t)(m - MREAL) * DM, ln, va);
            load_row(mb < MREAL ? x + (size_t)mb * DM : meta_tok + (size_t)(mb - MREAL) * DM, ln, vb);
            float sa, sb; row_ss2(va, vb, sa, sb);
            const float ra = __builtin_amdgcn_rsqf(sa * (1.0f / DM) + RMS_EPS), rb = __builtin_amdgcn_rsqf(sb * (1.0f / DM) + RMS_EPS);
#pragma unroll
            for (int j = 0; j < 8; ++j) { const f32x4 g = *(const f32x4*)(pre_g + 4 * (64 * j + ln)); va[j] = va[j] * ra * g; vb[j] = vb[j] * rb * g; }
            store_row_bf16(XN + (size_t)m * DM, ln, va);
            if (mb != m) store_row_bf16(XN + (size_t)mb * DM, ln, vb);
        }
        const u32x4 z = {0u, 0u, 0u, 0u};
        for (int i = gtid; i < NB * NH * 2 * 1024; i += NGT) *(u32x4*)(Kimg + (size_t)(i >> 10) * NTILE * KTILE_B + (i & 1023) * 16) = z;
        for (int i = gtid; i < NB * NH * 2048; i += NGT) *(u32x4*)(Vimg + (size_t)(i >> 11) * NTILE * VTILE_B + (i & 2047) * 16) = z;
        GRID_BAR();
    }
    if (IN(1)) REPS(1) {
        E.mode = 1;
        rows16_phase(F, XN + (size_t)MREAL * DM, DM, W1, DM, DM, 4 * DM / 32, 0, 1 << 30, E);
        { pg8::Gemm g{XN, W1, MREAL, 3 * DM, DM, DM, DM, 1 << 30, 0}; pg8::StaticOrder S; S.init(MREAL, 3 * DM, F.G, (int)blockIdx.x); S.skip_from = 16; S.skip_n = 8;
          pg8::gemm_phase<true>(F.lds, g, S, E, F.wave); }
        { E.mode = 6;
          pg8::Gemm g{W1 + (size_t)2 * DM * DM, XN, DM, MREAL, DM, DM, DM, 1 << 30, 0}; pg8::StaticOrder S; S.init(DM, MREAL, F.G, (int)blockIdx.x);
          pg8::gemm_phase<true>(F.lds, g, S, E, F.wave); }
        GRID_BAR();
    }
    if (IN(2)) REPS(2) {
        float d1 = 0.f, d2 = 0.f;
#pragma unroll
        for (int j = 0; j < 2; ++j) { d1 += lq1[lane_id() + 64 * j] * lk1[lane_id() + 64 * j]; d2 += lq2[lane_id() + 64 * j] * lk2[lane_id() + 64 * j]; }
        const float lam = expf(wave_sum(d1)) - expf(wave_sum(d2)) + 0.2f;
        if (F.wave == 0 && lane_id() == 0) *(LAS float*)(F.lds + MISC_OFF + 64) = lam;
        __syncthreads();
        if (ATT_STATICPRIO && F.wave >= 4) __builtin_amdgcn_s_setprio(1);
        const bool g256 = false && F.G == 256; const int xg = F.vcu >> 5, li = F.vcu & 31;
        for (int r = 0; g256 ? r < 3 : F.vcu + r * F.G < 520; ++r) {
            int bh, qb, desc;
            if (g256) { if (r == 2 && li != 0) break; bh = r == 2 ? xg : 2 * xg + r; qb = r == 0 ? li : (r == 1 ? 31 - li : -1); desc = r == 1; }
            else { const int u = F.vcu + r * F.G; desc = 0; if (u < 256) { bh = u >> 4; qb = u & 15; } else if (u < 512) { bh = (u - 256) >> 4; qb = 31 - ((u - 256) & 15); } else { bh = u - 512; qb = -1; } }
            att::attn_unit(F, QO, Kimg, Vimg, GB, XN, subln_g, bh >> 3, bh & 7, qb, desc);
        }
        if (ATT_STATICPRIO) __builtin_amdgcn_s_setprio(0);
        GRID_BAR();
    }
    if (IN(3)) REPS(3) {
        E.mode = 2; E.Y = Y0;
        rows16_phase(F, XN + (size_t)MREAL * DM, DM, W2, DM, DM, DM / 32, 0, 1 << 30, E);
        pg8::Gemm g{XN, W2, MREAL, DM, DM, DM, DM, 1 << 30, 0}; pg8::StaticOrder S; S.init(MREAL, DM, F.G, (int)blockIdx.x);
        pg8::gemm_phase<true>(F.lds, g, S, E, F.wave);
        GRID_BAR();
    }
    if (IN(4)) REPS(4) {
        for (int m = gw; m < MROWS; m += 2 * NGW) {
            const int mb = (m + NGW < MROWS) ? m + NGW : m;
            f32x4 ya[8], ha[8], yb[8], hb[8];
            load_row_bf16(Y0 + (size_t)m * DM, lane_id(), ya); load_row_bf16(Y0 + (size_t)mb * DM, lane_id(), yb);
            load_row(m < MREAL ? x + (size_t)m * DM : meta_tok + (size_t)(m - MREAL) * DM, lane_id(), ha);
            load_row(mb < MREAL ? x + (size_t)mb * DM : meta_tok + (size_t)(mb - MREAL) * DM, lane_id(), hb);
            float sa, sb; row_ss2(ya, yb, sa, sb);
            const float ra0 = __builtin_amdgcn_rsqf(sa * (1.0f / DM) + RMS_EPS), rb0 = __builtin_amdgcn_rsqf(sb * (1.0f / DM) + RMS_EPS);
            if (lane_id() == 0) { rstd0[m] = ra0; rstd0[mb] = rb0; }
#pragma unroll
            for (int j = 0; j < 8; ++j) { const f32x4 gp = *(const f32x4*)(post_g + 4 * (64 * j + lane_id())); ha[j] = ha[j] + ya[j] * ra0 * gp; hb[j] = hb[j] + yb[j] * rb0 * gp; }
            row_ss2(ha, hb, sa, sb);
            const float ra1 = __builtin_amdgcn_rsqf(sa * (1.0f / DM) + RMS_EPS), rb1 = __builtin_amdgcn_rsqf(sb * (1.0f / DM) + RMS_EPS);
#pragma unroll
            for (int j = 0; j < 8; ++j) { const f32x4 gq = *(const f32x4*)(pre_g + DM + 4 * (64 * j + lane_id())); ha[j] = ha[j] * ra1 * gq; hb[j] = hb[j] * rb1 * gq; }
            store_row_bf16(XN + (size_t)m * DM, lane_id(), ha);
            if (mb != m) store_row_bf16(XN + (size_t)mb * DM, lane_id(), hb);
        }
        GRID_BAR();
    }
    if (IN(5)) REPS(5) {
        E.mode = 3;
        rows16_phase(F, XN + (size_t)MREAL * DM, DM, W3, DM, DM, DM / 32, 0, 1 << 30, E);
        pg8::Gemm g{XN, W3, MREAL, 2 * DM, DM, DM, DM, 1 << 30, 0}; pg8::StaticOrder S; S.init(MREAL, 2 * DM, F.G, (int)blockIdx.x);
        pg8::gemm_phase<true>(F.lds, g, S, E, F.wave);
        GRID_BAR();
    }
    if (IN(6)) REPS(6) {
        for (int idx = gtid; idx < (MREAL / 16) * 256; idx += NGT) {
            const int strip = idx >> 8, c0 = (idx & 255) * 8, gi = c0 >> 9;
            if (gi == 0) mix_strip<2>(UB, MIX, strip, c0); else if (gi == 1) mix_strip<4>(UB, MIX, strip, c0);
            else if (gi == 2) mix_strip<8>(UB, MIX, strip, c0); else mix_strip<16>(UB, MIX, strip, c0);
        }
        GRID_BAR();
    }
    if (IN(7)) REPS(7) {
        E.mode = 4;
        pg8::Gemm g{MIX, W4, MREAL, DM, 512, DM, 512, 2, 512}; pg8::StaticOrder S; S.init(MREAL, DM, F.G, (int)blockIdx.x);
        pg8::gemm_phase<true>(F.lds, g, S, E, F.wave);
        GRID_BAR();
    }
    if (IN(8)) REPS(8) {
        E.mode = 5; E.Y = Y1;
        pg8::Gemm g{GATED1, W5, MREAL, DM, DM, DM, DM, 1 << 30, 0}; pg8::StaticOrder S; S.init(MREAL, DM, F.G, (int)blockIdx.x);
        pg8::gemm_phase<true>(F.lds, g, S, E, F.wave);
        GRID_BAR();
    }
    if (IN(9)) REPS(9) {
        for (int m = gw; m < MREAL; m += NGW) {
            f32x4 y1[8], acc[8]; load_row_bf16(Y1 + (size_t)m * DM, lane_id(), y1); load_row(x + (size_t)m * DM, lane_id(), acc);
            const float r0 = rstd0[m];
            const float r1 = __builtin_amdgcn_rsqf(row_ss(y1) * (1.0f / DM) + RMS_EPS);
#pragma unroll
            for (int j = 0; j < 8; ++j) {
                const int e = 4 * (64 * j + lane_id());
                const u32x2 y0w = *(const u32x2*)(Y0 + (size_t)m * DM + e); const f32x4 y0 = {bflo(y0w.x), bfhi(y0w.x), bflo(y0w.y), bfhi(y0w.y)};
                acc[j] = acc[j] + y0 * r0 * *(const f32x4*)(post_g + e) + y1[j] * r1 * *(const f32x4*)(post_g + DM + e);
                *(f32x4*)(args.out + (size_t)m * DM + e) = acc[j];
            }
        }
    }
#undef gtid
#undef IN
#undef GRID_BAR
}

extern "C" void kernel_launch(void* const* d_in, const int* in_sizes, int n_in, void* d_out, int out_size, void* d_ws, size_t ws_size, hipStream_t stream) {
    static int grid = 0;
    if (grid == 0) {
        if (n_in != 15 || in_sizes[0] != NB * SEQ * DM || out_size != NB * SEQ * DM || ws_size < WS_END) {
            fprintf(stderr, "kernel_launch: unexpected shapes (n_in %d, in0 %d, out %d, ws %zu)\n", n_in, n_in > 0 ? in_sizes[0] : -1, out_size, ws_size); grid = -1; return; }
        int dev = 0, cus = 0, per_cu = 0;
        if (hipGetDevice(&dev) != hipSuccess || hipDeviceGetAttribute(&cus, hipDeviceAttributeMultiprocessorCount, dev) != hipSuccess) { grid = -1; return; }
        if (hipFuncSetAttribute((const void*)trunk_fwd, hipFuncAttributeMaxDynamicSharedMemorySize, LDS_BYTES) != hipSuccess) { fprintf(stderr, "kernel_launch: hipFuncSetAttribute failed\n"); grid = -1; return; }
        if (hipOccupancyMaxActiveBlocksPerMultiprocessor(&per_cu, (const void*)trunk_fwd, 512, LDS_BYTES) != hipSuccess || per_cu < 1) {
            fprintf(stderr, "kernel_launch: occupancy query reports %d workgroups per CU\n", per_cu); (void)hipGetLastError(); grid = -1; return; }
        grid = cus;
    }
    if (grid < 0) return;
    (void)hipMemsetAsync((char*)d_ws + WS_CTL, 0, CTL_ZERO_BYTES, stream);
    Args a{};
    for (int i = 0; i < 15; ++i) a.in[i] = (const float*)d_in[i];
    a.out = (float*)d_out; a.ws = (unsigned char*)d_ws;
    for (int i = 0; i < 16; ++i) a.inv_freq[i] = (float)pow(500000.0, -(double)i / 16.0);
#if MK_N_LAUNCHES == 1
    a.ph_lo = 0; a.ph_hi = 10; a.li = 0;
    hipLaunchKernelGGL(trunk_fwd, dim3(grid), dim3(512), LDS_BYTES, stream, a);
#else
    for (int p = 0; p < 10; ++p) { a.ph_lo = p; a.ph_hi = p + 1; a.li = p; hipLaunchKernelGGL(trunk_fwd, dim3(grid), dim3(512), LDS_BYTES, stream, a); }
#endif
    const hipError_t le = hipPeekAtLastError();
    if (le != hipSuccess) fprintf(stderr, "kernel_launch: launch failed: %s\n", hipGetErrorName(le));
}
```
